# Optimizing an MI355X kernel written in HIP

```python
import jax, jax.numpy as jnp
from jax import lax
import numpy as np

D_MODEL = 1024
BATCH = 4
SEQ = 8192
DEPTH = 4

HG_HEADS = 8
HG_DK = 128
HG_DV = D_MODEL // HG_HEADS
HG_CHUNK = 64
LB_FLOOR = 1e-30
MLA_HEADS = 8
MLA_NOPE = 128
MLA_ROPE = 64
MLA_V = 128
Q_LORA = 384
KV_LORA = 256
ROPE_THETA = 10000.0
Q_BLOCK = 128
MASK_VALUE = -1e30
D_FF = 2816
DN_ALPHA = (2.0 * DEPTH) ** 0.25
DN_BETA = (8.0 * DEPTH) ** -0.25
LN_EPS = 1e-5
RMS_EPS = 1e-6
N_ADA = 9

SPLITS = (HG_HEADS * HG_DK,
          HG_HEADS * HG_DK,
          HG_HEADS * HG_DV,
          HG_HEADS * HG_DV,
          Q_LORA,
          KV_LORA,
          MLA_ROPE,
          D_MODEL,
          D_MODEL)
D_IN = sum(SPLITS)
SPLIT_POINTS = [int(v) for v in np.cumsum(SPLITS)[:-1]]

kernel_name = "hybrid_hgrn2_mla_macaron_deepnorm_adaln"


def layer_norm(x, g, b):
    xf = x.astype(jnp.float32)
    mu = jnp.mean(xf, -1, keepdims=True)
    var = jnp.mean(jnp.square(xf - mu), -1, keepdims=True)
    return ((xf - mu) * lax.rsqrt(var + LN_EPS)).astype(x.dtype) * g + b


def rms_norm(x, g):
    xf = x.astype(jnp.float32)
    return (xf * lax.rsqrt(jnp.mean(xf * xf, -1, keepdims=True) + RMS_EPS)).astype(x.dtype) * g


def rope_angles(positions):
    inv = 1.0 / (ROPE_THETA ** (jnp.arange(0, MLA_ROPE, 2, dtype=jnp.float32) / MLA_ROPE))
    ang = positions.astype(jnp.float32)[..., None] * inv
    return jnp.cos(ang), jnp.sin(ang)


def apply_rope(x, cos, sin):
    x1, x2 = jnp.split(x, 2, axis=-1)
    cos = cos.astype(x.dtype)
    sin = sin.astype(x.dtype)
    return jnp.concatenate([x1 * cos - x2 * sin, x1 * sin + x2 * cos], axis=-1)


def swiglu(u, w_gate, w_up, w_down):
    return (jax.nn.silu(u @ w_gate) * (u @ w_up)) @ w_down


def hgrn2_recurrence(q, k, v, log_f):
    B, S, H, DK = q.shape
    DV = v.shape[-1]
    n = S // HG_CHUNK

    def chunks(t):
        return t.astype(jnp.float32).reshape(B, n, HG_CHUNK, H, t.shape[-1]).transpose(1, 0, 3, 2, 4)

    qc, kc, vc = chunks(q), chunks(k), chunks(v)
    G = jnp.cumsum(chunks(log_f), axis=3)
    causal = jnp.tril(jnp.ones((HG_CHUNK, HG_CHUNK), bool))[:, :, None]

    def step(state, inp):
        qb, kb, vb, Gb = inp
        diff = Gb[:, :, :, None, :] - Gb[:, :, None, :, :]
        decay = jnp.where(causal, jnp.exp(jnp.where(causal, diff, 0.0)), 0.0)
        scores = jnp.einsum('bhtd,bhsd,bhtsd->bhts', qb, kb, decay)
        o = (jnp.einsum('bhts,bhse->bhte', scores, vb)
             + jnp.einsum('bhtd,bhde->bhte', qb * jnp.exp(Gb), state))
        G_end = Gb[:, :, -1:, :]
        state = (jnp.exp(G_end[:, :, 0, :])[..., None] * state
                 + jnp.einsum('bhsd,bhse->bhde', kb * jnp.exp(G_end - Gb), vb))
        return state, o

    state0 = jnp.zeros((B, H, DK, DV), jnp.float32)
    _, o = lax.scan(step, state0, (qc, kc, vc, G))
    return o.transpose(1, 0, 3, 2, 4).reshape(B, S, H, DV).astype(v.dtype)


def causal_block_attention(q, k, v):
    S = q.shape[1]
    scale = (MLA_NOPE + MLA_ROPE) ** -0.5
    outs = []
    for blk in range(S // Q_BLOCK):
        q0 = blk * Q_BLOCK
        kend = q0 + Q_BLOCK
        s = jnp.einsum('bqhd,bkhd->bhqk', q[:, q0:kend], k[:, :kend]).astype(jnp.float32) * scale
        mask = (q0 + jnp.arange(Q_BLOCK))[:, None] >= jnp.arange(kend)[None, :]
        p = jax.nn.softmax(jnp.where(mask, s, MASK_VALUE), axis=-1).astype(v.dtype)
        outs.append(jnp.einsum('bhqk,bkhd->bqhd', p, v[:, :kend]))
    return jnp.concatenate(outs, axis=1)


def token_mixer(u, cos, sin, lb, w_in, hg_norm_g, q_norm_g, w_uq, kv_norm_g, w_ukv,
                w_branch_hg, w_branch_mla, w_out):
    B, S, _ = u.shape
    zq, zf, zi, zg, cq, ckv, kr, ga, gb = jnp.split(u @ w_in, SPLIT_POINTS, axis=-1)

    lbh = lb.reshape(HG_HEADS, HG_DK)
    zf32 = zf.astype(jnp.float32).reshape(B, S, HG_HEADS, HG_DK)
    log_f = jnp.logaddexp(jnp.log(jnp.maximum(lbh, LB_FLOOR)),
                          jnp.log1p(-lbh) + jax.nn.log_sigmoid(zf32))
    hk = ((1.0 - lbh) * jax.nn.sigmoid(-zf32)).astype(u.dtype)
    hq = jax.nn.silu(zq).reshape(B, S, HG_HEADS, HG_DK)
    hv = zi.reshape(B, S, HG_HEADS, HG_DV)
    o_hg = hgrn2_recurrence(hq, hk, hv, log_f)
    o_hg = rms_norm(o_hg, hg_norm_g) * jax.nn.silu(zg).reshape(B, S, HG_HEADS, HG_DV)
    y_hg = o_hg.reshape(B, S, HG_HEADS * HG_DV) @ w_branch_hg

    q = (rms_norm(cq, q_norm_g) @ w_uq).reshape(B, S, MLA_HEADS, MLA_NOPE + MLA_ROPE)
    q = jnp.concatenate([q[..., :MLA_NOPE],
                         apply_rope(q[..., MLA_NOPE:], cos[:, :, None], sin[:, :, None])], axis=-1)
    kv = (rms_norm(ckv, kv_norm_g) @ w_ukv).reshape(B, S, MLA_HEADS, MLA_NOPE + MLA_V)
    k_rope = apply_rope(kr, cos, sin)[:, :, None, :]
    k = jnp.concatenate([kv[..., :MLA_NOPE],
                         jnp.broadcast_to(k_rope, (B, S, MLA_HEADS, MLA_ROPE))], axis=-1)
    v = kv[..., MLA_NOPE:]
    o_mla = causal_block_attention(q, k, v)
    y_mla = o_mla.reshape(B, S, MLA_HEADS * MLA_V) @ w_branch_mla

    merged = jax.nn.sigmoid(ga) * y_hg + jax.nn.sigmoid(gb) * y_mla
    return merged @ w_out


def setup_inputs(seed: int = 0) -> dict:
    key = jax.random.key(seed)
    ks = iter(jax.random.split(key, 32))

    def nrm(shape, fan_in, gain=1.0):
        return jax.random.normal(next(ks), shape, jnp.float32) * (gain * fan_in ** -0.5)

    def gains(shape):
        return 1.0 + 0.02 * jax.random.normal(next(ks), shape, jnp.float32)

    def small(shape, s=0.02):
        return s * jax.random.normal(next(ks), shape, jnp.float32)

    x = jax.random.normal(next(ks), (BATCH, SEQ, D_MODEL), jnp.float32)
    c = jax.random.normal(next(ks), (BATCH, D_MODEL), jnp.float32)
    offset = jax.random.randint(next(ks), (BATCH, 1), 0, 4096)
    positions = (jnp.arange(SEQ, dtype=jnp.int32)[None, :] + offset).astype(jnp.int32)
    return {
        "x": x,
        "c": c,
        "positions": positions,
        "ada_w": nrm((DEPTH, D_MODEL, N_ADA * D_MODEL), D_MODEL, 0.2),
        "ada_b": small((DEPTH, N_ADA * D_MODEL)),
        "ln_g": gains((DEPTH, 3, D_MODEL)),
        "ln_b": small((DEPTH, 3, D_MODEL)),
        "ffn1_gate": nrm((DEPTH, D_MODEL, D_FF), D_MODEL),
        "ffn1_up": nrm((DEPTH, D_MODEL, D_FF), D_MODEL),
        "ffn1_down": nrm((DEPTH, D_FF, D_MODEL), D_FF, DN_BETA),
        "w_in": nrm((DEPTH, D_MODEL, D_IN), D_MODEL),
        "hg_lower_bound": small((DEPTH, HG_HEADS * HG_DK), 0.1),
        "hg_norm_g": gains((DEPTH, HG_HEADS, HG_DV)),
        "mla_q_norm_g": gains((DEPTH, Q_LORA)),
        "mla_w_uq": nrm((DEPTH, Q_LORA, MLA_HEADS * (MLA_NOPE + MLA_ROPE)), Q_LORA),
        "mla_kv_norm_g": gains((DEPTH, KV_LORA)),
        "mla_w_ukv": nrm((DEPTH, KV_LORA, MLA_HEADS * (MLA_NOPE + MLA_V)), KV_LORA),
        "w_branch_hg": nrm((DEPTH, HG_HEADS * HG_DV, D_MODEL), HG_HEADS * HG_DV),
        "w_branch_mla": nrm((DEPTH, MLA_HEADS * MLA_V, D_MODEL), MLA_HEADS * MLA_V),
        "w_out": nrm((DEPTH, D_MODEL, D_MODEL), D_MODEL, DN_BETA),
        "ffn2_gate": nrm((DEPTH, D_MODEL, D_FF), D_MODEL),
        "ffn2_up": nrm((DEPTH, D_MODEL, D_FF), D_MODEL),
        "ffn2_down": nrm((DEPTH, D_FF, D_MODEL), D_FF, DN_BETA),
    }


def reference(x, c, positions, ada_w, ada_b, ln_g, ln_b, ffn1_gate, ffn1_up, ffn1_down, w_in,
              hg_lower_bound, hg_norm_g, mla_q_norm_g, mla_w_uq, mla_kv_norm_g, mla_w_ukv,
              w_branch_hg, w_branch_mla, w_out, ffn2_gate, ffn2_up, ffn2_down):
    B = x.shape[0]
    cos, sin = rope_angles(positions)
    lb_soft = jax.nn.softmax(hg_lower_bound.astype(jnp.float32), axis=0)
    lower = jnp.cumsum(lb_soft, axis=0) - lb_soft[0]
    cond = jax.nn.silu(c)
    h = x
    for l in range(DEPTH):
        ada = (cond @ ada_w[l] + ada_b[l]).reshape(B, 1, N_ADA, D_MODEL)

        u = h * (1.0 + ada[:, :, 1]) + ada[:, :, 0]
        y = swiglu(u, ffn1_gate[l], ffn1_up[l], ffn1_down[l])
        h = layer_norm(DN_ALPHA * h + 0.5 * (1.0 + ada[:, :, 2]) * y, ln_g[l, 0], ln_b[l, 0])

        u = h * (1.0 + ada[:, :, 4]) + ada[:, :, 3]
        y = token_mixer(u, cos, sin, lower[l], w_in[l], hg_norm_g[l], mla_q_norm_g[l], mla_w_uq[l],
                        mla_kv_norm_g[l], mla_w_ukv[l], w_branch_hg[l], w_branch_mla[l], w_out[l])
        h = layer_norm(DN_ALPHA * h + (1.0 + ada[:, :, 5]) * y, ln_g[l, 1], ln_b[l, 1])

        u = h * (1.0 + ada[:, :, 7]) + ada[:, :, 6]
        y = swiglu(u, ffn2_gate[l], ffn2_up[l], ffn2_down[l])
        h = layer_norm(DN_ALPHA * h + 0.5 * (1.0 + ada[:, :, 8]) * y, ln_g[l, 2], ln_b[l, 2])
    return h
```

```cpp
#include <hip/hip_runtime.h>
#include <hip/hip_cooperative_groups.h>
#include <cstdio>
#include <cstdint>
namespace cg = cooperative_groups;

#define LAS __attribute__((address_space(3)))
typedef unsigned short bf16_t;
typedef unsigned char uchar;
typedef short bf16x8 __attribute__((ext_vector_type(8)));
typedef float f32x4 __attribute__((ext_vector_type(4)));
typedef float f32x16 __attribute__((ext_vector_type(16)));
typedef unsigned u32x4 __attribute__((ext_vector_type(4)));
typedef unsigned u32x2 __attribute__((ext_vector_type(2)));
typedef float f32x2v __attribute__((ext_vector_type(2)));

constexpr int T = 32768, SEQ = 8192, DM = 1024, FF = 2816, NL = 4;
constexpr float DN_ALPHA = 1.681792830507429f;
constexpr float QSCALE = 0.10411754627697264f;
constexpr int NTHR = 512;

constexpr size_t MB = 1ull << 20;
constexpr size_t OFF_ADA = 0;
constexpr size_t OFF_COS = 1 * MB;
constexpr size_t OFF_SIN = OFF_COS + 4 * MB;
constexpr size_t OFF_LBT = OFF_SIN + 4 * MB;
constexpr size_t OFF_RSQ = OFF_LBT + 64 * 1024;
constexpr size_t OFF_RSKV = OFF_RSQ + 128 * 1024;
constexpr size_t OFF_DEC = OFF_RSKV + 128 * 1024;
constexpr size_t OFF_KRRAW = OFF_DEC + 2 * MB;
constexpr size_t OFF_KR = OFF_KRRAW + 8 * MB;
constexpr size_t OFF_W = OFF_KR + 4 * MB;
constexpr size_t WSZ = 57147392ull;
constexpr size_t W_GU1 = 0, W_D1 = 5767168, W_IN = 8650752, W_UQ = 15663104, W_UKV = 16252928, W_BH = 16777216, W_BM = 17825792,
                 W_OUT = 18874368, W_GU2 = 19922944, W_D2 = 25690112;
constexpr size_t OFF_U = OFF_W + 2 * WSZ;
constexpr size_t OFF_BIG = OFF_U + 64 * MB;
constexpr size_t OFF_R0 = OFF_BIG;
constexpr size_t OFF_R1 = OFF_R0 + 64 * MB;
constexpr size_t OFF_R2 = OFF_R1 + 64 * MB;
constexpr size_t OFF_R3 = OFF_R2 + 64 * MB;
constexpr size_t OFF_R4 = OFF_R3 + 64 * MB;
constexpr size_t OFF_R5 = OFF_R4 + 128 * MB;
constexpr size_t OFF_CQ = OFF_R5 + 32 * MB;
constexpr size_t OFF_CKV = OFF_CQ + 24 * MB;
constexpr size_t OFF_STATS = OFF_CKV + 16 * MB;
constexpr size_t OFF_ONES = OFF_STATS + 256 * 1024;
constexpr size_t WS_END = OFF_ONES + 8 * 1024;

struct Params {
    const float *x, *c; const int* pos;
    const float *ada_w, *ada_b, *ln_g, *ln_b, *f1g, *f1u, *f1d, *w_in, *hg_lb, *hg_ng, *qng, *w_uq, *kvng, *w_ukv, *w_bh, *w_bm, *w_out, *f2g, *f2u, *f2d;
    float* out; uchar* ws; int ph_lo, ph_hi;
};

#define DS0 OFF_R0
#define DM0 0x7f80u
#define DS1 OFF_R1
#define DM1 0x7c00u
#define DS2 OFF_R2
#define DM2 0x7f80u
#define DS3 OFF_R3
#define DM3 0x7f80u
#define DS4 OFF_R4
#define DM4 0x7f80u
#define DS5 (OFF_R4 + 64 * MB)
#define DM5 0x7f80u
typedef __bf16 bf16v2_t __attribute__((ext_vector_type(2)));
typedef float f32x2_t __attribute__((ext_vector_type(2)));
__device__ __forceinline__ unsigned pk2(float lo, float hi) { const f32x2_t v = {lo, hi}; const bf16v2_t r = __builtin_convertvector(v, bf16v2_t); return __builtin_bit_cast(unsigned, r); }
__device__ __forceinline__ bf16_t f2bf(float f) { return (bf16_t)(pk2(f, 0.f) & 0xffffu); }
__device__ __forceinline__ float bf2f(unsigned v) { return __uint_as_float(v << 16); }
__device__ __forceinline__ float sigm(float x) { return __builtin_amdgcn_rcpf(1.f + __expf(-x)); }
__device__ __forceinline__ float siluf(float x) { return x * sigm(x); }
__device__ __forceinline__ unsigned short f2h(float f) { _Float16 h = (_Float16)f; return __builtin_bit_cast(unsigned short, h); }
__device__ __forceinline__ float h2f(unsigned short v) { return (float)__builtin_bit_cast(_Float16, v); }
__device__ __forceinline__ unsigned pkh2(float lo, float hi) { return (unsigned)f2h(lo) | ((unsigned)f2h(hi) << 16); }
__device__ __forceinline__ u32x2 pk4(f32x4 v) { u32x2 w; w.x = pk2(v[0], v[1]); w.y = pk2(v[2], v[3]); return w; }

__device__ __forceinline__ int otid() { int w = __builtin_amdgcn_readfirstlane((int)(threadIdx.x >> 6)); asm volatile("" : "+s"(w)); int t = w * 64 + (int)__builtin_amdgcn_mbcnt_hi(~0u, __builtin_amdgcn_mbcnt_lo(~0u, 0u)); asm volatile("" : "+v"(t)); return t; }
__device__ __forceinline__ int obid() { int b = blockIdx.x; asm volatile("" : "+s"(b)); return b; }
__device__ __forceinline__ int ogdim() { int g = gridDim.x; asm volatile("" : "+s"(g)); return g; }
#define COORDS const int tid = otid(), wid = __builtin_amdgcn_readfirstlane(tid >> 6), lane = tid & 63, wr = wid >> 2, wc = wid & 3, fr = lane & 15, fq = lane >> 4; (void)lane; (void)wr; (void)wc; (void)fr; (void)fq;

constexpr int BK = 64, HALF = 128, HTB = HALF * BK * 2;
__device__ __forceinline__ int lds_byte(int r, int c) { const int st = (r >> 4) * 2 + (c >> 5), rr = r & 15, cc = c & 31, ob = rr * 64 + cc * 2; return st * 1024 + (ob ^ (((ob >> 9) & 1) << 5)); }
__device__ __forceinline__ void stage_rc(int b, int& R, int& C) { const int st = b / 1024, sb = b % 1024, swz = sb ^ (((sb >> 9) & 1) << 5); R = (st >> 1) * 16 + swz / 64; C = (st & 1) * 32 + (swz % 64) / 2; }

template <bool SWAP>
__device__ __forceinline__ void gemm_kloop(LAS uchar* lds, const char* cA, const char* cB, int K, f32x4 (&acc)[2][2][4][2]) {
    COORDS
    const int nt = K / BK;
    unsigned voff[2];
#pragma unroll
    for (int i = 0; i < 2; ++i) { int R, C; stage_rc(tid * 16 + i * 8192, R, C); voff[i] = (unsigned)(R * K + C) * 2u; }
    const size_t kstep = (size_t)(BK * 2), hstep = (size_t)HALF * K * 2;
    const unsigned ldsw = (unsigned)wid * 1024u;
    const int aoff = lds_byte(wr * 64 + fr, fq * 8), boff = lds_byte(wc * 32 + fr, fq * 8);
#define SA(b, h) (((b) * 2 + (h)) * HTB)
#define SB(b, h) ((4 + (b) * 2 + (h)) * HTB)
#define STAGE(bufoff, gbase) do { _Pragma("unroll") for (int _i = 0; _i < 2; ++_i) \
        __builtin_amdgcn_global_load_lds((const unsigned*)((const char*)(gbase) + voff[_i]), (LAS unsigned*)(lds + (bufoff) + ldsw + _i * 8192), 16, 0, 0); } while (0)
#define LDA(dst, b, h) do { _Pragma("unroll") for (int m = 0; m < 4; ++m) _Pragma("unroll") for (int k = 0; k < 2; ++k) dst[m][k] = *(const LAS bf16x8*)(lds + SA(b, h) + aoff + m * 2048 + k * 1024); } while (0)
#define LDB(dst, b, h) do { _Pragma("unroll") for (int n = 0; n < 2; ++n) _Pragma("unroll") for (int k = 0; k < 2; ++k) dst[n][k] = *(const LAS bf16x8*)(lds + SB(b, h) + boff + n * 2048 + k * 1024); } while (0)
#define MMA(ai, bj, At, Bt) do { __builtin_amdgcn_s_setprio(1); _Pragma("unroll") for (int m = 0; m < 4; ++m) _Pragma("unroll") for (int n = 0; n < 2; ++n) _Pragma("unroll") for (int k = 0; k < 2; ++k) \
        acc[ai][bj][m][n] = SWAP ? __builtin_amdgcn_mfma_f32_16x16x32_bf16(Bt[n][k], At[m][k], acc[ai][bj][m][n], 0, 0, 0) \
                                 : __builtin_amdgcn_mfma_f32_16x16x32_bf16(At[m][k], Bt[n][k], acc[ai][bj][m][n], 0, 0, 0); __builtin_amdgcn_s_setprio(0); } while (0)
#define WAIT_V(n) asm volatile("s_waitcnt vmcnt(" #n ")" ::: "memory")
#define WAIT_L(n) asm volatile("s_waitcnt lgkmcnt(" #n ")" ::: "memory")
#define BAR __builtin_amdgcn_s_barrier()
#define SCHED __builtin_amdgcn_sched_barrier(0)
    bf16x8 At[4][2], B0[2][2], B1[2][2];
    STAGE(SB(0, 0), cB); STAGE(SA(0, 0), cA); STAGE(SB(0, 1), cB + hstep); STAGE(SA(0, 1), cA + hstep);
    if (wr == 1) BAR;
    WAIT_V(4); BAR;
    STAGE(SB(1, 0), cB + kstep); STAGE(SA(1, 0), cA + kstep); STAGE(SB(1, 1), cB + hstep + kstep);
    WAIT_V(6); BAR;
    for (int t = 0; t < nt - 2; t += 2) {
        const char* a1 = cA + (size_t)(t + 1) * kstep;
        const char* a2 = cA + (size_t)(t + 2) * kstep; const char* b2 = cB + (size_t)(t + 2) * kstep;
        const char* a3 = a2 + kstep; const char* b3 = b2 + kstep;
        LDB(B0, 0, 0); SCHED; LDA(At, 0, 0); STAGE(SA(1, 1), a1 + hstep);
        WAIT_L(8); BAR; WAIT_L(0); MMA(0, 0, At, B0); BAR; SCHED;
        LDB(B1, 0, 1); STAGE(SB(0, 0), b2);
        BAR; WAIT_L(0); MMA(0, 1, At, B1); BAR;
        LDA(At, 0, 1); STAGE(SA(0, 0), a2);
        BAR; WAIT_L(0); MMA(1, 0, At, B0); BAR; SCHED;
        STAGE(SB(0, 1), b2 + hstep);
        WAIT_V(6); BAR; MMA(1, 1, At, B1); BAR;
        LDB(B0, 1, 0); SCHED; LDA(At, 1, 0); STAGE(SA(0, 1), a2 + hstep);
        WAIT_L(8); BAR; WAIT_L(0); MMA(0, 0, At, B0); BAR; SCHED;
        LDB(B1, 1, 1); STAGE(SB(1, 0), b3);
        BAR; WAIT_L(0); MMA(0, 1, At, B1); BAR;
        LDA(At, 1, 1); STAGE(SA(1, 0), a3);
        BAR; WAIT_L(0); MMA(1, 0, At, B0); BAR; SCHED;
        STAGE(SB(1, 1), b3 + hstep);
        WAIT_V(6); BAR; MMA(1, 1, At, B1); BAR;
    }
    { LDB(B0, 0, 0); LDA(At, 0, 0); STAGE(SA(1, 1), cA + (size_t)(nt - 1) * kstep + hstep);
      BAR; WAIT_L(0); MMA(0, 0, At, B0); BAR;
      LDB(B1, 0, 1); BAR; WAIT_L(0); MMA(0, 1, At, B1); BAR;
      LDA(At, 0, 1); WAIT_V(4); BAR; WAIT_L(0); MMA(1, 0, At, B0); MMA(1, 1, At, B1); BAR; }
    { LDB(B0, 1, 0); LDA(At, 1, 0); WAIT_V(2); BAR; WAIT_L(0); MMA(0, 0, At, B0); BAR;
      LDB(B1, 1, 1); WAIT_V(0); BAR; WAIT_L(0); MMA(0, 1, At, B1); BAR;
      LDA(At, 1, 1); BAR; WAIT_L(0); MMA(1, 0, At, B0); MMA(1, 1, At, B1); BAR; }
    if (wr == 0) BAR;
#undef SA
#undef SB
#undef STAGE
#undef LDA
#undef LDB
#undef MMA
}

__device__ __forceinline__ void unit_map(int L, int nM, int nN, int& pm, int& pn) {
    const int nwg = nM * nN; int wgid = L;
    { const int q = nwg / 8, r = nwg % 8, xcd = wgid % 8, off = wgid / 8; wgid = (xcd < r ? xcd * (q + 1) : r * (q + 1) + (xcd - r) * q) + off; }
    const int nig = 8 * nN, gid = wgid / nig, fm = gid * 8, gsz = (nM - fm) < 8 ? (nM - fm) : 8;
    pm = fm + ((wgid % nig) % gsz); pn = (wgid % nig) / gsz;
}

#define ZERO_ACC(acc) _Pragma("unroll") for (int a_ = 0; a_ < 2; ++a_) _Pragma("unroll") for (int b_ = 0; b_ < 2; ++b_) _Pragma("unroll") for (int m_ = 0; m_ < 4; ++m_) _Pragma("unroll") for (int n_ = 0; n_ < 2; ++n_) acc[a_][b_][m_][n_] = (f32x4){0.f, 0.f, 0.f, 0.f};

template <class Epi, bool SWAP>
__device__ __forceinline__ void gemm_run(LAS uchar* lds, const bf16_t* A, const bf16_t* Bt, int nM, int nN, int K, const Epi& E) {
    const int G = ogdim(), c = obid(), nwg = nM * nN;
    for (int i = 0;; ++i) {
        const long L = (long)i * G + c; if (L >= nwg) break;
        int pm, pn; unit_map((int)L, nM, nN, pm, pn);
        f32x4 acc[2][2][4][2]; ZERO_ACC(acc)
        asm volatile("s_waitcnt vmcnt(0)" ::: "memory");
        gemm_kloop<SWAP>(lds, (const char*)(A + (size_t)pm * 256 * K), (const char*)(Bt + (size_t)pn * 256 * K), K, acc);
        E(acc, pm, pn);
    }
}

namespace pg8 {
#define PG8_LAS __attribute__((address_space(3)))
typedef unsigned short bf16_t;
typedef short bf16x8 __attribute__((ext_vector_type(8)));
typedef float f32x4 __attribute__((ext_vector_type(4)));
typedef unsigned u32x4 __attribute__((ext_vector_type(4)));
constexpr int BM = 256, BK = 64, HALF = 128, HTB = HALF * BK * 2  , STAGE_BYTES = 8 * HTB, NXCD = 8, WGM = 8;

__host__ __device__ __forceinline__ int lds_byte(int r, int c) { const int st = (r >> 4) * 2 + (c >> 5), rr = r & 15, cc = c & 31, ob = rr * 64 + cc * 2; return st * 1024 + (ob ^ (((ob >> 9) & 1) << 5)); }
__host__ __device__ __forceinline__ void stage_rc(int b, int& R, int& C) { const int st = b / 1024, sb = b % 1024, swz = sb ^ (((sb >> 9) & 1) << 5); R = (st >> 1) * 16 + swz / 64; C = (st & 1) * 32 + (swz % 64) / 2; }
__host__ __device__ __forceinline__ int perm32(int rho) { const int n = rho >> 4, i = rho & 15; return 8 * (i >> 2) + 4 * n + (i & 3); }

struct Unit { int pm, pn; };
struct Gemm { const bf16_t* A; const bf16_t* Bt; int M, N, K; };

struct StaticOrder {
    int nM, nN, nwg, G, c;
    __host__ __device__ void init(int M, int N, int G_, int c_) { nM = M / BM; nN = N / BM; nwg = nM * nN; G = G_; c = c_; }
    __host__ __device__ bool next(int i, Unit& u) const {
        const long L = (long)i * G + c; if (L >= nwg) return false;
        int wgid = (int)L; { const int q = nwg / NXCD, r = nwg % NXCD, xcd = wgid % NXCD, off = wgid / NXCD; wgid = (xcd < r ? xcd * (q + 1) : r * (q + 1) + (xcd - r) * q) + off; }
        const int nig = WGM * nN, gid = wgid / nig, fm = gid * WGM, gsz = (nM - fm) < WGM ? (nM - fm) : WGM;
        u.pm = fm + ((wgid % nig) % gsz); u.pn = (wgid % nig) / gsz; return true;
    }
    __device__ __forceinline__ void a_ready(const Unit&) const {}
    __device__ __forceinline__ void done(const Unit&) const {}
};
template <class Epi, class Sched, bool ALIGN_EPI = false, bool SP2 = false>
__device__ __forceinline__ void gemm_phase(PG8_LAS unsigned char* lds, const Gemm g, const Sched& S, const Epi& E) {
    const int tid = otid(), wid = __builtin_amdgcn_readfirstlane(tid >> 6), lane = tid & 63, wr = wid >> 2, wc = wid & 3, fr = lane & 15, fq = lane >> 4;
    const int K = g.K, nt = K / BK;
    unsigned voffA[2], voffB[2];
#pragma unroll
    for (int i = 0; i < 2; ++i) { int R, C; stage_rc(tid * 16 + i * 8192, R, C); const int Rb = Epi::PERM ? ((R & ~31) + perm32(R & 31)) : R;
        voffA[i] = (unsigned)(R * K + C) * 2u; voffB[i] = (unsigned)(Rb * K + C) * 2u; }
    const size_t kstep = (size_t)(BK * 2);
    const size_t hstep = (size_t)HALF * K * 2;
    const size_t tstep = 2 * hstep;
    const unsigned ldsw = (unsigned)wid * 1024u;
    const int aoff = lds_byte(wr * 64 + fr, fq * 8), boff = lds_byte(wc * 32 + fr, fq * 8);
#define PG8_SA(b, h) (((b) * 2 + (h)) * HTB)
#define PG8_SB(b, h) ((4 + (b) * 2 + (h)) * HTB)
#define PG8_STAGE(bufoff, gbase, voff) do { _Pragma("unroll") for (int _i = 0; _i < 2; ++_i) \
        __builtin_amdgcn_global_load_lds((const unsigned*)((const char*)(gbase) + (voff)[_i]), (PG8_LAS unsigned*)(lds + (bufoff) + ldsw + _i * 8192), 16, 0, 0); } while (0)
#define PG8_LDA(dst, b, h) do { _Pragma("unroll") for (int m = 0; m < 4; ++m) _Pragma("unroll") for (int k = 0; k < 2; ++k) dst[m][k] = *(const PG8_LAS bf16x8*)(lds + PG8_SA(b, h) + aoff + m * 2048 + k * 1024); } while (0)
#define PG8_LDB(dst, b, h) do { _Pragma("unroll") for (int n = 0; n < 2; ++n) _Pragma("unroll") for (int k = 0; k < 2; ++k) dst[n][k] = *(const PG8_LAS bf16x8*)(lds + PG8_SB(b, h) + boff + n * 2048 + k * 1024); } while (0)
#define PG8_MMA(ai, bj, At, Bt) do { __builtin_amdgcn_s_setprio(1); _Pragma("unroll") for (int m = 0; m < 4; ++m) _Pragma("unroll") for (int n = 0; n < 2; ++n) _Pragma("unroll") for (int k = 0; k < 2; ++k) \
        acc[ai][bj][m][n] = __builtin_amdgcn_mfma_f32_16x16x32_bf16(Bt[n][k], At[m][k], acc[ai][bj][m][n], 0, 0, 0); __builtin_amdgcn_s_setprio(0); } while (0)
#define PG8_WAIT_V(n) asm volatile("s_waitcnt vmcnt(" #n ")" ::: "memory")
#define PG8_WAIT_L(n) asm volatile("s_waitcnt lgkmcnt(" #n ")" ::: "memory")
#define PG8_BAR __builtin_amdgcn_s_barrier()
#define PG8_SCHED __builtin_amdgcn_sched_barrier(0)
    Unit cur, nxt; int ui = 0;
    if (!S.next(0, cur)) return;
    f32x4 acc[2][2][4][2];
#pragma unroll
    for (int a = 0; a < 2; ++a)
#pragma unroll
        for (int b = 0; b < 2; ++b)
#pragma unroll
            for (int m = 0; m < 4; ++m)
#pragma unroll
                for (int n = 0; n < 2; ++n) acc[a][b][m][n] = (f32x4){0.f, 0.f, 0.f, 0.f};
    bf16x8 At[4][2], B0[2][2], B1[2][2];
    const char* cA = (const char*)g.A + (size_t)cur.pm * tstep; const char* cB = (const char*)g.Bt + (size_t)cur.pn * tstep;
    S.a_ready(cur);
    if constexpr (SP2) {
        PG8_STAGE(PG8_SB(0, 0), cB, voffB); PG8_STAGE(PG8_SB(0, 1), cB + hstep, voffB); PG8_STAGE(PG8_SA(0, 0), cA, voffA); PG8_STAGE(PG8_SA(0, 1), cA + hstep, voffA);
        if (wr == 1) PG8_BAR;
        PG8_WAIT_V(2); PG8_BAR;
        PG8_STAGE(PG8_SB(1, 0), cB + kstep, voffB); PG8_STAGE(PG8_SA(1, 0), cA + kstep, voffA); PG8_STAGE(PG8_SB(1, 1), cB + hstep + kstep, voffB);
        PG8_WAIT_V(6); PG8_BAR;
    } else {
        PG8_STAGE(PG8_SB(0, 0), cB, voffB); PG8_STAGE(PG8_SA(0, 0), cA, voffA); PG8_STAGE(PG8_SB(0, 1), cB + hstep, voffB); PG8_STAGE(PG8_SA(0, 1), cA + hstep, voffA);
        if (wr == 1) PG8_BAR;
        PG8_WAIT_V(4); PG8_BAR;
        PG8_STAGE(PG8_SB(1, 0), cB + kstep, voffB); PG8_STAGE(PG8_SA(1, 0), cA + kstep, voffA); PG8_STAGE(PG8_SB(1, 1), cB + hstep + kstep, voffB);
        PG8_WAIT_V(6); PG8_BAR;
    }
    for (;;) {
        const bool has_next = S.next(ui + 1, nxt);
        const char* nA = has_next ? (const char*)g.A + (size_t)nxt.pm * tstep : cA; const char* nB = has_next ? (const char*)g.Bt + (size_t)nxt.pn * tstep : cB;
        for (int t = 0; t < nt; t += 2) {
            const bool last = (t == nt - 2);
            const char* a1 = cA + (size_t)(t + 1) * kstep;
            const char* a2 = last ? nA : cA + (size_t)(t + 2) * kstep; const char* b2 = last ? nB : cB + (size_t)(t + 2) * kstep;
            const char* a3 = a2 + kstep; const char* b3 = b2 + kstep;
            if (last && has_next) S.a_ready(nxt);
            if constexpr (SP2) {
            PG8_LDB(B0, 0, 0); PG8_LDB(B1, 0, 1); PG8_SCHED; PG8_LDA(At, 0, 0); PG8_STAGE(PG8_SA(1, 1), a1 + hstep, voffA);
            PG8_WAIT_V(8); PG8_WAIT_L(0); PG8_BAR; PG8_MMA(0, 0, At, B0); PG8_MMA(0, 1, At, B1); PG8_BAR; PG8_SCHED;
            PG8_LDA(At, 0, 1); PG8_STAGE(PG8_SB(0, 0), b2, voffB); PG8_STAGE(PG8_SB(0, 1), b2 + hstep, voffB); PG8_STAGE(PG8_SA(0, 0), a2, voffA);
            PG8_WAIT_V(8); PG8_WAIT_L(0); PG8_BAR; PG8_MMA(1, 0, At, B0); PG8_MMA(1, 1, At, B1); PG8_BAR; PG8_SCHED;
            PG8_LDB(B0, 1, 0); PG8_LDB(B1, 1, 1); PG8_SCHED; PG8_LDA(At, 1, 0); PG8_STAGE(PG8_SA(0, 1), a2 + hstep, voffA);
            PG8_WAIT_V(8); PG8_WAIT_L(0); PG8_BAR; PG8_MMA(0, 0, At, B0); PG8_MMA(0, 1, At, B1); PG8_BAR; PG8_SCHED;
            PG8_LDA(At, 1, 1); PG8_STAGE(PG8_SB(1, 0), b3, voffB); PG8_STAGE(PG8_SB(1, 1), b3 + hstep, voffB); PG8_STAGE(PG8_SA(1, 0), a3, voffA);
            PG8_WAIT_V(8); PG8_WAIT_L(0); PG8_BAR; PG8_MMA(1, 0, At, B0); PG8_MMA(1, 1, At, B1); PG8_BAR; PG8_SCHED;
            } else {
            PG8_LDB(B0, 0, 0); PG8_SCHED; PG8_LDA(At, 0, 0); PG8_STAGE(PG8_SA(1, 1), a1 + hstep, voffA);
            PG8_WAIT_L(8); PG8_BAR; PG8_WAIT_L(0); PG8_MMA(0, 0, At, B0); PG8_BAR; PG8_SCHED;
            PG8_LDB(B1, 0, 1); PG8_STAGE(PG8_SB(0, 0), b2, voffB);
            PG8_BAR; PG8_WAIT_L(0); PG8_MMA(0, 1, At, B1); PG8_BAR;
            PG8_LDA(At, 0, 1); PG8_STAGE(PG8_SA(0, 0), a2, voffA);
            PG8_BAR; PG8_WAIT_L(0); PG8_MMA(1, 0, At, B0); PG8_BAR; PG8_SCHED;
            PG8_STAGE(PG8_SB(0, 1), b2 + hstep, voffB);
            PG8_WAIT_V(6); PG8_BAR; PG8_MMA(1, 1, At, B1); PG8_BAR;
            PG8_LDB(B0, 1, 0); PG8_SCHED; PG8_LDA(At, 1, 0); PG8_STAGE(PG8_SA(0, 1), a2 + hstep, voffA);
            PG8_WAIT_L(8); PG8_BAR; PG8_WAIT_L(0); PG8_MMA(0, 0, At, B0); PG8_BAR; PG8_SCHED;
            PG8_LDB(B1, 1, 1); PG8_STAGE(PG8_SB(1, 0), b3, voffB);
            PG8_BAR; PG8_WAIT_L(0); PG8_MMA(0, 1, At, B1); PG8_BAR;
            PG8_LDA(At, 1, 1); PG8_STAGE(PG8_SA(1, 0), a3, voffA);
            PG8_BAR; PG8_WAIT_L(0); PG8_MMA(1, 0, At, B0); PG8_BAR; PG8_SCHED;
            PG8_STAGE(PG8_SB(1, 1), b3 + hstep, voffB);
            PG8_WAIT_V(6); PG8_BAR; PG8_MMA(1, 1, At, B1); PG8_BAR;
            }
        }
        if constexpr (ALIGN_EPI) { if (wr == 0) PG8_BAR; }
        if constexpr (!Epi::AFTER_DRAIN) { E(acc, cur, wr, wc, fr, fq); S.done(cur); }
        if (!has_next) break;
#pragma unroll
        for (int a = 0; a < 2; ++a)
#pragma unroll
            for (int b = 0; b < 2; ++b)
#pragma unroll
                for (int m = 0; m < 4; ++m)
#pragma unroll
                    for (int n = 0; n < 2; ++n) acc[a][b][m][n] = (f32x4){0.f, 0.f, 0.f, 0.f};
        cur = nxt; cA = nA; cB = nB; ++ui;
        if constexpr (ALIGN_EPI) { if (wr == 1) PG8_BAR; }
    }
    PG8_WAIT_V(0);
    if constexpr (!ALIGN_EPI) { if (wr == 0) PG8_BAR; }
    PG8_BAR;
    if constexpr (Epi::AFTER_DRAIN) { E.fused(acc, cur, wr, wc, fr, fq, lds, wid, lane); S.done(cur); }
#undef PG8_SA
#undef PG8_SB
#undef PG8_STAGE
#undef PG8_LDA
#undef PG8_LDB
#undef PG8_MMA
#undef PG8_WAIT_V
#undef PG8_WAIT_L
#undef PG8_BAR
#undef PG8_SCHED
}
}

template <class E> struct Pg8Epi { static constexpr bool PERM = true, AFTER_DRAIN = false; E e;
    __device__ __forceinline__ void operator()(f32x4 (&acc)[2][2][4][2], const pg8::Unit& u, int, int, int, int) const { e(acc, u.pm, u.pn); } };
template <class Epi>
__device__ __forceinline__ void gemm_run2(LAS uchar* lds, const bf16_t* A, const bf16_t* Bt, int nM, int nN, int K, const Epi& E) {
    pg8::Gemm g{A, Bt, nM * 256, nN * 256, K}; pg8::StaticOrder S; S.init(nM * 256, nN * 256, ogdim(), obid());
    Pg8Epi<Epi> PE{E};
    pg8::gemm_phase<Pg8Epi<Epi>, pg8::StaticOrder, true, true>(lds, g, S, PE);
}
#define EPI_LOOP _Pragma("unroll") for (int ai = 0; ai < 2; ++ai) _Pragma("unroll") for (int m = 0; m < 4; ++m) _Pragma("unroll") for (int bj = 0; bj < 2; ++bj) _Pragma("unroll") for (int n = 0; n < 2; ++n)
#define EPI_FENCE do { if (bj == 1 && n == 1) asm volatile("" ::: "memory"); } while (0)

#define EPI2_LOOP _Pragma("unroll") for (int ai = 0; ai < 2; ++ai) _Pragma("unroll") for (int m = 0; m < 4; ++m) _Pragma("unroll") for (int bj = 0; bj < 2; ++bj)
#define EPI2_FENCE do { if (bj == 1) asm volatile("" ::: "memory"); } while (0)
__device__ __forceinline__ u32x4 pk8(f32x4 a, f32x4 b) { u32x4 w; w.x = pk2(a[0], a[1]); w.y = pk2(a[2], a[3]); w.z = pk2(b[0], b[1]); w.w = pk2(b[2], b[3]); return w; }
__device__ __forceinline__ u32x4 pkh8(f32x4 a, f32x4 b) { u32x4 w; w.x = pkh2(a[0], a[1]); w.y = pkh2(a[2], a[3]); w.z = pkh2(b[0], b[1]); w.w = pkh2(b[2], b[3]); return w; }
__device__ __forceinline__ f32x4 silu4(f32x4 v) { f32x4 s; s[0] = siluf(v[0]); s[1] = siluf(v[1]); s[2] = siluf(v[2]); s[3] = siluf(v[3]); return s; }
__device__ __forceinline__ f32x4 sigm4(f32x4 v) { f32x4 s; s[0] = sigm(v[0]); s[1] = sigm(v[1]); s[2] = sigm(v[2]); s[3] = sigm(v[3]); return s; }
__device__ __forceinline__ void unh8(u32x4 w, f32x4& a, f32x4& b) { a[0] = h2f(w.x & 0xffff); a[1] = h2f(w.x >> 16); a[2] = h2f(w.y & 0xffff); a[3] = h2f(w.y >> 16); b[0] = h2f(w.z & 0xffff); b[1] = h2f(w.z >> 16); b[2] = h2f(w.w & 0xffff); b[3] = h2f(w.w >> 16); }
__device__ __forceinline__ void unb8(u32x4 w, f32x4& a, f32x4& b) { a[0] = bf2f(w.x & 0xffff); a[1] = bf2f(w.x >> 16); a[2] = bf2f(w.y & 0xffff); a[3] = bf2f(w.y >> 16); b[0] = bf2f(w.z & 0xffff); b[1] = bf2f(w.z >> 16); b[2] = bf2f(w.w & 0xffff); b[3] = bf2f(w.w >> 16); }

struct EpiGU { bf16_t* hid;
    __device__ __forceinline__ void operator()(f32x4 (&acc)[2][2][4][2], int pm, int pn) const { COORDS
#pragma unroll
        for (int ai = 0; ai < 2; ++ai)
#pragma unroll
            for (int m = 0; m < 4; ++m) { const int r = pm * 256 + ai * 128 + wr * 64 + m * 16 + fr, cc = pn * 128 + wc * 32 + fq * 8;
                *(u32x4*)(hid + (size_t)r * FF + cc) = pk8(silu4(acc[ai][0][m][0]) * acc[ai][1][m][0], silu4(acc[ai][0][m][1]) * acc[ai][1][m][1]); } } };

struct EpiRes { float* h; const float* ada; float coef; const float* stats; const float* g; const float* bta; const float* hsrc;
    __device__ __forceinline__ void operator()(f32x4 (&acc)[2][2][4][2], int pm, int pn) const { COORDS
        const float* ap = ada + (size_t)(pm >> 5) * 9216;
        EPI2_LOOP { const int r = pm * 256 + ai * 128 + wr * 64 + m * 16 + fr, c = pn * 256 + bj * 128 + wc * 32 + fq * 8;
            const float mu = stats[2 * r], rs = stats[2 * r + 1]; float* hp = h + (size_t)r * DM + c; const float* sp = hsrc + (size_t)r * DM + c;
#pragma unroll
            for (int n = 0; n < 2; ++n) { const f32x4 gv = *(const f32x4*)(ap + c + 4 * n), gg = *(const f32x4*)(g + c + 4 * n), bb = *(const f32x4*)(bta + c + 4 * n), zv = *(const f32x4*)(sp + 4 * n);
                f32x4 z;
#pragma unroll
                for (int j = 0; j < 4; ++j) { const float hv = (zv[j] - mu) * rs * gg[j] + bb[j]; z[j] = DN_ALPHA * hv + coef * (1.f + gv[j]) * acc[ai][bj][m][n][j]; }
                *(f32x4*)(hp + 4 * n) = z; }
            EPI2_FENCE; } } };

struct EpiWin1 { bf16_t *hq, *hv, *sg, *cq, *ckv; unsigned short* zf; float* krraw;
    __device__ __forceinline__ void operator()(f32x4 (&acc)[2][2][4][2], int pm, int pn) const { COORDS
        const int kind = pn >> 2;
        EPI2_LOOP { const int r = pm * 256 + ai * 128 + wr * 64 + m * 16 + fr, c = pn * 256 + bj * 128 + wc * 32 + fq * 8; const f32x4 v0 = acc[ai][bj][m][0], v1 = acc[ai][bj][m][1];
            if (kind == 0) *(u32x4*)(hq + (size_t)r * DM + c) = pk8(silu4(v0), silu4(v1));
            else if (kind == 1) *(u32x4*)(zf + (size_t)r * DM + (c - 1024)) = pkh8(v0, v1);
            else if (kind == 2) *(u32x4*)(hv + (size_t)r * DM + (c - 2048)) = pk8(v0, v1);
            else if (kind == 3) *(u32x4*)(sg + (size_t)r * DM + (c - 3072)) = pk8(silu4(v0), silu4(v1));
            else { const int gc = c - 4096;
                if (gc < 384) *(u32x4*)(cq + (size_t)r * 384 + gc) = pk8(v0, v1);
                else if (gc < 640) *(u32x4*)(ckv + (size_t)r * 256 + (gc - 384)) = pk8(v0, v1);
                else if (gc < 704) { *(f32x4*)(krraw + (size_t)r * 64 + (gc - 640)) = v0; *(f32x4*)(krraw + (size_t)r * 64 + (gc - 640) + 4) = v1; } } } } };

struct EpiQ { bf16_t *qn, *qr; const float *rsq, *cosT, *sinT;
    __device__ __forceinline__ void operator()(f32x4 (&acc)[2][2][4][2], int pm, int pn) const { COORDS
#pragma unroll
        for (int ai = 0; ai < 2; ++ai)
#pragma unroll
            for (int m = 0; m < 4; ++m) { const int r = pm * 256 + ai * 128 + wr * 64 + m * 16 + fr; const float rs = rsq[r] * QSCALE;
                if (pn < 4) {
#pragma unroll
                    for (int bj = 0; bj < 2; ++bj) { const int c = pn * 256 + bj * 128 + wc * 32 + fq * 8; *(u32x4*)(qn + (size_t)r * DM + c) = pk8(acc[ai][bj][m][0] * rs, acc[ai][bj][m][1] * rs); }
                } else { const int cl = wc * 32 + fq * 8, hh = (pn - 4) * 4 + (cl >> 5), i = cl & 31;
                    f32x4 o1[2], o2[2];
#pragma unroll
                    for (int n = 0; n < 2; ++n) { const f32x4 x1 = acc[ai][0][m][n] * rs, x2 = acc[ai][1][m][n] * rs; const f32x4 cs = *(const f32x4*)(cosT + (size_t)r * 32 + i + 4 * n), sn = *(const f32x4*)(sinT + (size_t)r * 32 + i + 4 * n);
                        o1[n] = x1 * cs - x2 * sn; o2[n] = x1 * sn + x2 * cs; }
                    *(u32x4*)(qr + (size_t)r * 512 + hh * 64 + i) = pk8(o1[0], o1[1]); *(u32x4*)(qr + (size_t)r * 512 + hh * 64 + 32 + i) = pk8(o2[0], o2[1]);
                }
                asm volatile("" ::: "memory"); } } };

struct EpiKn { bf16_t* kn; const float* rskv;
    __device__ __forceinline__ void operator()(f32x4 (&acc)[2][2][4][2], int pm, int pn) const { COORDS
        EPI2_LOOP { const int r = pm * 256 + ai * 128 + wr * 64 + m * 16 + fr, c = pn * 256 + bj * 128 + wc * 32 + fq * 8; const float rs = rskv[r];
            *(u32x4*)(kn + (size_t)r * DM + c) = pk8(acc[ai][bj][m][0] * rs, acc[ai][bj][m][1] * rs); EPI2_FENCE; } } };

struct EpiV { bf16_t* vt; const float* rskv;
    __device__ __forceinline__ void operator()(f32x4 (&acc)[2][2][4][2], int pm, int pn) const { COORDS
        EPI_LOOP { const int r0 = pm * 256 + ai * 128 + wr * 64 + m * 16 + fq * 4, cv = pn * 256 + bj * 128 + wc * 32 + n * 16 + fr;
            const f32x4 rs = *(const f32x4*)(rskv + r0); const int b = r0 >> 13, s = r0 & 8191, hh = cv >> 7, e = cv & 127;
            *(u32x2*)(vt + (((size_t)((b * 8 + hh) * 128 + e)) << 13) + s) = pk4(acc[ai][bj][m][n] * rs); EPI_FENCE; } } };

struct EpiGate { unsigned short *sga, *sgb;
    __device__ __forceinline__ void operator()(f32x4 (&acc)[2][2][4][2], int pm, int pn) const { COORDS
        unsigned short* dst = pn < 4 ? sga : sgb;
        EPI2_LOOP { const int r = pm * 256 + ai * 128 + wr * 64 + m * 16 + fr, c = (pn & 3) * 256 + bj * 128 + wc * 32 + fq * 8;
            *(u32x4*)(dst + (size_t)r * DM + c) = pkh8(sigm4(acc[ai][bj][m][0]), sigm4(acc[ai][bj][m][1])); } } };

struct EpiM1 { bf16_t* m1; const unsigned short* sga;
    __device__ __forceinline__ void operator()(f32x4 (&acc)[2][2][4][2], int pm, int pn) const { COORDS
        EPI2_LOOP { const int r = pm * 256 + ai * 128 + wr * 64 + m * 16 + fr, c = pn * 256 + bj * 128 + wc * 32 + fq * 8;
            f32x4 s0, s1; unh8(*(const u32x4*)(sga + (size_t)r * DM + c), s0, s1);
            *(u32x4*)(m1 + (size_t)r * DM + c) = pk8(acc[ai][bj][m][0] * s0, acc[ai][bj][m][1] * s1); EPI2_FENCE; } } };
struct EpiM2 { const bf16_t* m1; const unsigned short* sgb; bf16_t* merged;
    __device__ __forceinline__ void operator()(f32x4 (&acc)[2][2][4][2], int pm, int pn) const { COORDS
        EPI2_LOOP { const int r = pm * 256 + ai * 128 + wr * 64 + m * 16 + fr, c = pn * 256 + bj * 128 + wc * 32 + fq * 8;
            f32x4 s0, s1, m0, m1v; unh8(*(const u32x4*)(sgb + (size_t)r * DM + c), s0, s1); unb8(*(const u32x4*)(m1 + (size_t)r * DM + c), m0, m1v);
            *(u32x4*)(merged + (size_t)r * DM + c) = pk8(m0 + acc[ai][bj][m][0] * s0, m1v + acc[ai][bj][m][1] * s1); EPI2_FENCE; } } };

struct ConvDesc { const float* src0; const float* src1; const float* kscale; int K, Ns; bf16_t* dst; int kind, item; };
__device__ __forceinline__ void conv_load(const ConvDesc& d, int tid, float (&v)[8]) {
    const int nkt = d.K / 64; const int kt = d.item % nkt, ntile = d.item / nkt; const int k0 = kt * 64, n0 = ntile * 64;
    const int tn = tid & 63, np = n0 + tn; const float* s = d.src0; int col = np;
    if (d.kind == 1) { const int tile = np >> 8, bj = (np >> 7) & 1, cc = np & 127; s = bj ? d.src1 : d.src0; col = tile * 128 + cc; }
    else if (d.kind == 2) { if (np < 1024) col = (np >> 7) * 192 + (np & 127); else { const int r = np - 1024, t2 = r >> 8, bj = (r >> 7) & 1, cc = r & 127, hh = t2 * 4 + (cc >> 5), i = cc & 31; col = hh * 192 + 128 + bj * 32 + i; } }
    else if (d.kind == 3) { if (np < 1024) col = (np >> 7) * 256 + (np & 127); else { const int r = np - 1024; col = (r >> 7) * 256 + 128 + (r & 127); } }
#pragma unroll
    for (int i = 0; i < 8; ++i) { const int kk = (tid >> 6) + 8 * i; float x = s[(size_t)(k0 + kk) * d.Ns + col]; if (d.kscale) x *= d.kscale[k0 + kk]; v[i] = x; }
}
__device__ __forceinline__ void conv_store(LAS uchar* lds, const ConvDesc& d, int tid, const float (&v)[8]) {
    LAS float* tl = (LAS float*)lds;
    const int nkt = d.K / 64; const int kt = d.item % nkt, ntile = d.item / nkt; const int k0 = kt * 64, n0 = ntile * 64;
    { const int tn = tid & 63;
#pragma unroll
      for (int i = 0; i < 8; ++i) tl[tn * 65 + (tid >> 6) + 8 * i] = v[i]; }
    __syncthreads();
    { const int n = tid >> 3, kc = tid & 7; const LAS float* rp = tl + n * 65 + kc * 8; u32x4 w; w.x = pk2(rp[0], rp[1]); w.y = pk2(rp[2], rp[3]); w.z = pk2(rp[4], rp[5]); w.w = pk2(rp[6], rp[7]);
      *(u32x4*)(d.dst + (size_t)(n0 + n) * d.K + k0 + kc * 8) = w; }
    __syncthreads();
}
__device__ __forceinline__ ConvDesc conv_desc(const Params& p, int l, int it) {
    bf16_t* W = (bf16_t*)(p.ws + OFF_W + (size_t)(l & 1) * WSZ);
    constexpr int I_GU = 16 * 88, I_D = 44 * 16, I_IN = 16 * 107, I_UQ = 6 * 24, I_UKV = 4 * 32, I_SQ = 256;
    const size_t o_ff = (size_t)l * DM * FF; int r = it;
    if (r < I_GU) return ConvDesc{p.f1g + o_ff, p.f1u + o_ff, nullptr, DM, FF, W + W_GU1, 1, r}; r -= I_GU;
    if (r < I_D) return ConvDesc{p.f1d + o_ff, nullptr, nullptr, FF, DM, W + W_D1, 0, r}; r -= I_D;
    if (r < I_IN) return ConvDesc{p.w_in + (size_t)l * DM * 6848, nullptr, nullptr, DM, 6848, W + W_IN, 0, r}; r -= I_IN;
    if (r < I_UQ) return ConvDesc{p.w_uq + (size_t)l * 384 * 1536, nullptr, p.qng + l * 384, 384, 1536, W + W_UQ, 2, r}; r -= I_UQ;
    if (r < I_UKV) return ConvDesc{p.w_ukv + (size_t)l * 256 * 2048, nullptr, p.kvng + l * 256, 256, 2048, W + W_UKV, 3, r}; r -= I_UKV;
    if (r < I_SQ) return ConvDesc{p.w_bh + (size_t)l * DM * DM, nullptr, nullptr, DM, DM, W + W_BH, 0, r}; r -= I_SQ;
    if (r < I_SQ) return ConvDesc{p.w_bm + (size_t)l * DM * DM, nullptr, nullptr, DM, DM, W + W_BM, 0, r}; r -= I_SQ;
    if (r < I_SQ) return ConvDesc{p.w_out + (size_t)l * DM * DM, nullptr, nullptr, DM, DM, W + W_OUT, 0, r}; r -= I_SQ;
    if (r < I_GU) return ConvDesc{p.f2g + o_ff, p.f2u + o_ff, nullptr, DM, FF, W + W_GU2, 1, r}; r -= I_GU;
    return ConvDesc{p.f2d + o_ff, nullptr, nullptr, FF, DM, W + W_D2, 0, r};
}
__device__ void conv_layer(LAS uchar* lds, const Params& p, int l, int start, int stride) {
    constexpr int TOT = 2 * 16 * 88 + 2 * 44 * 16 + 16 * 107 + 6 * 24 + 4 * 32 + 3 * 256;
    const int tid = otid();
    float v[8], vn[8];
    if (start < TOT) { const ConvDesc d = conv_desc(p, l, start); conv_load(d, tid, v); }
    for (int it = start; it < TOT; it += stride) {
        const ConvDesc d = conv_desc(p, l, it);
        if (it + stride < TOT) { const ConvDesc dn = conv_desc(p, l, it + stride); conv_load(dn, tid, vn); }
        conv_store(lds, d, tid, v);
#pragma unroll
        for (int i = 0; i < 8; ++i) v[i] = vn[i];
    }
}

__device__ void p0a(LAS uchar* lds, const Params& p) {
    const int tid = otid(), G = ogdim();
    float* ADA = (float*)(p.ws + OFF_ADA);
    LAS float* red = (LAS float*)lds;
    LAS float* cond = red + 2048;
    for (int i = tid; i < 4096; i += NTHR) cond[i] = siluf(p.c[i]);
    __syncthreads();
    for (int it = obid(); it < NL * 144; it += G) {
        const int l = it / 144, cg0 = (it % 144) * 64, cn = tid & 63, kp = tid >> 6;
        const float* w = p.ada_w + (size_t)l * DM * 9216 + cg0 + cn;
        float a0 = 0.f, a1 = 0.f, a2 = 0.f, a3 = 0.f;
        for (int k = kp * 128; k < kp * 128 + 128; ++k) { const float wv = w[(size_t)k * 9216];
            a0 += cond[k] * wv; a1 += cond[1024 + k] * wv; a2 += cond[2048 + k] * wv; a3 += cond[3072 + k] * wv; }
        red[(kp * 4 + 0) * 64 + cn] = a0; red[(kp * 4 + 1) * 64 + cn] = a1; red[(kp * 4 + 2) * 64 + cn] = a2; red[(kp * 4 + 3) * 64 + cn] = a3;
        __syncthreads();
        if (tid < 256) { const int b = tid >> 6; float s = 0.f;
#pragma unroll
            for (int q = 0; q < 8; ++q) s += red[(q * 4 + b) * 64 + cn];
            ADA[(size_t)(l * 4 + b) * 9216 + cg0 + cn] = s + p.ada_b[(size_t)l * 9216 + cg0 + cn]; }
        __syncthreads();
    }
    float* COS = (float*)(p.ws + OFF_COS); float* SIN = (float*)(p.ws + OFF_SIN);
    for (int e = obid() * NTHR + tid; e < T * 32; e += G * NTHR) {
        const int tok = e >> 5, i = e & 31; double inv = 1.0, rr = 0.7498942093324558; int n = i;
        while (n) { if (n & 1) inv *= rr; rr *= rr; n >>= 1; }
        const double ang = (double)p.pos[tok] * inv; const double kq = __builtin_rint(ang * 0.15915494309189535);
        double r = ang - kq * 6.283185307179586 - kq * 2.4492935982947064e-16; const double r2 = r * r;
        double sn, cs;
        { double t = 1.0;
#pragma unroll
          for (int q = 27; q >= 3; q -= 2) t = 1.0 - t * r2 * (1.0 / (double)(q * (q - 1))); sn = t * r; }
        { double t = 1.0;
#pragma unroll
          for (int q = 26; q >= 2; q -= 2) t = 1.0 - t * r2 * (1.0 / (double)(q * (q - 1))); cs = t; }
        COS[e] = (float)cs; SIN[e] = (float)sn;
    }
    { float* onz = (float*)(p.ws + OFF_ONES); for (int ch = obid() * NTHR + tid; ch < 2048; ch += G * NTHR) onz[ch] = ch < 1024 ? 1.f : 0.f; }
    float* LBT = (float*)(p.ws + OFF_LBT);
    for (int ch = obid() * NTHR + tid; ch < 1024; ch += G * NTHR) {
        const float v0 = p.hg_lb[ch], v1 = p.hg_lb[1024 + ch], v2 = p.hg_lb[2048 + ch], v3 = p.hg_lb[3072 + ch];
        const float mx = fmaxf(fmaxf(v0, v1), fmaxf(v2, v3)); const float e0 = expf(v0 - mx), e1 = expf(v1 - mx), e2 = expf(v2 - mx), e3 = expf(v3 - mx); const float inv = 1.f / (e0 + e1 + e2 + e3);
        float lw[4]; lw[0] = 0.f; lw[1] = e1 * inv; lw[2] = (e1 + e2) * inv; lw[3] = (e1 + e2 + e3) * inv;
#pragma unroll
        for (int l = 0; l < 4; ++l) { const float lb = lw[l]; LBT[(l * 3 + 0) * 1024 + ch] = fmaxf(lb, 1e-30f); LBT[(l * 3 + 1) * 1024 + ch] = log1pf(-lb); LBT[(l * 3 + 2) * 1024 + ch] = 1.f - lb; }
    }
}

__device__ void ln_pass(const Params& p, const float* src, float* hdst, bf16_t* U, const float* g, const float* bta, const float* ada_l, int sc_idx, int sh_idx, bool donorm, bool writeU, bool writeH) {
    float* stats = (float*)(p.ws + OFF_STATS);
    const int tid = otid(), wid = tid >> 6, lane = tid & 63;
    for (int row = obid() * 8 + wid; row < T; row += ogdim() * 8) {
        const f32x4* xr = (const f32x4*)(src + (size_t)row * DM) + lane; f32x4 v[4]; float s = 0.f;
#pragma unroll
        for (int j = 0; j < 4; ++j) { v[j] = xr[64 * j]; s += (v[j][0] + v[j][1]) + (v[j][2] + v[j][3]); }
        if (donorm) {
#pragma unroll
            for (int o = 32; o > 0; o >>= 1) s += __shfl_xor(s, o);
            const float mean = s * (1.f / DM); float s2 = 0.f;
#pragma unroll
            for (int j = 0; j < 4; ++j) { v[j] = v[j] - mean; s2 += (v[j][0] * v[j][0] + v[j][1] * v[j][1]) + (v[j][2] * v[j][2] + v[j][3] * v[j][3]); }
#pragma unroll
            for (int o = 32; o > 0; o >>= 1) s2 += __shfl_xor(s2, o);
            const float rstd = 1.f / sqrtf(s2 * (1.f / DM) + 1e-5f);
            if (lane == 0) *(f32x2v*)(stats + 2 * row) = (f32x2v){mean, rstd};
#pragma unroll
            for (int j = 0; j < 4; ++j) { const f32x4 gg = *((const f32x4*)g + lane + 64 * j), bb = *((const f32x4*)bta + lane + 64 * j); v[j] = v[j] * rstd * gg + bb; }
        }
        else if (lane == 0) { const float zz = v[0][0] * 0.f; *(f32x2v*)(stats + 2 * row) = (f32x2v){zz, 1.f + zz}; }
        if (writeH) { f32x4* hr = (f32x4*)(hdst + (size_t)row * DM) + lane;
#pragma unroll
            for (int j = 0; j < 4; ++j) hr[64 * j] = v[j]; }
        if (writeU) { const float* ab = ada_l + (size_t)(row >> 13) * 9216; u32x2* ur = (u32x2*)(U + (size_t)row * DM) + lane;
#pragma unroll
            for (int j = 0; j < 4; ++j) { const f32x4 sc = *((const f32x4*)(ab + sc_idx * 1024) + lane + 64 * j), sh = *((const f32x4*)(ab + sh_idx * 1024) + lane + 64 * j); ur[64 * j] = pk4(v[j] * (1.f + sc) + sh); } }
    }
}

__device__ void ln_pass2(const Params& p, const float* src, float* outH, bf16_t* U, const float* g, const float* bta, const float* ada_l, int sc_idx, int sh_idx) {
    float* stats = (float*)(p.ws + OFF_STATS);
    const int tid = otid(), wid = tid >> 6, lane = tid & 63; const int rstep = ogdim() * 8, r0 = obid() * 8 + wid;
    for (int b = 0; b < 4; ++b) {
        f32x4 A[4], B[4];
#pragma unroll
        for (int j = 0; j < 4; ++j) { const f32x4 gg = *((const f32x4*)g + lane + 64 * j), bb = *((const f32x4*)bta + lane + 64 * j);
            if (outH) { A[j] = gg; B[j] = bb; }
            else { const float* ab = ada_l + (size_t)b * 9216; const f32x4 sc = *((const f32x4*)(ab + sc_idx * 1024) + lane + 64 * j), sh = *((const f32x4*)(ab + sh_idx * 1024) + lane + 64 * j); A[j] = gg * (1.f + sc); B[j] = bb * (1.f + sc) + sh; } }
        f32x4 v[4], vn[4];
        if (r0 < SEQ) {
#pragma unroll
            for (int j = 0; j < 4; ++j) v[j] = *((const f32x4*)(src + (size_t)(b * SEQ + r0) * DM) + lane + 64 * j); }
        for (int rr = r0; rr < SEQ; rr += rstep) {
            const int row = b * SEQ + rr;
            if (rr + rstep < SEQ) {
#pragma unroll
                for (int j = 0; j < 4; ++j) vn[j] = *((const f32x4*)(src + (size_t)(row + rstep) * DM) + lane + 64 * j); }
            float s = 0.f;
#pragma unroll
            for (int j = 0; j < 4; ++j) s += (v[j][0] + v[j][1]) + (v[j][2] + v[j][3]);
#pragma unroll
            for (int o = 32; o > 0; o >>= 1) s += __shfl_xor(s, o);
            const float mean = s * (1.f / DM); float s2 = 0.f;
#pragma unroll
            for (int j = 0; j < 4; ++j) { v[j] = v[j] - mean; s2 += (v[j][0] * v[j][0] + v[j][1] * v[j][1]) + (v[j][2] * v[j][2] + v[j][3] * v[j][3]); }
#pragma unroll
            for (int o = 32; o > 0; o >>= 1) s2 += __shfl_xor(s2, o);
            const float rstd = 1.f / sqrtf(s2 * (1.f / DM) + 1e-5f);
            if (lane == 0) *(f32x2v*)(stats + 2 * row) = (f32x2v){mean, rstd};
            if (outH) { f32x4* hr = (f32x4*)(outH + (size_t)row * DM) + lane;
#pragma unroll
                for (int j = 0; j < 4; ++j) hr[64 * j] = v[j] * rstd * A[j] + B[j]; }
            else { u32x2* ur = (u32x2*)(U + (size_t)row * DM) + lane;
#pragma unroll
                for (int j = 0; j < 4; ++j) ur[64 * j] = pk4(v[j] * rstd * A[j] + B[j]); }
#pragma unroll
            for (int j = 0; j < 4; ++j) v[j] = vn[j];
        }
    }
}

__device__ void tok_pass(const Params& p) {
    const int tid = otid(), wid = tid >> 6, lane = tid & 63;
    const bf16_t* CQ = (const bf16_t*)(p.ws + OFF_CQ); const bf16_t* CKV = (const bf16_t*)(p.ws + OFF_CKV);
    const float* KRRAW = (const float*)(p.ws + OFF_KRRAW); bf16_t* KR = (bf16_t*)(p.ws + OFF_KR);
    const float* COS = (const float*)(p.ws + OFF_COS); const float* SIN = (const float*)(p.ws + OFF_SIN);
    float* RSQ = (float*)(p.ws + OFF_RSQ); float* RSKV = (float*)(p.ws + OFF_RSKV);
    const int step = ogdim() * 8, t0 = obid() * 8 + wid; const int l31 = lane & 31;
    unsigned qw[3], qn[3]; u32x2 kw, kn2; float x1, x2, cs, sn, x1n, x2n, csn, snn;
#define TOK_LOAD(tok_, Q_, K_, X1_, X2_, C_, S_) do { const unsigned* q_ = (const unsigned*)(CQ + (size_t)(tok_) * 384) + lane * 3; Q_[0] = q_[0]; Q_[1] = q_[1]; Q_[2] = q_[2]; K_ = *((const u32x2*)(CKV + (size_t)(tok_) * 256) + lane); \
        X1_ = KRRAW[(size_t)(tok_) * 64 + l31]; X2_ = KRRAW[(size_t)(tok_) * 64 + 32 + l31]; C_ = COS[(size_t)(tok_) * 32 + l31]; S_ = SIN[(size_t)(tok_) * 32 + l31]; } while (0)
    if (t0 < T) TOK_LOAD(t0, qw, kw, x1, x2, cs, sn);
    for (int tok = t0; tok < T; tok += step) {
        if (tok + step < T) TOK_LOAD(tok + step, qn, kn2, x1n, x2n, csn, snn);
        float s = 0.f;
#pragma unroll
        for (int j = 0; j < 3; ++j) { const float a = bf2f(qw[j] & 0xffff), b = bf2f(qw[j] >> 16); s += a * a + b * b; }
        float s2; { const float a = bf2f(kw.x & 0xffff), b = bf2f(kw.x >> 16), c = bf2f(kw.y & 0xffff), d = bf2f(kw.y >> 16); s2 = a * a + b * b + c * c + d * d; }
#pragma unroll
        for (int o = 32; o > 0; o >>= 1) { s += __shfl_xor(s, o); s2 += __shfl_xor(s2, o); }
        if (lane == 0) { RSQ[tok] = 1.f / sqrtf(s * (1.f / 384.f) + 1e-6f); RSKV[tok] = 1.f / sqrtf(s2 * (1.f / 256.f) + 1e-6f); }
        if (lane < 32) { KR[(size_t)tok * 64 + lane] = f2bf(x1 * cs - x2 * sn); KR[(size_t)tok * 64 + 32 + lane] = f2bf(x1 * sn + x2 * cs); }
        qw[0] = qn[0]; qw[1] = qn[1]; qw[2] = qn[2]; kw = kn2; x1 = x1n; x2 = x2n; cs = csn; sn = snn;
    }
#undef TOK_LOAD
}

__device__ __forceinline__ void gate2(float z, float lbp, float oml, float& lf2, float& hk) {
    const float t = __builtin_amdgcn_exp2f(-fabsf(z) * 1.44269504f), r = __builtin_amdgcn_rcpf(1.f + t), sm = t * r;
    const float sz = z >= 0.f ? r : sm, snz = z >= 0.f ? sm : r;
    lf2 = __builtin_amdgcn_logf(lbp + oml * sz); hk = oml * snz;
}
constexpr int KT_STR = 72;
constexpr int TD_STR = 136;

__device__ void hg1_phase(LAS uchar* lds, const Params& p, int l) {
    COORDS
    const unsigned* ZF32 = (const unsigned*)(p.ws + OFF_R1); const unsigned* HV32 = (const unsigned*)(p.ws + OFF_R2);
    bf16_t* LS = (bf16_t*)(p.ws + OFF_R4); float* DEC = (float*)(p.ws + OFF_DEC); const float* LBT = (const float*)(p.ws + OFF_LBT) + (size_t)l * 3 * 1024;
    LAS bf16_t* Kt = (LAS bf16_t*)lds;
    LAS bf16_t* Vt = (LAS bf16_t*)(lds + 128 * KT_STR * 2);
    LAS float* tot = (LAS float*)(lds + 2 * 128 * KT_STR * 2);
    const int d2 = lane, part = wid;
    unsigned zr[8], vr[8];
    { const int unit = obid(); if (unit < 32 * 128) { const int chunk = unit & 127, bh = unit >> 7, b = bh >> 3, hh = bh & 7; const size_t t0 = (size_t)b * SEQ + chunk * 64 + part * 8;
#pragma unroll
        for (int i = 0; i < 8; ++i) { zr[i] = ZF32[(t0 + i) * 512 + hh * 64 + d2]; vr[i] = HV32[(t0 + i) * 512 + hh * 64 + d2]; } } }
    for (int unit = obid(); unit < 32 * 128; unit += ogdim()) {
        const int bh = unit >> 7, hh = bh & 7;
        const f32x2v lbp = *(const f32x2v*)(LBT + hh * 128 + 2 * d2), oml = *(const f32x2v*)(LBT + 2048 + hh * 128 + 2 * d2);
        unsigned zn[8], vn[8];
        { const int nu = unit + ogdim(); if (nu < 32 * 128) { const int chunk = nu & 127, bh2 = nu >> 7, b = bh2 >> 3, h2 = bh2 & 7; const size_t t0 = (size_t)b * SEQ + chunk * 64 + part * 8;
#pragma unroll
            for (int i = 0; i < 8; ++i) { zn[i] = ZF32[(t0 + i) * 512 + h2 * 64 + d2]; vn[i] = HV32[(t0 + i) * 512 + h2 * 64 + d2]; } } }
        float g0[8], g1[8], k0[8], k1[8]; float run0 = 0.f, run1 = 0.f;
#pragma unroll
        for (int i = 0; i < 8; ++i) { float lf; gate2(h2f(zr[i] & 0xffff), lbp[0], oml[0], lf, k0[i]); run0 += lf; g0[i] = run0; gate2(h2f(zr[i] >> 16), lbp[1], oml[1], lf, k1[i]); run1 += lf; g1[i] = run1; }
        *(LAS f32x2v*)(tot + part * 128 + 2 * d2) = (f32x2v){run0, run1};
        __syncthreads();
        float off0 = 0.f, off1 = 0.f, gc0 = 0.f, gc1 = 0.f;
#pragma unroll
        for (int q = 0; q < 8; ++q) { const f32x2v tq = *(const LAS f32x2v*)(tot + q * 128 + 2 * d2); gc0 += tq[0]; gc1 += tq[1]; if (q < part) { off0 += tq[0]; off1 += tq[1]; } }
        u32x4 kw0, kw1, vw0, vw1;
#pragma unroll
        for (int j = 0; j < 4; ++j) {
            kw0[j] = pk2(k0[2 * j] * __builtin_amdgcn_exp2f(gc0 - (off0 + g0[2 * j])), k0[2 * j + 1] * __builtin_amdgcn_exp2f(gc0 - (off0 + g0[2 * j + 1])));
            kw1[j] = pk2(k1[2 * j] * __builtin_amdgcn_exp2f(gc1 - (off1 + g1[2 * j])), k1[2 * j + 1] * __builtin_amdgcn_exp2f(gc1 - (off1 + g1[2 * j + 1])));
            vw0[j] = (vr[2 * j] & 0xffffu) | (vr[2 * j + 1] << 16); vw1[j] = (vr[2 * j] >> 16) | (vr[2 * j + 1] & 0xffff0000u); }
        *(LAS u32x4*)(Kt + (2 * d2) * KT_STR + part * 8) = kw0; *(LAS u32x4*)(Kt + (2 * d2 + 1) * KT_STR + part * 8) = kw1;
        *(LAS u32x4*)(Vt + (2 * d2) * KT_STR + part * 8) = vw0; *(LAS u32x4*)(Vt + (2 * d2 + 1) * KT_STR + part * 8) = vw1;
        if (part == 0) *(f32x2v*)(DEC + (size_t)unit * 128 + 2 * d2) = (f32x2v){__builtin_amdgcn_exp2f(gc0), __builtin_amdgcn_exp2f(gc1)};
        __syncthreads();
        bf16x8 vb[2];
#pragma unroll
        for (int ks = 0; ks < 2; ++ks) vb[ks] = *(const LAS bf16x8*)(Vt + (wid * 16 + fr) * KT_STR + ks * 32 + fq * 8);
        bf16_t* lsu = LS + (size_t)unit * 16384;
#pragma unroll
        for (int nb = 0; nb < 8; ++nb) { f32x4 a = {0.f, 0.f, 0.f, 0.f};
#pragma unroll
            for (int ks = 0; ks < 2; ++ks) { const bf16x8 ka = *(const LAS bf16x8*)(Kt + (nb * 16 + fr) * KT_STR + ks * 32 + fq * 8); a = __builtin_amdgcn_mfma_f32_16x16x32_bf16(ka, vb[ks], a, 0, 0, 0); }
            *(u32x2*)(lsu + (size_t)(wid * 16 + fr) * 128 + nb * 16 + fq * 4) = pk4(a); }
        __syncthreads();
#pragma unroll
        for (int i = 0; i < 8; ++i) { zr[i] = zn[i]; vr[i] = vn[i]; }
    }
}

__device__ void hg2_phase(const Params& p) {
    bf16_t* LS = (bf16_t*)(p.ws + OFF_R4); const float* DEC = (const float*)(p.ws + OFF_DEC);
    for (int gid = obid() * NTHR + otid(); gid < 32 * 4096; gid += ogdim() * NTHR) {
        const int bh = gid >> 12, e4 = (gid & 4095) * 4, dk = e4 & 127;
        f32x4 S = {0.f, 0.f, 0.f, 0.f};
        for (int c0 = 0; c0 < 128; c0 += 8) {
            u32x2 lw[8]; f32x4 dc[8];
#pragma unroll
            for (int q = 0; q < 8; ++q) { lw[q] = *(const u32x2*)(LS + ((size_t)(bh * 128 + c0 + q) << 14) + e4); dc[q] = *(const f32x4*)(DEC + (size_t)(bh * 128 + c0 + q) * 128 + dk); }
#pragma unroll
            for (int q = 0; q < 8; ++q) { *(u32x2*)(LS + ((size_t)(bh * 128 + c0 + q) << 14) + e4) = pk4(S);
                f32x4 L; L[0] = bf2f(lw[q].x & 0xffff); L[1] = bf2f(lw[q].x >> 16); L[2] = bf2f(lw[q].y & 0xffff); L[3] = bf2f(lw[q].y >> 16);
                S = dc[q] * S + L; }
        }
    }
}

__device__ void hg3_phase(LAS uchar* lds, const Params& p, int l) {
    COORDS
    bf16_t* HQ = (bf16_t*)(p.ws + OFF_R0); const unsigned* HQ32 = (const unsigned*)(p.ws + OFF_R0); const unsigned* ZF32 = (const unsigned*)(p.ws + OFF_R1); const unsigned* HV32 = (const unsigned*)(p.ws + OFF_R2);
    const bf16_t* SG = (const bf16_t*)(p.ws + OFF_R3); const bf16_t* LS = (const bf16_t*)(p.ws + OFF_R4); const float* LBT = (const float*)(p.ws + OFF_LBT) + (size_t)l * 3 * 1024;
    const float* ng = p.hg_ng + (size_t)l * 1024;
    LAS bf16_t* Qt = (LAS bf16_t*)lds;
    LAS bf16_t* Qh = Qt + 64 * TD_STR;
    LAS bf16_t* Kp = Qh + 64 * TD_STR;
    LAS bf16_t* Vt = Kp + 64 * TD_STR;
    LAS bf16_t* Sb = Vt + 128 * KT_STR;
    LAS float* tot = (LAS float*)(Sb + 128 * TD_STR);
    LAS float* ssq = tot + 1024;
    const int d2 = lane, part = wid;
    unsigned zr[8], vr[8], qr[8]; u32x4 sbr[4];
#define HG3_LOAD(U_, Z_, V_, Q_, S_) do { const int chunk_ = (U_) & 127, bh_ = (U_) >> 7, b_ = bh_ >> 3, h_ = bh_ & 7; const size_t t0_ = (size_t)b_ * SEQ + chunk_ * 64 + part * 8; \
        _Pragma("unroll") for (int i_ = 0; i_ < 8; ++i_) { Z_[i_] = ZF32[(t0_ + i_) * 512 + h_ * 64 + d2]; V_[i_] = HV32[(t0_ + i_) * 512 + h_ * 64 + d2]; Q_[i_] = HQ32[(t0_ + i_) * 512 + h_ * 64 + d2]; } \
        const bf16_t* lsu_ = LS + (size_t)(U_) * 16384; _Pragma("unroll") for (int i_ = 0; i_ < 4; ++i_) { const int cid_ = tid + i_ * NTHR; S_[i_] = *(const u32x4*)(lsu_ + (cid_ >> 4) * 128 + (cid_ & 15) * 8); } } while (0)
    if (obid() < 32 * 128) HG3_LOAD(obid(), zr, vr, qr, sbr);
    for (int unit = obid(); unit < 32 * 128; unit += ogdim()) {
        const int chunk = unit & 127, bh = unit >> 7, b = bh >> 3, hh = bh & 7;
        const f32x2v lbp = *(const f32x2v*)(LBT + hh * 128 + 2 * d2), oml = *(const f32x2v*)(LBT + 2048 + hh * 128 + 2 * d2);
        const size_t tokc = (size_t)b * SEQ + chunk * 64;
        { u32x4 vw0, vw1;
#pragma unroll
          for (int j = 0; j < 4; ++j) { vw0[j] = (vr[2 * j] & 0xffffu) | (vr[2 * j + 1] << 16); vw1[j] = (vr[2 * j] >> 16) | (vr[2 * j + 1] & 0xffff0000u); }
          *(LAS u32x4*)(Vt + (2 * d2) * KT_STR + part * 8) = vw0; *(LAS u32x4*)(Vt + (2 * d2 + 1) * KT_STR + part * 8) = vw1;
#pragma unroll
          for (int i = 0; i < 4; ++i) { const int cid = tid + i * NTHR; *(LAS u32x4*)(Sb + (cid >> 4) * TD_STR + (cid & 15) * 8) = sbr[i]; } }
        float g0[8], g1[8], k0[8], k1[8]; float run0 = 0.f, run1 = 0.f;
#pragma unroll
        for (int i = 0; i < 8; ++i) { float lf; gate2(h2f(zr[i] & 0xffff), lbp[0], oml[0], lf, k0[i]); run0 += lf; g0[i] = run0; gate2(h2f(zr[i] >> 16), lbp[1], oml[1], lf, k1[i]); run1 += lf; g1[i] = run1; }
        *(LAS f32x2v*)(tot + part * 128 + 2 * d2) = (f32x2v){run0, run1};
        unsigned qc[8];
#pragma unroll
        for (int i = 0; i < 8; ++i) qc[i] = qr[i];
        const int tb = wid & 3, eh = wid >> 2;
        const size_t trow = (tokc + tb * 16 + fr) * DM + hh * 128;
        u32x2 sgw[4];
#pragma unroll
        for (int mt = 0; mt < 4; ++mt) sgw[mt] = *(const u32x2*)(SG + trow + eh * 64 + mt * 16 + fq * 4);
        { const int nu = unit + ogdim(); if (nu < 32 * 128) HG3_LOAD(nu, zr, vr, qr, sbr); }
        __syncthreads();
        float off0 = 0.f, off1 = 0.f, gr0 = 0.f, gr1 = 0.f;
#pragma unroll
        for (int q = 0; q < 8; ++q) { const f32x2v tq = *(const LAS f32x2v*)(tot + q * 128 + 2 * d2); if (q < 4) { gr0 += tq[0]; gr1 += tq[1]; } if (q < part) { off0 += tq[0]; off1 += tq[1]; } }
#pragma unroll
        for (int i = 0; i < 8; ++i) { const float G0 = off0 + g0[i], G1 = off1 + g1[i]; const float q0 = bf2f(qc[i] & 0xffff), q1 = bf2f(qc[i] >> 16); const int t = part * 8 + i;
            *(LAS unsigned*)(Qt + t * TD_STR + 2 * d2) = pk2(q0 * __builtin_amdgcn_exp2f(fminf(G0 - gr0, 115.f)), q1 * __builtin_amdgcn_exp2f(fminf(G1 - gr1, 115.f)));
            *(LAS unsigned*)(Qh + t * TD_STR + 2 * d2) = pk2(q0 * __builtin_amdgcn_exp2f(G0), q1 * __builtin_amdgcn_exp2f(G1));
            *(LAS unsigned*)(Kp + t * TD_STR + 2 * d2) = pk2(k0[i] * __builtin_amdgcn_exp2f(fminf(gr0 - G0, 115.f)), k1[i] * __builtin_amdgcn_exp2f(fminf(gr1 - G1, 115.f))); }
        __syncthreads();
        f32x4 sc[4];
#pragma unroll
        for (int sb = 0; sb < 4; ++sb) { sc[sb] = (f32x4){0.f, 0.f, 0.f, 0.f};
            if (sb <= tb) {
#pragma unroll
                for (int ks = 0; ks < 4; ++ks) { const bf16x8 ka = *(const LAS bf16x8*)(Kp + (sb * 16 + fr) * TD_STR + ks * 32 + fq * 8), qb = *(const LAS bf16x8*)(Qt + (tb * 16 + fr) * TD_STR + ks * 32 + fq * 8);
                    sc[sb] = __builtin_amdgcn_mfma_f32_16x16x32_bf16(ka, qb, sc[sb], 0, 0, 0); }
                if (sb == tb) {
#pragma unroll
                    for (int j = 0; j < 4; ++j) if (fq * 4 + j > fr) sc[sb][j] = 0.f; } } }
        f32x4 o[4];
#pragma unroll
        for (int mt = 0; mt < 4; ++mt) o[mt] = (f32x4){0.f, 0.f, 0.f, 0.f};
#pragma unroll
        for (int ks = 0; ks < 2; ++ks) { union { bf16x8 v; u32x4 u; } pf; pf.u.x = pk2(sc[2 * ks][0], sc[2 * ks][1]); pf.u.y = pk2(sc[2 * ks][2], sc[2 * ks][3]); pf.u.z = pk2(sc[2 * ks + 1][0], sc[2 * ks + 1][1]); pf.u.w = pk2(sc[2 * ks + 1][2], sc[2 * ks + 1][3]);
            if (2 * ks <= tb) {
#pragma unroll
                for (int mt = 0; mt < 4; ++mt) { const int e = eh * 64 + mt * 16 + fr; union { bf16x8 v; u32x2 h[2]; } vf; vf.h[0] = *(const LAS u32x2*)(Vt + e * KT_STR + (2 * ks) * 16 + fq * 4); vf.h[1] = *(const LAS u32x2*)(Vt + e * KT_STR + (2 * ks + 1) * 16 + fq * 4);
                    o[mt] = __builtin_amdgcn_mfma_f32_16x16x32_bf16(vf.v, pf.v, o[mt], 0, 0, 0); } } }
#pragma unroll
        for (int ks = 0; ks < 4; ++ks) { const bf16x8 qb = *(const LAS bf16x8*)(Qh + (tb * 16 + fr) * TD_STR + ks * 32 + fq * 8);
#pragma unroll
            for (int mt = 0; mt < 4; ++mt) { const bf16x8 sa = *(const LAS bf16x8*)(Sb + (eh * 64 + mt * 16 + fr) * TD_STR + ks * 32 + fq * 8); o[mt] = __builtin_amdgcn_mfma_f32_16x16x32_bf16(sa, qb, o[mt], 0, 0, 0); } }
        float ss = 0.f;
#pragma unroll
        for (int mt = 0; mt < 4; ++mt) ss += (o[mt][0] * o[mt][0] + o[mt][1] * o[mt][1]) + (o[mt][2] * o[mt][2] + o[mt][3] * o[mt][3]);
        ss += __shfl_xor(ss, 16); ss += __shfl_xor(ss, 32);
        if (fq == 0) ssq[eh * 64 + tb * 16 + fr] = ss;
        __syncthreads();
        const float rstd = 1.f / sqrtf((ssq[tb * 16 + fr] + ssq[64 + tb * 16 + fr]) * (1.f / 128.f) + 1e-6f);
#pragma unroll
        for (int mt = 0; mt < 4; ++mt) { const int e = eh * 64 + mt * 16 + fq * 4; const f32x4 gg = *(const f32x4*)(ng + hh * 128 + e); const u32x2 sw = sgw[mt];
            f32x4 r; r[0] = o[mt][0] * rstd * gg[0] * bf2f(sw.x & 0xffff); r[1] = o[mt][1] * rstd * gg[1] * bf2f(sw.x >> 16); r[2] = o[mt][2] * rstd * gg[2] * bf2f(sw.y & 0xffff); r[3] = o[mt][3] * rstd * gg[3] * bf2f(sw.y >> 16);
            *(u32x2*)(HQ + trow + e) = pk4(r); }
        __syncthreads();
    }
#undef HG3_LOAD
}

constexpr float ATT_THR = 30.0f;
constexpr int AK_STR = 400, AV_STR = 136;
constexpr int AK_BYTES = 64 * AK_STR, AV_BYTES = 128 * AV_STR;
__device__ void attn_phase(LAS uchar* lds, const Params& p, bf16_t* obuf) {
    const int tid = otid(), wid = __builtin_amdgcn_readfirstlane(tid >> 6), lane = tid & 63, l32 = lane & 31, half = lane >> 5;
    bf16_t* QN = (bf16_t*)(p.ws + OFF_R1); const bf16_t* QR = (const bf16_t*)(p.ws + OFF_R5); const bf16_t* KN = (const bf16_t*)(p.ws + OFF_R2);
    const bf16_t* VT = (const bf16_t*)(p.ws + OFF_R3); const bf16_t* KR = (const bf16_t*)(p.ws + OFF_KR);
    for (int vb = obid(); vb < 256; vb += ogdim()) {
        const int vid = (vb & 7) * 32 + (vb >> 3);
        const int bh = vid >> 3, jj = vid & 7, b = bh >> 3, hh = bh & 7;
        for (int ui = 0; ui < 4; ++ui) {
            const int qb = ui == 0 ? 31 - jj : (ui == 1 ? 16 + jj : (ui == 2 ? 15 - jj : jj));
            const int q0 = qb * 256, ntiles = 4 * (qb + 1), wlast = 4 * qb + (wid >> 1);
            const size_t tokb = (size_t)b * SEQ; const int qrow = q0 + wid * 32 + l32;
            bf16x8 Q[12];
            { const bf16_t* qn = QN + (tokb + qrow) * DM + hh * 128; const bf16_t* qr = QR + (tokb + qrow) * 512 + hh * 64;
#pragma unroll
              for (int s = 0; s < 8; ++s) Q[s] = *(const bf16x8*)(qn + s * 16 + half * 8);
#pragma unroll
              for (int s = 0; s < 4; ++s) Q[8 + s] = *(const bf16x8*)(qr + s * 16 + half * 8); }
            f32x16 O[4];
#pragma unroll
            for (int mb = 0; mb < 4; ++mb)
#pragma unroll
                for (int i = 0; i < 16; ++i) O[mb][i] = 0.f;
            bool shifted = false;
            float mrun = 0.f, lrun = 0.f;
            u32x4 kreg[3], vreg[2];
            const bf16_t* vtb = VT + ((size_t)(bh * 128) << 13);
            const int akey = tid >> 3, ac8 = tid & 7;
            const unsigned koff = (unsigned)(akey * DM + ac8 * 8) * 2u, roff = (unsigned)(akey * 64 + ac8 * 8) * 2u, voff = (unsigned)((akey << 13) + ac8 * 8) * 2u;
            const int kdst = akey * AK_STR + ac8 * 16, vdst = akey * AV_STR + ac8 * 16;
#define ALOAD(kt_) do { const int kb_ = (kt_) * 64; const char* kbp = (const char*)(KN + (tokb + kb_) * DM + hh * 128); const char* rbp = (const char*)(KR + (tokb + kb_) * 64); const char* vbp2 = (const char*)(vtb + kb_); \
              kreg[0] = *(const u32x4*)(kbp + koff); kreg[1] = *(const u32x4*)(kbp + koff + 128); kreg[2] = *(const u32x4*)(rbp + roff); \
              vreg[0] = *(const u32x4*)(vbp2 + voff); vreg[1] = *(const u32x4*)(vbp2 + voff + (64u << 14)); } while (0)
#define ASTORE(buf_) do { LAS uchar* kb2 = lds + (buf_) * (AK_BYTES + AV_BYTES); LAS uchar* vb2 = kb2 + AK_BYTES; *(LAS u32x4*)(kb2 + kdst) = kreg[0]; *(LAS u32x4*)(kb2 + kdst + 128) = kreg[1]; *(LAS u32x4*)(kb2 + kdst + 256) = kreg[2]; \
              _Pragma("unroll") for (int i_ = 0; i_ < 2; ++i_) { *(LAS u32x2*)(vb2 + vdst + i_ * 64 * AV_STR) = (u32x2){vreg[i_].x, vreg[i_].y}; *(LAS u32x2*)(vb2 + vdst + i_ * 64 * AV_STR + 8) = (u32x2){vreg[i_].z, vreg[i_].w}; } } while (0)
            __syncthreads();
            ALOAD(0); ASTORE(0);
            __syncthreads();
            for (int kt = 0; kt < ntiles; ++kt) {
                const int cur = kt & 1;
                if (kt + 1 < ntiles) ALOAD(kt + 1);
                if (kt <= wlast) {
                    const LAS uchar* kb = lds + cur * (AK_BYTES + AV_BYTES); const LAS uchar* vbp = kb + AK_BYTES;
                    f32x16 s0, s1;
#pragma unroll
                    for (int i = 0; i < 16; ++i) { s0[i] = 0.f; s1[i] = 0.f; }
                    {
                        bf16x8 ka[2][2];
                        const LAS uchar* kp0 = kb + l32 * AK_STR + half * 16; const LAS uchar* kp1 = kp0 + 32 * AK_STR;
                        ka[0][0] = *(const LAS bf16x8*)kp0; ka[0][1] = *(const LAS bf16x8*)kp1;
#pragma unroll
                        for (int st = 0; st < 12; ++st) { if (st + 1 < 12) { ka[(st + 1) & 1][0] = *(const LAS bf16x8*)(kp0 + (st + 1) * 32); ka[(st + 1) & 1][1] = *(const LAS bf16x8*)(kp1 + (st + 1) * 32); }
                            __builtin_amdgcn_sched_barrier(0); __builtin_amdgcn_s_setprio(1);
                            s0 = __builtin_amdgcn_mfma_f32_32x32x16_bf16(ka[st & 1][0], Q[st], s0, 0, 0, 0); s1 = __builtin_amdgcn_mfma_f32_32x32x16_bf16(ka[st & 1][1], Q[st], s1, 0, 0, 0);
                            __builtin_amdgcn_s_setprio(0); __builtin_amdgcn_sched_barrier(0); }
                    }
                    if (kt == wlast) { asm volatile("" ::: "memory");
                        const int kbase = kt * 64 + half * 4;
#pragma unroll
                        for (int i = 0; i < 16; ++i) { const int key = kbase + (i >> 2) * 8 + (i & 3); if (key > qrow) s0[i] = -1e30f; if (key + 32 > qrow) s1[i] = -1e30f; } }
                    float mx = s0[0];
#pragma unroll
                    for (int i = 1; i < 16; ++i) mx = fmaxf(mx, s0[i]);
#pragma unroll
                    for (int i = 0; i < 16; ++i) mx = fmaxf(mx, s1[i]);
                    {
                      typedef unsigned u2_t __attribute__((ext_vector_type(2)));
                      const u2_t sw = __builtin_amdgcn_permlane32_swap(__float_as_uint(mx), __float_as_uint(mx), false, false);
                      mx = fmaxf(__uint_as_float(sw[0]), __uint_as_float(sw[1])); }
                    if (kt == 0 && __builtin_amdgcn_ballot_w64(mx < -ATT_THR) != 0ull) { if (mx < -ATT_THR) mrun = mx; shifted = true; }
                    const float dm = fmaxf(mx - mrun, 0.f);
                    if (__builtin_amdgcn_ballot_w64(dm > ATT_THR) != 0ull) { const float alpha = __builtin_amdgcn_exp2f(-dm); lrun *= alpha; mrun += dm; shifted = true;
#pragma unroll
                        for (int mb = 0; mb < 4; ++mb)
#pragma unroll
                            for (int i = 0; i < 16; ++i) O[mb][i] *= alpha; }
                    if (shifted) {
#pragma unroll
                        for (int i = 0; i < 16; ++i) { s0[i] -= mrun; s1[i] -= mrun; } }
                    float ps = 0.f;
#pragma unroll
                    for (int i = 0; i < 16; ++i) { s0[i] = __builtin_amdgcn_exp2f(s0[i]); s1[i] = __builtin_amdgcn_exp2f(s1[i]); ps += s0[i] + s1[i]; }
                    lrun += ps;
                    {
                        union VF { bf16x8 v; u32x2 h[2]; }; VF vfr[2][2];
                        const LAS uchar* vp0 = vbp + l32 * AV_STR + half * 8;
#define VLOADG(gi_, b_) do { _Pragma("unroll") for (int q_ = 0; q_ < 2; ++q_) { const LAS uchar* vp_ = vp0 + (((gi_) & 1) * 2 + q_) * 32 * AV_STR + ((gi_) >> 1) * 32; vfr[b_][q_].h[0] = *(const LAS u32x2*)vp_; vfr[b_][q_].h[1] = *(const LAS u32x2*)(vp_ + 16); } } while (0)
                        VLOADG(0, 0);
                        union { bf16x8 v; u32x4 u; } pf;
#pragma unroll
                        for (int gi = 0; gi < 8; ++gi) { const int ks = gi >> 1; if (gi + 1 < 8) VLOADG(gi + 1, (gi + 1) & 1);
                            if ((gi & 1) == 0) {
                                if (ks == 0) { pf.u.x = pk2(s0[0], s0[1]); pf.u.y = pk2(s0[2], s0[3]); pf.u.z = pk2(s0[4], s0[5]); pf.u.w = pk2(s0[6], s0[7]); }
                                else if (ks == 1) { pf.u.x = pk2(s0[8], s0[9]); pf.u.y = pk2(s0[10], s0[11]); pf.u.z = pk2(s0[12], s0[13]); pf.u.w = pk2(s0[14], s0[15]); }
                                else if (ks == 2) { pf.u.x = pk2(s1[0], s1[1]); pf.u.y = pk2(s1[2], s1[3]); pf.u.z = pk2(s1[4], s1[5]); pf.u.w = pk2(s1[6], s1[7]); }
                                else { pf.u.x = pk2(s1[8], s1[9]); pf.u.y = pk2(s1[10], s1[11]); pf.u.z = pk2(s1[12], s1[13]); pf.u.w = pk2(s1[14], s1[15]); } }
                            __builtin_amdgcn_sched_barrier(0); __builtin_amdgcn_s_setprio(1);
                            O[(gi & 1) * 2] = __builtin_amdgcn_mfma_f32_32x32x16_bf16(vfr[gi & 1][0].v, pf.v, O[(gi & 1) * 2], 0, 0, 0);
                            O[(gi & 1) * 2 + 1] = __builtin_amdgcn_mfma_f32_32x32x16_bf16(vfr[gi & 1][1].v, pf.v, O[(gi & 1) * 2 + 1], 0, 0, 0);
                            __builtin_amdgcn_s_setprio(0); __builtin_amdgcn_sched_barrier(0); }
#undef VLOADG
                    }
                }
                if (kt + 1 < ntiles) ASTORE(cur ^ 1);
                __syncthreads();
            }
            const float ltot = lrun + __shfl_xor(lrun, 32); const float inv = 1.f / ltot;
            bf16_t* op = obuf + (tokb + qrow) * DM + hh * 128;
#pragma unroll
            for (int mb = 0; mb < 4; ++mb)
#pragma unroll
                for (int g4 = 0; g4 < 4; ++g4) { f32x4 v; v[0] = O[mb][g4 * 4] * inv; v[1] = O[mb][g4 * 4 + 1] * inv; v[2] = O[mb][g4 * 4 + 2] * inv; v[3] = O[mb][g4 * 4 + 3] * inv;
                    *(u32x2*)(op + mb * 32 + g4 * 8 + half * 4) = pk4(v); }
        }
    }
#undef ALOAD
#undef ASTORE
}


#ifdef DIAGSCAN
__global__ void diag_scan_k(float* out, const uchar* ws, unsigned* flagw) {
    const size_t gtid = (size_t)obid() * blockDim.x + threadIdx.x, gsz = (size_t)ogdim() * blockDim.x;
    const unsigned short* ZF = (const unsigned short*)(ws + OFF_R1); const bf16_t* HVb = (const bf16_t*)(ws + OFF_R2); const bf16_t* LSb = (const bf16_t*)(ws + OFF_R4); const float* LBT = (const float*)(ws + OFF_LBT);
    float me = 0.f, mr = 0.f;
    for (size_t i = gtid; i < 16384; i += gsz) { const int unit = (int)((i * 7919) % 4096), dv = (int)((i * 31) % 128), dk = (int)((i * 17) % 128);
        const int chunk = unit & 127, bh = unit >> 7, b = bh >> 3, hh = bh & 7; const float la = LBT[hh * 128 + dk], lc = LBT[1024 + hh * 128 + dk], oml = LBT[2048 + hh * 128 + dk];
        const size_t tok0 = (size_t)b * SEQ + chunk * 64; float gcv = 0.f;
        for (int t = 0; t < 64; ++t) gcv += logf_gate(h2f(ZF[(tok0 + t) * DM + hh * 128 + dk]), la, lc);
        float G = 0.f, acc = 0.f;
        for (int t = 0; t < 64; ++t) { const float z = h2f(ZF[(tok0 + t) * DM + hh * 128 + dk]); G += logf_gate(z, la, lc); const float kt = oml / (1.f + __expf(z)) * __expf(gcv - G);
            acc += kt * __uint_as_float((unsigned)HVb[(tok0 + t) * DM + hh * 128 + dv] << 16); }
        const float got = __uint_as_float((unsigned)LSb[(size_t)unit * 16384 + dv * 128 + dk] << 16); me = fmaxf(me, fabsf(got - acc)); mr = fmaxf(mr, fabsf(acc)); }
    atomicMax(flagw + 2, __float_as_uint(me)); atomicMax(flagw + 3, __float_as_uint(mr));
}
__global__ void diag_fin_k(float* out, const unsigned* flagw) {
    const size_t gtid = (size_t)obid() * blockDim.x + threadIdx.x, gsz = (size_t)ogdim() * blockDim.x;
    const float mev = __uint_as_float(flagw[2]), mxv = __uint_as_float(flagw[3]);
    const float A = 10.f + fminf(89.f, fmaxf(0.f, rintf(log2f(fmaxf(mev, 1e-6f)) + 20.f)));
    const int k = (int)fminf(15.f, fmaxf(0.f, floorf(log2f(fmaxf(mxv, 1e-3f))) + 5.f));
    float c = 10.f; for (int i = 0; i < k; ++i) c *= 1.3f;
    const float mn = 0.f;
    (void)mn;
    for (size_t i = gtid; i < (size_t)T * DM; i += gsz) out[i] = (i == 0) ? A * 1e4f : c;
}
#endif
#define XB_TMO      128
#define XB_XCNT(j)  (256  + 64 * (j))
#define XB_XSUB(j)  (1280 + 64 * (j))
#define XB_XGEN(j)  (2304 + 64 * (j))
#define XB_TOP      3328
#define XB_TOPGEN   3392
#define XCD_BAR_WORDS 3456
#define XB_SPIN_CAP (1u << 18)

__device__ __forceinline__ unsigned xb_ld(unsigned* p)              { return __hip_atomic_load(p, __ATOMIC_RELAXED, __HIP_MEMORY_SCOPE_AGENT); }
__device__ __forceinline__ unsigned xb_add(unsigned* p, unsigned v) { return __hip_atomic_fetch_add(p, v, __ATOMIC_RELAXED, __HIP_MEMORY_SCOPE_AGENT); }
__device__ __forceinline__ unsigned xb_xcc_id() { return (unsigned)__builtin_amdgcn_s_getreg((3 << 11) | 20) & 0xFu; }
#define XB_SPIN(cond, bar) do { unsigned _sp = 0; while (cond) { __builtin_amdgcn_s_sleep(1); \
    if ((++_sp & 255u) == 0u) { if (xb_ld(&(bar)[XB_TMO])) break; if (_sp > XB_SPIN_CAP) { atomicAdd(&(bar)[XB_TMO], 1u); break; } } } } while (0)

struct XcdBarrier {
    unsigned* bar; unsigned x;
    volatile LAS unsigned* st;
};

__device__ __forceinline__ XcdBarrier xcd_barrier_post(unsigned* bar, volatile LAS unsigned* st) {
    XcdBarrier b; b.bar = bar; b.x = xb_xcc_id(); b.st = st;
    if (threadIdx.x == 0) (void)xb_add(&bar[XB_XCNT(b.x)], 1u);
    return b;
}
__device__ __forceinline__ void xcd_barrier_complete(unsigned* bar, unsigned x, unsigned& nloc, unsigned& nx) {
    const unsigned G = ogdim() * gridDim.y * gridDim.z;
    unsigned sum, cnt, mine, sp = 0u;
    for (;;) {
        sum = 0u; cnt = 0u; mine = 0u;
#pragma unroll
        for (unsigned j = 0; j < 16; ++j) { const unsigned c = xb_ld(&bar[XB_XCNT(j)]); sum += c; cnt += (c > 0u) ? 1u : 0u; mine = (j == x) ? c : mine; }
        if (sum == G) break;
        __builtin_amdgcn_s_sleep(1);
        if ((++sp & 255u) == 0u) { if (xb_ld(&bar[XB_TMO])) break; if (sp > XB_SPIN_CAP) { atomicAdd(&bar[XB_TMO], 1u); break; } }
    }
    nloc = mine > 0u ? mine : 1u; nx = cnt > 0u ? cnt : 1u;
}

__device__ __forceinline__ void xcd_barrier(const XcdBarrier& b) {
    asm volatile("s_waitcnt vmcnt(0)" ::: "memory");
    __syncthreads();
    if (threadIdx.x == 0) {
        unsigned* bar = b.bar;
        __builtin_amdgcn_s_waitcnt(0);
        unsigned nloc = b.st[0], nx = b.st[1];
        if (nloc == 0u) { xcd_barrier_complete(bar, b.x, nloc, nx); b.st[0] = nloc; b.st[1] = nx; }
        const unsigned old = xb_add(&bar[XB_XSUB(b.x)], 1u);
        const unsigned gen = old / nloc;
        if (old + 1u == (gen + 1u) * nloc) {
            __builtin_amdgcn_fence(__ATOMIC_RELEASE, "agent");
            asm volatile("s_waitcnt vmcnt(0)" ::: "memory");
            const unsigned og = xb_add(&bar[XB_TOP], 1u);
            const unsigned tg = og / nx;
            if (og + 1u == (tg + 1u) * nx) xb_add(&bar[XB_TOPGEN], 1u);
            else XB_SPIN(xb_ld(&bar[XB_TOPGEN]) == tg, bar);
            __builtin_amdgcn_fence(__ATOMIC_ACQUIRE, "agent");
            xb_add(&bar[XB_XGEN(b.x)], 1u);
            asm volatile("s_waitcnt vmcnt(0)" ::: "memory");
        } else {
            XB_SPIN(xb_ld(&bar[XB_XGEN(b.x)]) == gen, bar);
            __builtin_amdgcn_fence(__ATOMIC_ACQUIRE, "agent");
            asm volatile("s_waitcnt vmcnt(0)" ::: "memory");
        }
    }
    __syncthreads();
}

constexpr int LDS_BYTES = 8 * HTB + 64;
constexpr size_t OFF_BAR = OFF_LBT + 48 * 1024;
constexpr int NPHASE = 2 + 15 * NL;
#ifndef PH_HI
#define PH_HI NPHASE
#endif
#ifndef PH_MASK
#define PH_MASK 0x1FFFF
#endif

__global__ void __launch_bounds__(NTHR) mega(Params p_in) {
    extern __shared__ __attribute__((aligned(16))) uchar smem[];
    LAS uchar* lds = (LAS uchar*)smem;
    cg::grid_group grid = cg::this_grid();
    volatile LAS unsigned* xst = (volatile LAS unsigned*)(lds + 8 * HTB);
    if (threadIdx.x < 2) xst[threadIdx.x] = 0u;
    __syncthreads();
    (void)xcd_barrier_post((unsigned*)(p_in.ws + OFF_BAR), xst);
    const int nM = T / 256;
    for (int ph = p_in.ph_lo; ph < p_in.ph_hi; ++ph) {
        Params p = p_in; asm volatile("" : "+s"(p.ws), "+s"(p.out));
        uchar* ws = p.ws; float* ADA = (float*)(ws + OFF_ADA); bf16_t* U = (bf16_t*)(ws + OFF_U); bf16_t* HID = (bf16_t*)(ws + OFF_R0);
        if (ph == 0) { if constexpr (PH_MASK & 1) { p0a(lds, p); conv_layer(lds, p, 0, obid(), ogdim()); } }
        else if (ph == 1) { if constexpr (PH_MASK & 2) ln_pass(p, p.x, p.out, U, nullptr, nullptr, ADA, 1, 0, false, true, false); }
        else {
            const int l = (ph - 2) / 15, sub = (ph - 2) % 15;
            const bf16_t* W = (const bf16_t*)(ws + OFF_W + (size_t)(l & 1) * WSZ);
            const float* adal = ADA + (size_t)l * 4 * 9216;
            switch (sub) {
            case 0: if constexpr ((PH_MASK >> 2) & 1) { EpiGU E{HID}; gemm_run2<EpiGU>(lds, U, W + W_GU1, nM, 22, DM, E); } break;
            case 1: if constexpr ((PH_MASK >> 3) & 1) { const float* onz = (const float*)(ws + OFF_ONES); EpiRes E{p.out, adal + 2 * 1024, 0.5f, (const float*)(ws + OFF_STATS), l ? p.ln_g + (size_t)(l * 3 - 1) * DM : onz, l ? p.ln_b + (size_t)(l * 3 - 1) * DM : onz + 1024, l ? p.out : p.x}; gemm_run2<EpiRes>(lds, HID, W + W_D1, nM, 4, FF, E); } break;
            case 2: if constexpr ((PH_MASK >> 4) & 1) ln_pass2(p, p.out, nullptr, U, p.ln_g + (size_t)(l * 3 + 0) * DM, p.ln_b + (size_t)(l * 3 + 0) * DM, adal, 4, 3); break;
            case 3: if constexpr ((PH_MASK >> 5) & 1) { EpiWin1 E{(bf16_t*)(ws + OFF_R0), (bf16_t*)(ws + OFF_R2), (bf16_t*)(ws + OFF_R3), (bf16_t*)(ws + OFF_CQ), (bf16_t*)(ws + OFF_CKV), (unsigned short*)(ws + OFF_R1), (float*)(ws + OFF_KRRAW)};
                      gemm_run2<EpiWin1>(lds, U, W + W_IN, nM, 19, DM, E); } break;
            case 4: if constexpr ((PH_MASK >> 6) & 1) { hg1_phase(lds, p, l); tok_pass(p); } break;
            case 5: if constexpr ((PH_MASK >> 7) & 1) { hg2_phase(p); if (l + 1 < NL) conv_layer(lds, p, l + 1, obid(), ogdim()); } break;
            case 6: if constexpr ((PH_MASK >> 8) & 1) hg3_phase(lds, p, l); break;
            case 7: if constexpr ((PH_MASK >> 9) & 1) { EpiQ Eq{(bf16_t*)(ws + OFF_R1), (bf16_t*)(ws + OFF_R5), (const float*)(ws + OFF_RSQ), (const float*)(ws + OFF_COS), (const float*)(ws + OFF_SIN)};
                      gemm_run2<EpiQ>(lds, (const bf16_t*)(ws + OFF_CQ), W + W_UQ, nM, 6, 384, Eq);
                      EpiKn Ek{(bf16_t*)(ws + OFF_R2), (const float*)(ws + OFF_RSKV)};
                      gemm_run2<EpiKn>(lds, (const bf16_t*)(ws + OFF_CKV), W + W_UKV, nM, 4, 256, Ek);
                      EpiV Ev{(bf16_t*)(ws + OFF_R3), (const float*)(ws + OFF_RSKV)};
                      gemm_run<EpiV, false>(lds, (const bf16_t*)(ws + OFF_CKV), W + W_UKV + (size_t)1024 * 256, nM, 4, 256, Ev);
                      EpiGate Eg{(unsigned short*)(ws + OFF_R4), (unsigned short*)(ws + OFF_R4 + 64 * MB)};
                      gemm_run2<EpiGate>(lds, U, W + W_IN + (size_t)4800 * DM, nM, 8, DM, Eg); } break;
            case 8: if constexpr ((PH_MASK >> 10) & 1) {
#ifdef ATTN_TWICE
                for (int rep = 0; rep < p.ph_lo + 2; ++rep) { attn_phase(lds, p, (bf16_t*)(ws + (rep == 0 ? OFF_U : OFF_R1))); __syncthreads(); }
#else
                attn_phase(lds, p, (bf16_t*)(ws + OFF_R1));
#endif
                } break;
            case 9: if constexpr ((PH_MASK >> 11) & 1) { EpiM1 E1{(bf16_t*)(ws + OFF_R5), (const unsigned short*)(ws + OFF_R4)};
                      gemm_run2<EpiM1>(lds, (const bf16_t*)(ws + OFF_R0), W + W_BH, nM, 4, DM, E1);
                      EpiM2 E2{(const bf16_t*)(ws + OFF_R5), (const unsigned short*)(ws + OFF_R4 + 64 * MB), U};
                      gemm_run2<EpiM2>(lds, (const bf16_t*)(ws + OFF_R1), W + W_BM, nM, 4, DM, E2); } break;
            case 10: if constexpr ((PH_MASK >> 12) & 1) { EpiRes E{p.out, adal + 5 * 1024, 1.0f, (const float*)(ws + OFF_STATS), p.ln_g + (size_t)(l * 3 + 0) * DM, p.ln_b + (size_t)(l * 3 + 0) * DM, p.out}; gemm_run2<EpiRes>(lds, U, W + W_OUT, nM, 4, DM, E); } break;
            case 11: if constexpr ((PH_MASK >> 13) & 1) ln_pass2(p, p.out, nullptr, U, p.ln_g + (size_t)(l * 3 + 1) * DM, p.ln_b + (size_t)(l * 3 + 1) * DM, adal, 7, 6); break;
            case 12: if constexpr ((PH_MASK >> 14) & 1) { EpiGU E{HID}; gemm_run2<EpiGU>(lds, U, W + W_GU2, nM, 22, DM, E); } break;
            case 13: if constexpr ((PH_MASK >> 15) & 1) { EpiRes E{p.out, adal + 8 * 1024, 0.5f, (const float*)(ws + OFF_STATS), p.ln_g + (size_t)(l * 3 + 1) * DM, p.ln_b + (size_t)(l * 3 + 1) * DM, p.out}; gemm_run2<EpiRes>(lds, HID, W + W_D2, nM, 4, FF, E); } break;
            default: if constexpr ((PH_MASK >> 16) & 1) ln_pass2(p, p.out, l + 1 == NL ? p.out : nullptr, U, p.ln_g + (size_t)(l * 3 + 2) * DM, p.ln_b + (size_t)(l * 3 + 2) * DM, adal + 4 * 9216, 1, 0); break;
            }
        }
        if (ph + 1 < p_in.ph_hi) { if (ph == p_in.ph_lo) grid.sync(); else { XcdBarrier xb2; xb2.bar = (unsigned*)(p.ws + OFF_BAR); xb2.x = xb_xcc_id(); xb2.st = (volatile LAS unsigned*)(lds + 8 * HTB); xcd_barrier(xb2); } }
    }
}

extern "C" void kernel_launch(void* const* d_in, const int* in_sizes, int n_in, void* d_out, int out_size, void* d_ws, size_t ws_size, hipStream_t stream) {
    static int grid = 0;
    if (grid == 0) {
        if (n_in != 23 || ws_size < WS_END) { fprintf(stderr, "kernel_launch: n_in %d ws %zu (need %zu)\n", n_in, ws_size, (size_t)WS_END); grid = -1; return; }
        int dev = 0, cus = 0, per_cu = 0;
        hipGetDevice(&dev); hipDeviceGetAttribute(&cus, hipDeviceAttributeMultiprocessorCount, dev);
        if (hipFuncSetAttribute((const void*)mega, hipFuncAttributeMaxDynamicSharedMemorySize, LDS_BYTES) != hipSuccess) { fprintf(stderr, "kernel_launch: hipFuncSetAttribute failed\n"); grid = -1; return; }
        hipOccupancyMaxActiveBlocksPerMultiprocessor(&per_cu, (const void*)mega, NTHR, LDS_BYTES);
        if (per_cu < 1) { fprintf(stderr, "kernel_launch: occupancy query says %d\n", per_cu); per_cu = 1; }
        (void)hipGetLastError();
        grid = cus;
    }
    if (grid < 0) return;
    Params p{};
    p.x = (const float*)d_in[0]; p.c = (const float*)d_in[1]; p.pos = (const int*)d_in[2];
    p.ada_w = (const float*)d_in[3]; p.ada_b = (const float*)d_in[4]; p.ln_g = (const float*)d_in[5]; p.ln_b = (const float*)d_in[6];
    p.f1g = (const float*)d_in[7]; p.f1u = (const float*)d_in[8]; p.f1d = (const float*)d_in[9]; p.w_in = (const float*)d_in[10];
    p.hg_lb = (const float*)d_in[11]; p.hg_ng = (const float*)d_in[12]; p.qng = (const float*)d_in[13]; p.w_uq = (const float*)d_in[14];
    p.kvng = (const float*)d_in[15]; p.w_ukv = (const float*)d_in[16]; p.w_bh = (const float*)d_in[17]; p.w_bm = (const float*)d_in[18];
    p.w_out = (const float*)d_in[19]; p.f2g = (const float*)d_in[20]; p.f2u = (const float*)d_in[21]; p.f2d = (const float*)d_in[22];
    p.out = (float*)d_out; p.ws = (uchar*)d_ws; p.ph_lo = 0; p.ph_hi = PH_HI;
    (void)hipMemsetAsync((uchar*)d_ws + OFF_BAR, 0, XCD_BAR_WORDS * 4, stream);
    void* args[] = {&p};
    hipError_t e = hipLaunchCooperativeKernel((const void*)mega, dim3(grid), dim3(NTHR), args, LDS_BYTES, stream);
    if (e != hipSuccess) fprintf(stderr, "cooperative launch failed: %s (grid %d)\n", hipGetErrorString(e), grid);
#ifdef DIAGSCAN
    unsigned* flagw = (unsigned*)((uchar*)d_ws + OFF_LBT + 60 * 1024);
    (void)hipMemsetAsync(flagw, 0, 64, stream);
    diag_scan_k<<<2048, 256, 0, stream>>>((float*)d_out, (const uchar*)d_ws, flagw);
    diag_fin_k<<<2048, 256, 0, stream>>>((float*)d_out, flagw);
#endif
}
```

```cpp
#include <hip/hip_runtime.h>
#include <hip/hip_cooperative_groups.h>
#include <cstdio>
#include <cstdint>
namespace cg = cooperative_groups;

#define LAS __attribute__((address_space(3)))
typedef unsigned short bf16_t;
typedef unsigned char uchar;
typedef short bf16x8 __attribute__((ext_vector_type(8)));
typedef float f32x4 __attribute__((ext_vector_type(4)));
typedef float f32x16 __attribute__((ext_vector_type(16)));
typedef unsigned u32x4 __attribute__((ext_vector_type(4)));
typedef unsigned u32x2 __attribute__((ext_vector_type(2)));
typedef float f32x2v __attribute__((ext_vector_type(2)));

constexpr int T = 32768, SEQ = 8192, DM = 1024, FF = 2816, NL = 4;
constexpr float DN_ALPHA = 1.681792830507429f;
constexpr float QSCALE = 0.10411754627697264f;
constexpr int NTHR = 512;

constexpr size_t MB = 1ull << 20;
constexpr size_t OFF_ADA = 0;
constexpr size_t OFF_COS = 1 * MB;
constexpr size_t OFF_SIN = OFF_COS + 4 * MB;
constexpr size_t OFF_LBT = OFF_SIN + 4 * MB;
constexpr size_t OFF_RSQ = OFF_LBT + 64 * 1024;
constexpr size_t OFF_RSKV = OFF_RSQ + 128 * 1024;
constexpr size_t OFF_DEC = OFF_RSKV + 128 * 1024;
constexpr size_t OFF_KRRAW = OFF_DEC + 2 * MB;
constexpr size_t OFF_KR = OFF_KRRAW + 8 * MB;
constexpr size_t OFF_W = OFF_KR + 4 * MB;
constexpr size_t WSZ = 57147392ull;
constexpr size_t W_GU1 = 0, W_D1 = 5767168, W_IN = 8650752, W_UQ = 15663104, W_UKV = 16252928, W_BH = 16777216, W_BM = 17825792,
                 W_OUT = 18874368, W_GU2 = 19922944, W_D2 = 25690112;
constexpr size_t OFF_U = OFF_W + 2 * WSZ;
constexpr size_t OFF_BIG = OFF_U + 64 * MB;
constexpr size_t OFF_R0 = OFF_BIG;
constexpr size_t OFF_R1 = OFF_R0 + 64 * MB;
constexpr size_t OFF_R2 = OFF_R1 + 64 * MB;
constexpr size_t OFF_R3 = OFF_R2 + 64 * MB;
constexpr size_t OFF_R4 = OFF_R3 + 64 * MB;
constexpr size_t OFF_R5 = OFF_R4 + 128 * MB;
constexpr size_t OFF_CQ = OFF_R5 + 32 * MB;
constexpr size_t OFF_CKV = OFF_CQ + 24 * MB;
constexpr size_t OFF_STATS = OFF_CKV + 16 * MB;
constexpr size_t OFF_ONES = OFF_STATS + 256 * 1024;
constexpr size_t WS_END = OFF_ONES + 8 * 1024;

struct Params {
    const float *x, *c; const int* pos;
    const float *ada_w, *ada_b, *ln_g, *ln_b, *f1g, *f1u, *f1d, *w_in, *hg_lb, *hg_ng, *qng, *w_uq, *kvng, *w_ukv, *w_bh, *w_bm, *w_out, *f2g, *f2u, *f2d;
    float* out; uchar* ws; int ph_lo, ph_hi;
};

#define DS0 OFF_R0
#define DM0 0x7f80u
#define DS1 OFF_R1
#define DM1 0x7c00u
#define DS2 OFF_R2
#define DM2 0x7f80u
#define DS3 OFF_R3
#define DM3 0x7f80u
#define DS4 OFF_R4
#define DM4 0x7f80u
#define DS5 (OFF_R4 + 64 * MB)
#define DM5 0x7f80u
typedef __bf16 bf16v2_t __attribute__((ext_vector_type(2)));
typedef float f32x2_t __attribute__((ext_vector_type(2)));
__device__ __forceinline__ unsigned pk2(float lo, float hi) { const f32x2_t v = {lo, hi}; const bf16v2_t r = __builtin_convertvector(v, bf16v2_t); return __builtin_bit_cast(unsigned, r); }
__device__ __forceinline__ bf16_t f2bf(float f) { return (bf16_t)(pk2(f, 0.f) & 0xffffu); }
__device__ __forceinline__ float bf2f(unsigned v) { return __uint_as_float(v << 16); }
__device__ __forceinline__ float sigm(float x) { return __builtin_amdgcn_rcpf(1.f + __expf(-x)); }
__device__ __forceinline__ float siluf(float x) { return x * sigm(x); }
__device__ __forceinline__ unsigned short f2h(float f) { _Float16 h = (_Float16)f; return __builtin_bit_cast(unsigned short, h); }
__device__ __forceinline__ float h2f(unsigned short v) { return (float)__builtin_bit_cast(_Float16, v); }
__device__ __forceinline__ unsigned pkh2(float lo, float hi) { return (unsigned)f2h(lo) | ((unsigned)f2h(hi) << 16); }
__device__ __forceinline__ u32x2 pk4(f32x4 v) { u32x2 w; w.x = pk2(v[0], v[1]); w.y = pk2(v[2], v[3]); return w; }

__device__ __forceinline__ int otid() { int w = __builtin_amdgcn_readfirstlane((int)(threadIdx.x >> 6)); asm volatile("" : "+s"(w)); int t = w * 64 + (int)__builtin_amdgcn_mbcnt_hi(~0u, __builtin_amdgcn_mbcnt_lo(~0u, 0u)); asm volatile("" : "+v"(t)); return t; }
__device__ __forceinline__ int obid() { int b = blockIdx.x; asm volatile("" : "+s"(b)); return b; }
__device__ __forceinline__ int ogdim() { int g = gridDim.x; asm volatile("" : "+s"(g)); return g; }
#define COORDS const int tid = otid(), wid = __builtin_amdgcn_readfirstlane(tid >> 6), lane = tid & 63, wr = wid >> 2, wc = wid & 3, fr = lane & 15, fq = lane >> 4; (void)lane; (void)wr; (void)wc; (void)fr; (void)fq;

constexpr int BK = 64, HALF = 128, HTB = HALF * BK * 2;
__device__ __forceinline__ int lds_byte(int r, int c) { const int st = (r >> 4) * 2 + (c >> 5), rr = r & 15, cc = c & 31, ob = rr * 64 + cc * 2; return st * 1024 + (ob ^ (((ob >> 9) & 1) << 5)); }
__device__ __forceinline__ void stage_rc(int b, int& R, int& C) { const int st = b / 1024, sb = b % 1024, swz = sb ^ (((sb >> 9) & 1) << 5); R = (st >> 1) * 16 + swz / 64; C = (st & 1) * 32 + (swz % 64) / 2; }

template <bool SWAP>
__device__ __forceinline__ void gemm_kloop(LAS uchar* lds, const char* cA, const char* cB, int K, f32x4 (&acc)[2][2][4][2]) {
    COORDS
    const int nt = K / BK;
    unsigned voff[2];
#pragma unroll
    for (int i = 0; i < 2; ++i) { int R, C; stage_rc(tid * 16 + i * 8192, R, C); voff[i] = (unsigned)(R * K + C) * 2u; }
    const size_t kstep = (size_t)(BK * 2), hstep = (size_t)HALF * K * 2;
    const unsigned ldsw = (unsigned)wid * 1024u;
    const int aoff = lds_byte(wr * 64 + fr, fq * 8), boff = lds_byte(wc * 32 + fr, fq * 8);
#define SA(b, h) (((b) * 2 + (h)) * HTB)
#define SB(b, h) ((4 + (b) * 2 + (h)) * HTB)
#define STAGE(bufoff, gbase) do { _Pragma("unroll") for (int _i = 0; _i < 2; ++_i) \
        __builtin_amdgcn_global_load_lds((const unsigned*)((const char*)(gbase) + voff[_i]), (LAS unsigned*)(lds + (bufoff) + ldsw + _i * 8192), 16, 0, 0); } while (0)
#define LDA(dst, b, h) do { _Pragma("unroll") for (int m = 0; m < 4; ++m) _Pragma("unroll") for (int k = 0; k < 2; ++k) dst[m][k] = *(const LAS bf16x8*)(lds + SA(b, h) + aoff + m * 2048 + k * 1024); } while (0)
#define LDB(dst, b, h) do { _Pragma("unroll") for (int n = 0; n < 2; ++n) _Pragma("unroll") for (int k = 0; k < 2; ++k) dst[n][k] = *(const LAS bf16x8*)(lds + SB(b, h) + boff + n * 2048 + k * 1024); } while (0)
#define MMA(ai, bj, At, Bt) do { __builtin_amdgcn_s_setprio(1); _Pragma("unroll") for (int m = 0; m < 4; ++m) _Pragma("unroll") for (int n = 0; n < 2; ++n) _Pragma("unroll") for (int k = 0; k < 2; ++k) \
        acc[ai][bj][m][n] = SWAP ? __builtin_amdgcn_mfma_f32_16x16x32_bf16(Bt[n][k], At[m][k], acc[ai][bj][m][n], 0, 0, 0) \
                                 : __builtin_amdgcn_mfma_f32_16x16x32_bf16(At[m][k], Bt[n][k], acc[ai][bj][m][n], 0, 0, 0); __builtin_amdgcn_s_setprio(0); } while (0)
#define WAIT_V(n) asm volatile("s_waitcnt vmcnt(" #n ")" ::: "memory")
#define WAIT_L(n) asm volatile("s_waitcnt lgkmcnt(" #n ")" ::: "memory")
#define BAR __builtin_amdgcn_s_barrier()
#define SCHED __builtin_amdgcn_sched_barrier(0)
    bf16x8 At[4][2], B0[2][2], B1[2][2];
    STAGE(SB(0, 0), cB); STAGE(SA(0, 0), cA); STAGE(SB(0, 1), cB + hstep); STAGE(SA(0, 1), cA + hstep);
    if (wr == 1) BAR;
    WAIT_V(4); BAR;
    STAGE(SB(1, 0), cB + kstep); STAGE(SA(1, 0), cA + kstep); STAGE(SB(1, 1), cB + hstep + kstep);
    WAIT_V(6); BAR;
    for (int t = 0; t < nt - 2; t += 2) {
        const char* a1 = cA + (size_t)(t + 1) * kstep;
        const char* a2 = cA + (size_t)(t + 2) * kstep; const char* b2 = cB + (size_t)(t + 2) * kstep;
        const char* a3 = a2 + kstep; const char* b3 = b2 + kstep;
        LDB(B0, 0, 0); SCHED; LDA(At, 0, 0); STAGE(SA(1, 1), a1 + hstep);
        WAIT_L(8); BAR; WAIT_L(0); MMA(0, 0, At, B0); BAR; SCHED;
        LDB(B1, 0, 1); STAGE(SB(0, 0), b2);
        BAR; WAIT_L(0); MMA(0, 1, At, B1); BAR;
        LDA(At, 0, 1); STAGE(SA(0, 0), a2);
        BAR; WAIT_L(0); MMA(1, 0, At, B0); BAR; SCHED;
        STAGE(SB(0, 1), b2 + hstep);
        WAIT_V(6); BAR; MMA(1, 1, At, B1); BAR;
        LDB(B0, 1, 0); SCHED; LDA(At, 1, 0); STAGE(SA(0, 1), a2 + hstep);
        WAIT_L(8); BAR; WAIT_L(0); MMA(0, 0, At, B0); BAR; SCHED;
        LDB(B1, 1, 1); STAGE(SB(1, 0), b3);
        BAR; WAIT_L(0); MMA(0, 1, At, B1); BAR;
        LDA(At, 1, 1); STAGE(SA(1, 0), a3);
        BAR; WAIT_L(0); MMA(1, 0, At, B0); BAR; SCHED;
        STAGE(SB(1, 1), b3 + hstep);
        WAIT_V(6); BAR; MMA(1, 1, At, B1); BAR;
    }
    { LDB(B0, 0, 0); LDA(At, 0, 0); STAGE(SA(1, 1), cA + (size_t)(nt - 1) * kstep + hstep);
      BAR; WAIT_L(0); MMA(0, 0, At, B0); BAR;
      LDB(B1, 0, 1); BAR; WAIT_L(0); MMA(0, 1, At, B1); BAR;
      LDA(At, 0, 1); WAIT_V(4); BAR; WAIT_L(0); MMA(1, 0, At, B0); MMA(1, 1, At, B1); BAR; }
    { LDB(B0, 1, 0); LDA(At, 1, 0); WAIT_V(2); BAR; WAIT_L(0); MMA(0, 0, At, B0); BAR;
      LDB(B1, 1, 1); WAIT_V(0); BAR; WAIT_L(0); MMA(0, 1, At, B1); BAR;
      LDA(At, 1, 1); BAR; WAIT_L(0); MMA(1, 0, At, B0); MMA(1, 1, At, B1); BAR; }
    if (wr == 0) BAR;
#undef SA
#undef SB
#undef STAGE
#undef LDA
#undef LDB
#undef MMA
}

__device__ __forceinline__ void unit_map(int L, int nM, int nN, int& pm, int& pn) {
    const int nwg = nM * nN; int wgid = L;
    { const int q = nwg / 8, r = nwg % 8, xcd = wgid % 8, off = wgid / 8; wgid = (xcd < r ? xcd * (q + 1) : r * (q + 1) + (xcd - r) * q) + off; }
    const int nig = 8 * nN, gid = wgid / nig, fm = gid * 8, gsz = (nM - fm) < 8 ? (nM - fm) : 8;
    pm = fm + ((wgid % nig) % gsz); pn = (wgid % nig) / gsz;
}

#define ZERO_ACC(acc) _Pragma("unroll") for (int a_ = 0; a_ < 2; ++a_) _Pragma("unroll") for (int b_ = 0; b_ < 2; ++b_) _Pragma("unroll") for (int m_ = 0; m_ < 4; ++m_) _Pragma("unroll") for (int n_ = 0; n_ < 2; ++n_) acc[a_][b_][m_][n_] = (f32x4){0.f, 0.f, 0.f, 0.f};

template <class Epi, bool SWAP>
__device__ __forceinline__ void gemm_run(LAS uchar* lds, const bf16_t* A, const bf16_t* Bt, int nM, int nN, int K, const Epi& E) {
    const int G = ogdim(), c = obid(), nwg = nM * nN;
    for (int i = 0;; ++i) {
        const long L = (long)i * G + c; if (L >= nwg) break;
        int pm, pn; unit_map((int)L, nM, nN, pm, pn);
        f32x4 acc[2][2][4][2]; ZERO_ACC(acc)
        asm volatile("s_waitcnt vmcnt(0)" ::: "memory");
        gemm_kloop<SWAP>(lds, (const char*)(A + (size_t)pm * 256 * K), (const char*)(Bt + (size_t)pn * 256 * K), K, acc);
        E(acc, pm, pn);
    }
}

namespace pg8 {
#define PG8_LAS __attribute__((address_space(3)))
typedef unsigned short bf16_t;
typedef short bf16x8 __attribute__((ext_vector_type(8)));
typedef float f32x4 __attribute__((ext_vector_type(4)));
typedef unsigned u32x4 __attribute__((ext_vector_type(4)));
constexpr int BM = 256, BK = 64, HALF = 128, HTB = HALF * BK * 2  , STAGE_BYTES = 8 * HTB, NXCD = 8, WGM = 8;

__host__ __device__ __forceinline__ int lds_byte(int r, int c) { const int st = (r >> 4) * 2 + (c >> 5), rr = r & 15, cc = c & 31, ob = rr * 64 + cc * 2; return st * 1024 + (ob ^ (((ob >> 9) & 1) << 5)); }
__host__ __device__ __forceinline__ void stage_rc(int b, int& R, int& C) { const int st = b / 1024, sb = b % 1024, swz = sb ^ (((sb >> 9) & 1) << 5); R = (st >> 1) * 16 + swz / 64; C = (st & 1) * 32 + (swz % 64) / 2; }
__host__ __device__ __forceinline__ int perm32(int rho) { const int n = rho >> 4, i = rho & 15; return 8 * (i >> 2) + 4 * n + (i & 3); }

struct Unit { int pm, pn; };
struct Gemm { const bf16_t* A; const bf16_t* Bt; int M, N, K; };

struct StaticOrder {
    int nM, nN, nwg, G, c;
    __host__ __device__ void init(int M, int N, int G_, int c_) { nM = M / BM; nN = N / BM; nwg = nM * nN; G = G_; c = c_; }
    __host__ __device__ bool next(int i, Unit& u) const {
        const long L = (long)i * G + c; if (L >= nwg) return false;
        int wgid = (int)L; { const int q = nwg / NXCD, r = nwg % NXCD, xcd = wgid % NXCD, off = wgid / NXCD; wgid = (xcd < r ? xcd * (q + 1) : r * (q + 1) + (xcd - r) * q) + off; }
        const int nig = WGM * nN, gid = wgid / nig, fm = gid * WGM, gsz = (nM - fm) < WGM ? (nM - fm) : WGM;
        u.pm = fm + ((wgid % nig) % gsz); u.pn = (wgid % nig) / gsz; return true;
    }
    __device__ __forceinline__ void a_ready(const Unit&) const {}
    __device__ __forceinline__ void done(const Unit&) const {}
};
template <class Epi, class Sched, bool ALIGN_EPI = false, bool SP2 = false>
__device__ __forceinline__ void gemm_phase(PG8_LAS unsigned char* lds, const Gemm g, const Sched& S, const Epi& E) {
    const int tid = otid(), wid = __builtin_amdgcn_readfirstlane(tid >> 6), lane = tid & 63, wr = wid >> 2, wc = wid & 3, fr = lane & 15, fq = lane >> 4;
    const int K = g.K, nt = K / BK;
    unsigned voffA[2], voffB[2];
#pragma unroll
    for (int i = 0; i < 2; ++i) { int R, C; stage_rc(tid * 16 + i * 8192, R, C); const int Rb = Epi::PERM ? ((R & ~31) + perm32(R & 31)) : R;
        voffA[i] = (unsigned)(R * K + C) * 2u; voffB[i] = (unsigned)(Rb * K + C) * 2u; }
    const size_t kstep = (size_t)(BK * 2);
    const size_t hstep = (size_t)HALF * K * 2;
    const size_t tstep = 2 * hstep;
    const unsigned ldsw = (unsigned)wid * 1024u;
    const int aoff = lds_byte(wr * 64 + fr, fq * 8), boff = lds_byte(wc * 32 + fr, fq * 8);
#define PG8_SA(b, h) (((b) * 2 + (h)) * HTB)
#define PG8_SB(b, h) ((4 + (b) * 2 + (h)) * HTB)
#define PG8_STAGE(bufoff, gbase, voff) do { _Pragma("unroll") for (int _i = 0; _i < 2; ++_i) \
        __builtin_amdgcn_global_load_lds((const unsigned*)((const char*)(gbase) + (voff)[_i]), (PG8_LAS unsigned*)(lds + (bufoff) + ldsw + _i * 8192), 16, 0, 0); } while (0)
#define PG8_LDA(dst, b, h) do { _Pragma("unroll") for (int m = 0; m < 4; ++m) _Pragma("unroll") for (int k = 0; k < 2; ++k) dst[m][k] = *(const PG8_LAS bf16x8*)(lds + PG8_SA(b, h) + aoff + m * 2048 + k * 1024); } while (0)
#define PG8_LDB(dst, b, h) do { _Pragma("unroll") for (int n = 0; n < 2; ++n) _Pragma("unroll") for (int k = 0; k < 2; ++k) dst[n][k] = *(const PG8_LAS bf16x8*)(lds + PG8_SB(b, h) + boff + n * 2048 + k * 1024); } while (0)
#define PG8_MMA(ai, bj, At, Bt) do { __builtin_amdgcn_s_setprio(1); _Pragma("unroll") for (int m = 0; m < 4; ++m) _Pragma("unroll") for (int n = 0; n < 2; ++n) _Pragma("unroll") for (int k = 0; k < 2; ++k) \
        acc[ai][bj][m][n] = __builtin_amdgcn_mfma_f32_16x16x32_bf16(Bt[n][k], At[m][k], acc[ai][bj][m][n], 0, 0, 0); __builtin_amdgcn_s_setprio(0); } while (0)
#define PG8_WAIT_V(n) asm volatile("s_waitcnt vmcnt(" #n ")" ::: "memory")
#define PG8_WAIT_L(n) asm volatile("s_waitcnt lgkmcnt(" #n ")" ::: "memory")
#define PG8_BAR __builtin_amdgcn_s_barrier()
#define PG8_SCHED __builtin_amdgcn_sched_barrier(0)
    Unit cur, nxt; int ui = 0;
    if (!S.next(0, cur)) return;
    f32x4 acc[2][2][4][2];
#pragma unroll
    for (int a = 0; a < 2; ++a)
#pragma unroll
        for (int b = 0; b < 2; ++b)
#pragma unroll
            for (int m = 0; m < 4; ++m)
#pragma unroll
                for (int n = 0; n < 2; ++n) acc[a][b][m][n] = (f32x4){0.f, 0.f, 0.f, 0.f};
    bf16x8 At[4][2], B0[2][2], B1[2][2];
    const char* cA = (const char*)g.A + (size_t)cur.pm * tstep; const char* cB = (const char*)g.Bt + (size_t)cur.pn * tstep;
    S.a_ready(cur);
    if constexpr (SP2) {
        PG8_STAGE(PG8_SB(0, 0), cB, voffB); PG8_STAGE(PG8_SB(0, 1), cB + hstep, voffB); PG8_STAGE(PG8_SA(0, 0), cA, voffA); PG8_STAGE(PG8_SA(0, 1), cA + hstep, voffA);
        if (wr == 1) PG8_BAR;
        PG8_WAIT_V(2); PG8_BAR;
        PG8_STAGE(PG8_SB(1, 0), cB + kstep, voffB); PG8_STAGE(PG8_SA(1, 0), cA + kstep, voffA); PG8_STAGE(PG8_SB(1, 1), cB + hstep + kstep, voffB);
        PG8_WAIT_V(6); PG8_BAR;
    } else {
        PG8_STAGE(PG8_SB(0, 0), cB, voffB); PG8_STAGE(PG8_SA(0, 0), cA, voffA); PG8_STAGE(PG8_SB(0, 1), cB + hstep, voffB); PG8_STAGE(PG8_SA(0, 1), cA + hstep, voffA);
        if (wr == 1) PG8_BAR;
        PG8_WAIT_V(4); PG8_BAR;
        PG8_STAGE(PG8_SB(1, 0), cB + kstep, voffB); PG8_STAGE(PG8_SA(1, 0), cA + kstep, voffA); PG8_STAGE(PG8_SB(1, 1), cB + hstep + kstep, voffB);
        PG8_WAIT_V(6); PG8_BAR;
    }
    for (;;) {
        const bool has_next = S.next(ui + 1, nxt);
        const char* nA = has_next ? (const char*)g.A + (size_t)nxt.pm * tstep : cA; const char* nB = has_next ? (const char*)g.Bt + (size_t)nxt.pn * tstep : cB;
        for (int t = 0; t < nt; t += 2) {
            const bool last = (t == nt - 2);
            const char* a1 = cA + (size_t)(t + 1) * kstep;
            const char* a2 = last ? nA : cA + (size_t)(t + 2) * kstep; const char* b2 = last ? nB : cB + (size_t)(t + 2) * kstep;
            const char* a3 = a2 + kstep; const char* b3 = b2 + kstep;
            if (last && has_next) S.a_ready(nxt);
            if constexpr (SP2) {
            PG8_LDB(B0, 0, 0); PG8_LDB(B1, 0, 1); PG8_SCHED; PG8_LDA(At, 0, 0); PG8_STAGE(PG8_SA(1, 1), a1 + hstep, voffA);
            PG8_WAIT_V(8); PG8_WAIT_L(0); PG8_BAR; PG8_MMA(0, 0, At, B0); PG8_MMA(0, 1, At, B1); PG8_BAR; PG8_SCHED;
            PG8_LDA(At, 0, 1); PG8_STAGE(PG8_SB(0, 0), b2, voffB); PG8_STAGE(PG8_SB(0, 1), b2 + hstep, voffB); PG8_STAGE(PG8_SA(0, 0), a2, voffA);
            PG8_WAIT_V(8); PG8_WAIT_L(0); PG8_BAR; PG8_MMA(1, 0, At, B0); PG8_MMA(1, 1, At, B1); PG8_BAR; PG8_SCHED;
            PG8_LDB(B0, 1, 0); PG8_LDB(B1, 1, 1); PG8_SCHED; PG8_LDA(At, 1, 0); PG8_STAGE(PG8_SA(0, 1), a2 + hstep, voffA);
            PG8_WAIT_V(8); PG8_WAIT_L(0); PG8_BAR; PG8_MMA(0, 0, At, B0); PG8_MMA(0, 1, At, B1); PG8_BAR; PG8_SCHED;
            PG8_LDA(At, 1, 1); PG8_STAGE(PG8_SB(1, 0), b3, voffB); PG8_STAGE(PG8_SB(1, 1), b3 + hstep, voffB); PG8_STAGE(PG8_SA(1, 0), a3, voffA);
            PG8_WAIT_V(8); PG8_WAIT_L(0); PG8_BAR; PG8_MMA(1, 0, At, B0); PG8_MMA(1, 1, At, B1); PG8_BAR; PG8_SCHED;
            } else {
            PG8_LDB(B0, 0, 0); PG8_SCHED; PG8_LDA(At, 0, 0); PG8_STAGE(PG8_SA(1, 1), a1 + hstep, voffA);
            PG8_WAIT_L(8); PG8_BAR; PG8_WAIT_L(0); PG8_MMA(0, 0, At, B0); PG8_BAR; PG8_SCHED;
            PG8_LDB(B1, 0, 1); PG8_STAGE(PG8_SB(0, 0), b2, voffB);
            PG8_BAR; PG8_WAIT_L(0); PG8_MMA(0, 1, At, B1); PG8_BAR;
            PG8_LDA(At, 0, 1); PG8_STAGE(PG8_SA(0, 0), a2, voffA);
            PG8_BAR; PG8_WAIT_L(0); PG8_MMA(1, 0, At, B0); PG8_BAR; PG8_SCHED;
            PG8_STAGE(PG8_SB(0, 1), b2 + hstep, voffB);
            PG8_WAIT_V(6); PG8_BAR; PG8_MMA(1, 1, At, B1); PG8_BAR;
            PG8_LDB(B0, 1, 0); PG8_SCHED; PG8_LDA(At, 1, 0); PG8_STAGE(PG8_SA(0, 1), a2 + hstep, voffA);
            PG8_WAIT_L(8); PG8_BAR; PG8_WAIT_L(0); PG8_MMA(0, 0, At, B0); PG8_BAR; PG8_SCHED;
            PG8_LDB(B1, 1, 1); PG8_STAGE(PG8_SB(1, 0), b3, voffB);
            PG8_BAR; PG8_WAIT_L(0); PG8_MMA(0, 1, At, B1); PG8_BAR;
            PG8_LDA(At, 1, 1); PG8_STAGE(PG8_SA(1, 0), a3, voffA);
            PG8_BAR; PG8_WAIT_L(0); PG8_MMA(1, 0, At, B0); PG8_BAR; PG8_SCHED;
            PG8_STAGE(PG8_SB(1, 1), b3 + hstep, voffB);
            PG8_WAIT_V(6); PG8_BAR; PG8_MMA(1, 1, At, B1); PG8_BAR;
            }
        }
        if constexpr (ALIGN_EPI) { if (wr == 0) PG8_BAR; }
        if constexpr (!Epi::AFTER_DRAIN) { E(acc, cur, wr, wc, fr, fq); S.done(cur); }
        if (!has_next) break;
#pragma unroll
        for (int a = 0; a < 2; ++a)
#pragma unroll
            for (int b = 0; b < 2; ++b)
#pragma unroll
                for (int m = 0; m < 4; ++m)
#pragma unroll
                    for (int n = 0; n < 2; ++n) acc[a][b][m][n] = (f32x4){0.f, 0.f, 0.f, 0.f};
        cur = nxt; cA = nA; cB = nB; ++ui;
        if constexpr (ALIGN_EPI) { if (wr == 1) PG8_BAR; }
    }
    PG8_WAIT_V(0);
    if constexpr (!ALIGN_EPI) { if (wr == 0) PG8_BAR; }
    PG8_BAR;
    if constexpr (Epi::AFTER_DRAIN) { E.fused(acc, cur, wr, wc, fr, fq, lds, wid, lane); S.done(cur); }
#undef PG8_SA
#undef PG8_SB
#undef PG8_STAGE
#undef PG8_LDA
#undef PG8_LDB
#undef PG8_MMA
#undef PG8_WAIT_V
#undef PG8_WAIT_L
#undef PG8_BAR
#undef PG8_SCHED
}
}

template <class E> struct Pg8Epi { static constexpr bool PERM = true, AFTER_DRAIN = false; E e;
    __device__ __forceinline__ void operator()(f32x4 (&acc)[2][2][4][2], const pg8::Unit& u, int, int, int, int) const { e(acc, u.pm, u.pn); } };
template <class Epi>
__device__ __forceinline__ void gemm_run2(LAS uchar* lds, const bf16_t* A, const bf16_t* Bt, int nM, int nN, int K, const Epi& E) {
    pg8::Gemm g{A, Bt, nM * 256, nN * 256, K}; pg8::StaticOrder S; S.init(nM * 256, nN * 256, ogdim(), obid());
    Pg8Epi<Epi> PE{E};
    pg8::gemm_phase<Pg8Epi<Epi>, pg8::StaticOrder, true, true>(lds, g, S, PE);
}
#define EPI_LOOP _Pragma("unroll") for (int ai = 0; ai < 2; ++ai) _Pragma("unroll") for (int m = 0; m < 4; ++m) _Pragma("unroll") for (int bj = 0; bj < 2; ++bj) _Pragma("unroll") for (int n = 0; n < 2; ++n)
#define EPI_FENCE do { if (bj == 1 && n == 1) asm volatile("" ::: "memory"); } while (0)

#define EPI2_LOOP _Pragma("unroll") for (int ai = 0; ai < 2; ++ai) _Pragma("unroll") for (int m = 0; m < 4; ++m) _Pragma("unroll") for (int bj = 0; bj < 2; ++bj)
#define EPI2_FENCE do { if (bj == 1) asm volatile("" ::: "memory"); } while (0)
__device__ __forceinline__ u32x4 pk8(f32x4 a, f32x4 b) { u32x4 w; w.x = pk2(a[0], a[1]); w.y = pk2(a[2], a[3]); w.z = pk2(b[0], b[1]); w.w = pk2(b[2], b[3]); return w; }
__device__ __forceinline__ u32x4 pkh8(f32x4 a, f32x4 b) { u32x4 w; w.x = pkh2(a[0], a[1]); w.y = pkh2(a[2], a[3]); w.z = pkh2(b[0], b[1]); w.w = pkh2(b[2], b[3]); return w; }
__device__ __forceinline__ f32x4 silu4(f32x4 v) { f32x4 s; s[0] = siluf(v[0]); s[1] = siluf(v[1]); s[2] = siluf(v[2]); s[3] = siluf(v[3]); return s; }
__device__ __forceinline__ f32x4 sigm4(f32x4 v) { f32x4 s; s[0] = sigm(v[0]); s[1] = sigm(v[1]); s[2] = sigm(v[2]); s[3] = sigm(v[3]); return s; }
__device__ __forceinline__ void unh8(u32x4 w, f32x4& a, f32x4& b) { a[0] = h2f(w.x & 0xffff); a[1] = h2f(w.x >> 16); a[2] = h2f(w.y & 0xffff); a[3] = h2f(w.y >> 16); b[0] = h2f(w.z & 0xffff); b[1] = h2f(w.z >> 16); b[2] = h2f(w.w & 0xffff); b[3] = h2f(w.w >> 16); }
__device__ __forceinline__ void unb8(u32x4 w, f32x4& a, f32x4& b) { a[0] = bf2f(w.x & 0xffff); a[1] = bf2f(w.x >> 16); a[2] = bf2f(w.y & 0xffff); a[3] = bf2f(w.y >> 16); b[0] = bf2f(w.z & 0xffff); b[1] = bf2f(w.z >> 16); b[2] = bf2f(w.w & 0xffff); b[3] = bf2f(w.w >> 16); }

struct EpiGU { bf16_t* hid;
    __device__ __forceinline__ void operator()(f32x4 (&acc)[2][2][4][2], int pm, int pn) const { COORDS
#pragma unroll
        for (int ai = 0; ai < 2; ++ai)
#pragma unroll
            for (int m = 0; m < 4; ++m) { const int r = pm * 256 + ai * 128 + wr * 64 + m * 16 + fr, cc = pn * 128 + wc * 32 + fq * 8;
                *(u32x4*)(hid + (size_t)r * FF + cc) = pk8(silu4(acc[ai][0][m][0]) * acc[ai][1][m][0], silu4(acc[ai][0][m][1]) * acc[ai][1][m][1]); } } };

struct EpiRes { float* h; const float* ada; float coef; const float* stats; const float* g; const float* bta; const float* hsrc;
    __device__ __forceinline__ void operator()(f32x4 (&acc)[2][2][4][2], int pm, int pn) const { COORDS
        const float* ap = ada + (size_t)(pm >> 5) * 9216;
        EPI2_LOOP { const int r = pm * 256 + ai * 128 + wr * 64 + m * 16 + fr, c = pn * 256 + bj * 128 + wc * 32 + fq * 8;
            const float mu = stats[2 * r], rs = stats[2 * r + 1]; float* hp = h + (size_t)r * DM + c; const float* sp = hsrc + (size_t)r * DM + c;
#pragma unroll
            for (int n = 0; n < 2; ++n) { const f32x4 gv = *(const f32x4*)(ap + c + 4 * n), gg = *(const f32x4*)(g + c + 4 * n), bb = *(const f32x4*)(bta + c + 4 * n), zv = *(const f32x4*)(sp + 4 * n);
                f32x4 z;
#pragma unroll
                for (int j = 0; j < 4; ++j) { const float hv = (zv[j] - mu) * rs * gg[j] + bb[j]; z[j] = DN_ALPHA * hv + coef * (1.f + gv[j]) * acc[ai][bj][m][n][j]; }
                *(f32x4*)(hp + 4 * n) = z; }
            EPI2_FENCE; } } };

struct EpiWin1 { bf16_t *hq, *hv, *sg, *cq, *ckv; unsigned short* zf; float* krraw;
    __device__ __forceinline__ void operator()(f32x4 (&acc)[2][2][4][2], int pm, int pn) const { COORDS
        const int kind = pn >> 2;
        EPI2_LOOP { const int r = pm * 256 + ai * 128 + wr * 64 + m * 16 + fr, c = pn * 256 + bj * 128 + wc * 32 + fq * 8; const f32x4 v0 = acc[ai][bj][m][0], v1 = acc[ai][bj][m][1];
            if (kind == 0) *(u32x4*)(hq + (size_t)r * DM + c) = pk8(silu4(v0), silu4(v1));
            else if (kind == 1) *(u32x4*)(zf + (size_t)r * DM + (c - 1024)) = pkh8(v0, v1);
            else if (kind == 2) *(u32x4*)(hv + (size_t)r * DM + (c - 2048)) = pk8(v0, v1);
            else if (kind == 3) *(u32x4*)(sg + (size_t)r * DM + (c - 3072)) = pk8(silu4(v0), silu4(v1));
            else { const int gc = c - 4096;
                if (gc < 384) *(u32x4*)(cq + (size_t)r * 384 + gc) = pk8(v0, v1);
                else if (gc < 640) *(u32x4*)(ckv + (size_t)r * 256 + (gc - 384)) = pk8(v0, v1);
                else if (gc < 704) { *(f32x4*)(krraw + (size_t)r * 64 + (gc - 640)) = v0; *(f32x4*)(krraw + (size_t)r * 64 + (gc - 640) + 4) = v1; } } } } };

struct EpiQ { bf16_t *qn, *qr; const float *rsq, *cosT, *sinT;
    __device__ __forceinline__ void operator()(f32x4 (&acc)[2][2][4][2], int pm, int pn) const { COORDS
#pragma unroll
        for (int ai = 0; ai < 2; ++ai)
#pragma unroll
            for (int m = 0; m < 4; ++m) { const int r = pm * 256 + ai * 128 + wr * 64 + m * 16 + fr; const float rs = rsq[r] * QSCALE;
                if (pn < 4) {
#pragma unroll
                    for (int bj = 0; bj < 2; ++bj) { const int c = pn * 256 + bj * 128 + wc * 32 + fq * 8; *(u32x4*)(qn + (size_t)r * DM + c) = pk8(acc[ai][bj][m][0] * rs, acc[ai][bj][m][1] * rs); }
                } else { const int cl = wc * 32 + fq * 8, hh = (pn - 4) * 4 + (cl >> 5), i = cl & 31;
                    f32x4 o1[2], o2[2];
#pragma unroll
                    for (int n = 0; n < 2; ++n) { const f32x4 x1 = acc[ai][0][m][n] * rs, x2 = acc[ai][1][m][n] * rs; const f32x4 cs = *(const f32x4*)(cosT + (size_t)r * 32 + i + 4 * n), sn = *(const f32x4*)(sinT + (size_t)r * 32 + i + 4 * n);
                        o1[n] = x1 * cs - x2 * sn; o2[n] = x1 * sn + x2 * cs; }
                    *(u32x4*)(qr + (size_t)r * 512 + hh * 64 + i) = pk8(o1[0], o1[1]); *(u32x4*)(qr + (size_t)r * 512 + hh * 64 + 32 + i) = pk8(o2[0], o2[1]);
                }
                asm volatile("" ::: "memory"); } } };

struct EpiKn { bf16_t* kn; const float* rskv;
    __device__ __forceinline__ void operator()(f32x4 (&acc)[2][2][4][2], int pm, int pn) const { COORDS
        EPI2_LOOP { const int r = pm * 256 + ai * 128 + wr * 64 + m * 16 + fr, c = pn * 256 + bj * 128 + wc * 32 + fq * 8; const float rs = rskv[r];
            *(u32x4*)(kn + (size_t)r * DM + c) = pk8(acc[ai][bj][m][0] * rs, acc[ai][bj][m][1] * rs); EPI2_FENCE; } } };

struct EpiV { bf16_t* vt; const float* rskv;
    __device__ __forceinline__ void operator()(f32x4 (&acc)[2][2][4][2], int pm, int pn) const { COORDS
        EPI_LOOP { const int r0 = pm * 256 + ai * 128 + wr * 64 + m * 16 + fq * 4, cv = pn * 256 + bj * 128 + wc * 32 + n * 16 + fr;
            const f32x4 rs = *(const f32x4*)(rskv + r0); const int b = r0 >> 13, s = r0 & 8191, hh = cv >> 7, e = cv & 127;
            *(u32x2*)(vt + (((size_t)((b * 8 + hh) * 128 + e)) << 13) + s) = pk4(acc[ai][bj][m][n] * rs); EPI_FENCE; } } };

struct EpiGate { unsigned short *sga, *sgb;
    __device__ __forceinline__ void operator()(f32x4 (&acc)[2][2][4][2], int pm, int pn) const { COORDS
        unsigned short* dst = pn < 4 ? sga : sgb;
        EPI2_LOOP { const int r = pm * 256 + ai * 128 + wr * 64 + m * 16 + fr, c = (pn & 3) * 256 + bj * 128 + wc * 32 + fq * 8;
            *(u32x4*)(dst + (size_t)r * DM + c) = pkh8(sigm4(acc[ai][bj][m][0]), sigm4(acc[ai][bj][m][1])); } } };

struct EpiM1 { bf16_t* m1; const unsigned short* sga;
    __device__ __forceinline__ void operator()(f32x4 (&acc)[2][2][4][2], int pm, int pn) const { COORDS
        EPI2_LOOP { const int r = pm * 256 + ai * 128 + wr * 64 + m * 16 + fr, c = pn * 256 + bj * 128 + wc * 32 + fq * 8;
            f32x4 s0, s1; unh8(*(const u32x4*)(sga + (size_t)r * DM + c), s0, s1);
            *(u32x4*)(m1 + (size_t)r * DM + c) = pk8(acc[ai][bj][m][0] * s0, acc[ai][bj][m][1] * s1); EPI2_FENCE; } } };
struct EpiM2 { const bf16_t* m1; const unsigned short* sgb; bf16_t* merged;
    __device__ __forceinline__ void operator()(f32x4 (&acc)[2][2][4][2], int pm, int pn) const { COORDS
        EPI2_LOOP { const int r = pm * 256 + ai * 128 + wr * 64 + m * 16 + fr, c = pn * 256 + bj * 128 + wc * 32 + fq * 8;
            f32x4 s0, s1, m0, m1v; unh8(*(const u32x4*)(sgb + (size_t)r * DM + c), s0, s1); unb8(*(const u32x4*)(m1 + (size_t)r * DM + c), m0, m1v);
            *(u32x4*)(merged + (size_t)r * DM + c) = pk8(m0 + acc[ai][bj][m][0] * s0, m1v + acc[ai][bj][m][1] * s1); EPI2_FENCE; } } };

struct ConvDesc { const float* src0; const float* src1; const float* kscale; int K, Ns; bf16_t* dst; int kind, item; };
__device__ __forceinline__ void conv_load(const ConvDesc& d, int tid, float (&v)[8]) {
    const int nkt = d.K / 64; const int kt = d.item % nkt, ntile = d.item / nkt; const int k0 = kt * 64, n0 = ntile * 64;
    const int tn = tid & 63, np = n0 + tn; const float* s = d.src0; int col = np;
    if (d.kind == 1) { const int tile = np >> 8, bj = (np >> 7) & 1, cc = np & 127; s = bj ? d.src1 : d.src0; col = tile * 128 + cc; }
    else if (d.kind == 2) { if (np < 1024) col = (np >> 7) * 192 + (np & 127); else { const int r = np - 1024, t2 = r >> 8, bj = (r >> 7) & 1, cc = r & 127, hh = t2 * 4 + (cc >> 5), i = cc & 31; col = hh * 192 + 128 + bj * 32 + i; } }
    else if (d.kind == 3) { if (np < 1024) col = (np >> 7) * 256 + (np & 127); else { const int r = np - 1024; col = (r >> 7) * 256 + 128 + (r & 127); } }
#pragma unroll
    for (int i = 0; i < 8; ++i) { const int kk = (tid >> 6) + 8 * i; float x = s[(size_t)(k0 + kk) * d.Ns + col]; if (d.kscale) x *= d.kscale[k0 + kk]; v[i] = x; }
}
__device__ __forceinline__ void conv_store(LAS uchar* lds, const ConvDesc& d, int tid, const float (&v)[8]) {
    LAS float* tl = (LAS float*)lds;
    const int nkt = d.K / 64; const int kt = d.item % nkt, ntile = d.item / nkt; const int k0 = kt * 64, n0 = ntile * 64;
    { const int tn = tid & 63;
#pragma unroll
      for (int i = 0; i < 8; ++i) tl[tn * 65 + (tid >> 6) + 8 * i] = v[i]; }
    __syncthreads();
    { const int n = tid >> 3, kc = tid & 7; const LAS float* rp = tl + n * 65 + kc * 8; u32x4 w; w.x = pk2(rp[0], rp[1]); w.y = pk2(rp[2], rp[3]); w.z = pk2(rp[4], rp[5]); w.w = pk2(rp[6], rp[7]);
      *(u32x4*)(d.dst + (size_t)(n0 + n) * d.K + k0 + kc * 8) = w; }
    __syncthreads();
}
__device__ __forceinline__ ConvDesc conv_desc(const Params& p, int l, int it) {
    bf16_t* W = (bf16_t*)(p.ws + OFF_W + (size_t)(l & 1) * WSZ);
    constexpr int I_GU = 16 * 88, I_D = 44 * 16, I_IN = 16 * 107, I_UQ = 6 * 24, I_UKV = 4 * 32, I_SQ = 256;
    const size_t o_ff = (size_t)l * DM * FF; int r = it;
    if (r < I_GU) return ConvDesc{p.f1g + o_ff, p.f1u + o_ff, nullptr, DM, FF, W + W_GU1, 1, r}; r -= I_GU;
    if (r < I_D) return ConvDesc{p.f1d + o_ff, nullptr, nullptr, FF, DM, W + W_D1, 0, r}; r -= I_D;
    if (r < I_IN) return ConvDesc{p.w_in + (size_t)l * DM * 6848, nullptr, nullptr, DM, 6848, W + W_IN, 0, r}; r -= I_IN;
    if (r < I_UQ) return ConvDesc{p.w_uq + (size_t)l * 384 * 1536, nullptr, p.qng + l * 384, 384, 1536, W + W_UQ, 2, r}; r -= I_UQ;
    if (r < I_UKV) return ConvDesc{p.w_ukv + (size_t)l * 256 * 2048, nullptr, p.kvng + l * 256, 256, 2048, W + W_UKV, 3, r}; r -= I_UKV;
    if (r < I_SQ) return ConvDesc{p.w_bh + (size_t)l * DM * DM, nullptr, nullptr, DM, DM, W + W_BH, 0, r}; r -= I_SQ;
    if (r < I_SQ) return ConvDesc{p.w_bm + (size_t)l * DM * DM, nullptr, nullptr, DM, DM, W + W_BM, 0, r}; r -= I_SQ;
    if (r < I_SQ) return ConvDesc{p.w_out + (size_t)l * DM * DM, nullptr, nullptr, DM, DM, W + W_OUT, 0, r}; r -= I_SQ;
    if (r < I_GU) return ConvDesc{p.f2g + o_ff, p.f2u + o_ff, nullptr, DM, FF, W + W_GU2, 1, r}; r -= I_GU;
    return ConvDesc{p.f2d + o_ff, nullptr, nullptr, FF, DM, W + W_D2, 0, r};
}
__device__ void conv_layer(LAS uchar* lds, const Params& p, int l, int start, int stride) {
    constexpr int TOT = 2 * 16 * 88 + 2 * 44 * 16 + 16 * 107 + 6 * 24 + 4 * 32 + 3 * 256;
    const int tid = otid();
    float v[8], vn[8];
    if (start < TOT) { const ConvDesc d = conv_desc(p, l, start); conv_load(d, tid, v); }
    for (int it = start; it < TOT; it += stride) {
        const ConvDesc d = conv_desc(p, l, it);
        if (it + stride < TOT) { const ConvDesc dn = conv_desc(p, l, it + stride); conv_load(dn, tid, vn); }
        conv_store(lds, d, tid, v);
#pragma unroll
        for (int i = 0; i < 8; ++i) v[i] = vn[i];
    }
}

__device__ void p0a(LAS uchar* lds, const Params& p) {
    const int tid = otid(), G = ogdim();
    float* ADA = (float*)(p.ws + OFF_ADA);
    LAS float* red = (LAS float*)lds;
    LAS float* cond = red + 2048;
    for (int i = tid; i < 4096; i += NTHR) cond[i] = siluf(p.c[i]);
    __syncthreads();
    for (int it = obid(); it < NL * 144; it += G) {
        const int l = it / 144, cg0 = (it % 144) * 64, cn = tid & 63, kp = tid >> 6;
        const float* w = p.ada_w + (size_t)l * DM * 9216 + cg0 + cn;
        float a0 = 0.f, a1 = 0.f, a2 = 0.f, a3 = 0.f;
        for (int k = kp * 128; k < kp * 128 + 128; ++k) { const float wv = w[(size_t)k * 9216];
            a0 += cond[k] * wv; a1 += cond[1024 + k] * wv; a2 += cond[2048 + k] * wv; a3 += cond[3072 + k] * wv; }
        red[(kp * 4 + 0) * 64 + cn] = a0; red[(kp * 4 + 1) * 64 + cn] = a1; red[(kp * 4 + 2) * 64 + cn] = a2; red[(kp * 4 + 3) * 64 + cn] = a3;
        __syncthreads();
        if (tid < 256) { const int b = tid >> 6; float s = 0.f;
#pragma unroll
            for (int q = 0; q < 8; ++q) s += red[(q * 4 + b) * 64 + cn];
            ADA[(size_t)(l * 4 + b) * 9216 + cg0 + cn] = s + p.ada_b[(size_t)l * 9216 + cg0 + cn]; }
        __syncthreads();
    }
    float* COS = (float*)(p.ws + OFF_COS); float* SIN = (float*)(p.ws + OFF_SIN);
    for (int e = obid() * NTHR + tid; e < T * 32; e += G * NTHR) {
        const int tok = e >> 5, i = e & 31; double inv = 1.0, rr = 0.7498942093324558; int n = i;
        while (n) { if (n & 1) inv *= rr; rr *= rr; n >>= 1; }
        const double ang = (double)p.pos[tok] * inv; const double kq = __builtin_rint(ang * 0.15915494309189535);
        double r = ang - kq * 6.283185307179586 - kq * 2.4492935982947064e-16; const double r2 = r * r;
        double sn, cs;
        { double t = 1.0;
#pragma unroll
          for (int q = 27; q >= 3; q -= 2) t = 1.0 - t * r2 * (1.0 / (double)(q * (q - 1))); sn = t * r; }
        { double t = 1.0;
#pragma unroll
          for (int q = 26; q >= 2; q -= 2) t = 1.0 - t * r2 * (1.0 / (double)(q * (q - 1))); cs = t; }
        COS[e] = (float)cs; SIN[e] = (float)sn;
    }
    { float* onz = (float*)(p.ws + OFF_ONES); for (int ch = obid() * NTHR + tid; ch < 2048; ch += G * NTHR) onz[ch] = ch < 1024 ? 1.f : 0.f; }
    float* LBT = (float*)(p.ws + OFF_LBT);
    for (int ch = obid() * NTHR + tid; ch < 1024; ch += G * NTHR) {
        const float v0 = p.hg_lb[ch], v1 = p.hg_lb[1024 + ch], v2 = p.hg_lb[2048 + ch], v3 = p.hg_lb[3072 + ch];
        const float mx = fmaxf(fmaxf(v0, v1), fmaxf(v2, v3)); const float e0 = expf(v0 - mx), e1 = expf(v1 - mx), e2 = expf(v2 - mx), e3 = expf(v3 - mx); const float inv = 1.f / (e0 + e1 + e2 + e3);
        float lw[4]; lw[0] = 0.f; lw[1] = e1 * inv; lw[2] = (e1 + e2) * inv; lw[3] = (e1 + e2 + e3) * inv;
#pragma unroll
        for (int l = 0; l < 4; ++l) { const float lb = lw[l]; LBT[(l * 3 + 0) * 1024 + ch] = fmaxf(lb, 1e-30f); LBT[(l * 3 + 1) * 1024 + ch] = log1pf(-lb); LBT[(l * 3 + 2) * 1024 + ch] = 1.f - lb; }
    }
}

__device__ void ln_pass(const Params& p, const float* src, float* hdst, bf16_t* U, const float* g, const float* bta, const float* ada_l, int sc_idx, int sh_idx, bool donorm, bool writeU, bool writeH) {
    float* stats = (float*)(p.ws + OFF_STATS);
    const int tid = otid(), wid = tid >> 6, lane = tid & 63;
    for (int row = obid() * 8 + wid; row < T; row += ogdim() * 8) {
        const f32x4* xr = (const f32x4*)(src + (size_t)row * DM) + lane; f32x4 v[4]; float s = 0.f;
#pragma unroll
        for (int j = 0; j < 4; ++j) { v[j] = xr[64 * j]; s += (v[j][0] + v[j][1]) + (v[j][2] + v[j][3]); }
        if (donorm) {
#pragma unroll
            for (int o = 32; o > 0; o >>= 1) s += __shfl_xor(s, o);
            const float mean = s * (1.f / DM); float s2 = 0.f;
#pragma unroll
            for (int j = 0; j < 4; ++j) { v[j] = v[j] - mean; s2 += (v[j][0] * v[j][0] + v[j][1] * v[j][1]) + (v[j][2] * v[j][2] + v[j][3] * v[j][3]); }
#pragma unroll
            for (int o = 32; o > 0; o >>= 1) s2 += __shfl_xor(s2, o);
            const float rstd = 1.f / sqrtf(s2 * (1.f / DM) + 1e-5f);
            if (lane == 0) *(f32x2v*)(stats + 2 * row) = (f32x2v){mean, rstd};
#pragma unroll
            for (int j = 0; j < 4; ++j) { const f32x4 gg = *((const f32x4*)g + lane + 64 * j), bb = *((const f32x4*)bta + lane + 64 * j); v[j] = v[j] * rstd * gg + bb; }
        }
        else if (lane == 0) { const float zz = v[0][0] * 0.f; *(f32x2v*)(stats + 2 * row) = (f32x2v){zz, 1.f + zz}; }
        if (writeH) { f32x4* hr = (f32x4*)(hdst + (size_t)row * DM) + lane;
#pragma unroll
            for (int j = 0; j < 4; ++j) hr[64 * j] = v[j]; }
        if (writeU) { const float* ab = ada_l + (size_t)(row >> 13) * 9216; u32x2* ur = (u32x2*)(U + (size_t)row * DM) + lane;
#pragma unroll
            for (int j = 0; j < 4; ++j) { const f32x4 sc = *((const f32x4*)(ab + sc_idx * 1024) + lane + 64 * j), sh = *((const f32x4*)(ab + sh_idx * 1024) + lane + 64 * j); ur[64 * j] = pk4(v[j] * (1.f + sc) + sh); } }
    }
}

__device__ void ln_pass2(const Params& p, const float* src, float* outH, bf16_t* U, const float* g, const float* bta, const float* ada_l, int sc_idx, int sh_idx) {
    float* stats = (float*)(p.ws + OFF_STATS);
    const int tid = otid(), wid = tid >> 6, lane = tid & 63; const int rstep = ogdim() * 8, r0 = obid() * 8 + wid;
    for (int b = 0; b < 4; ++b) {
        f32x4 A[4], B[4];
#pragma unroll
        for (int j = 0; j < 4; ++j) { const f32x4 gg = *((const f32x4*)g + lane + 64 * j), bb = *((const f32x4*)bta + lane + 64 * j);
            if (outH) { A[j] = gg; B[j] = bb; }
            else { const float* ab = ada_l + (size_t)b * 9216; const f32x4 sc = *((const f32x4*)(ab + sc_idx * 1024) + lane + 64 * j), sh = *((const f32x4*)(ab + sh_idx * 1024) + lane + 64 * j); A[j] = gg * (1.f + sc); B[j] = bb * (1.f + sc) + sh; } }
        f32x4 v[4], vn[4];
        if (r0 < SEQ) {
#pragma unroll
            for (int j = 0; j < 4; ++j) v[j] = *((const f32x4*)(src + (size_t)(b * SEQ + r0) * DM) + lane + 64 * j); }
        for (int rr = r0; rr < SEQ; rr += rstep) {
            const int row = b * SEQ + rr;
            if (rr + rstep < SEQ) {
#pragma unroll
                for (int j = 0; j < 4; ++j) vn[j] = *((const f32x4*)(src + (size_t)(row + rstep) * DM) + lane + 64 * j); }
            float s = 0.f;
#pragma unroll
            for (int j = 0; j < 4; ++j) s += (v[j][0] + v[j][1]) + (v[j][2] + v[j][3]);
#pragma unroll
            for (int o = 32; o > 0; o >>= 1) s += __shfl_xor(s, o);
            const float mean = s * (1.f / DM); float s2 = 0.f;
#pragma unroll
            for (int j = 0; j < 4; ++j) { v[j] = v[j] - mean; s2 += (v[j][0] * v[j][0] + v[j][1] * v[j][1]) + (v[j][2] * v[j][2] + v[j][3] * v[j][3]); }
#pragma unroll
            for (int o = 32; o > 0; o >>= 1) s2 += __shfl_xor(s2, o);
            const float rstd = 1.f / sqrtf(s2 * (1.f / DM) + 1e-5f);
            if (lane == 0) *(f32x2v*)(stats + 2 * row) = (f32x2v){mean, rstd};
            if (outH) { f32x4* hr = (f32x4*)(outH + (size_t)row * DM) + lane;
#pragma unroll
                for (int j = 0; j < 4; ++j) hr[64 * j] = v[j] * rstd * A[j] + B[j]; }
            else { u32x2* ur = (u32x2*)(U + (size_t)row * DM) + lane;
#pragma unroll
                for (int j = 0; j < 4; ++j) ur[64 * j] = pk4(v[j] * rstd * A[j] + B[j]); }
#pragma unroll
            for (int j = 0; j < 4; ++j) v[j] = vn[j];
        }
    }
}

__device__ void tok_pass(const Params& p) {
    const int tid = otid(), wid = tid >> 6, lane = tid & 63;
    const bf16_t* CQ = (const bf16_t*)(p.ws + OFF_CQ); const bf16_t* CKV = (const bf16_t*)(p.ws + OFF_CKV);
    const float* KRRAW = (const float*)(p.ws + OFF_KRRAW); bf16_t* KR = (bf16_t*)(p.ws + OFF_KR);
    const float* COS = (const float*)(p.ws + OFF_COS); const float* SIN = (const float*)(p.ws + OFF_SIN);
    float* RSQ = (float*)(p.ws + OFF_RSQ); float* RSKV = (float*)(p.ws + OFF_RSKV);
    const int step = ogdim() * 8, t0 = obid() * 8 + wid; const int l31 = lane & 31;
    unsigned qw[3], qn[3]; u32x2 kw, kn2; float x1, x2, cs, sn, x1n, x2n, csn, snn;
#define TOK_LOAD(tok_, Q_, K_, X1_, X2_, C_, S_) do { const unsigned* q_ = (const unsigned*)(CQ + (size_t)(tok_) * 384) + lane * 3; Q_[0] = q_[0]; Q_[1] = q_[1]; Q_[2] = q_[2]; K_ = *((const u32x2*)(CKV + (size_t)(tok_) * 256) + lane); \
        X1_ = KRRAW[(size_t)(tok_) * 64 + l31]; X2_ = KRRAW[(size_t)(tok_) * 64 + 32 + l31]; C_ = COS[(size_t)(tok_) * 32 + l31]; S_ = SIN[(size_t)(tok_) * 32 + l31]; } while (0)
    if (t0 < T) TOK_LOAD(t0, qw, kw, x1, x2, cs, sn);
    for (int tok = t0; tok < T; tok += step) {
        if (tok + step < T) TOK_LOAD(tok + step, qn, kn2, x1n, x2n, csn, snn);
        float s = 0.f;
#pragma unroll
        for (int j = 0; j < 3; ++j) { const float a = bf2f(qw[j] & 0xffff), b = bf2f(qw[j] >> 16); s += a * a + b * b; }
        float s2; { const float a = bf2f(kw.x & 0xffff), b = bf2f(kw.x >> 16), c = bf2f(kw.y & 0xffff), d = bf2f(kw.y >> 16); s2 = a * a + b * b + c * c + d * d; }
#pragma unroll
        for (int o = 32; o > 0; o >>= 1) { s += __shfl_xor(s, o); s2 += __shfl_xor(s2, o); }
        if (lane == 0) { RSQ[tok] = 1.f / sqrtf(s * (1.f / 384.f) + 1e-6f); RSKV[tok] = 1.f / sqrtf(s2 * (1.f / 256.f) + 1e-6f); }
        if (lane < 32) { KR[(size_t)tok * 64 + lane] = f2bf(x1 * cs - x2 * sn); KR[(size_t)tok * 64 + 32 + lane] = f2bf(x1 * sn + x2 * cs); }
        qw[0] = qn[0]; qw[1] = qn[1]; qw[2] = qn[2]; kw = kn2; x1 = x1n; x2 = x2n; cs = csn; sn = snn;
    }
#undef TOK_LOAD
}

__device__ __forceinline__ void gate2(float z, float lbp, float oml, float& lf2, float& hk) {
    const float t = __builtin_amdgcn_exp2f(-fabsf(z) * 1.44269504f), r = __builtin_amdgcn_rcpf(1.f + t), sm = t * r;
    const float sz = z >= 0.f ? r : sm, snz = z >= 0.f ? sm : r;
    lf2 = __builtin_amdgcn_logf(lbp + oml * sz); hk = oml * snz;
}
constexpr int KT_STR = 72;
constexpr int TD_STR = 136;

__device__ void hg1_phase(LAS uchar* lds, const Params& p, int l) {
    COORDS
    const unsigned* ZF32 = (const unsigned*)(p.ws + OFF_R1); const unsigned* HV32 = (const unsigned*)(p.ws + OFF_R2);
    bf16_t* LS = (bf16_t*)(p.ws + OFF_R4); float* DEC = (float*)(p.ws + OFF_DEC); const float* LBT = (const float*)(p.ws + OFF_LBT) + (size_t)l * 3 * 1024;
    LAS bf16_t* Kt = (LAS bf16_t*)lds;
    LAS bf16_t* Vt = (LAS bf16_t*)(lds + 128 * KT_STR * 2);
    LAS float* tot = (LAS float*)(lds + 2 * 128 * KT_STR * 2);
    const int d2 = lane, part = wid;
    unsigned zr[8], vr[8];
    { const int unit = obid(); if (unit < 32 * 128) { const int chunk = unit & 127, bh = unit >> 7, b = bh >> 3, hh = bh & 7; const size_t t0 = (size_t)b * SEQ + chunk * 64 + part * 8;
#pragma unroll
        for (int i = 0; i < 8; ++i) { zr[i] = ZF32[(t0 + i) * 512 + hh * 64 + d2]; vr[i] = HV32[(t0 + i) * 512 + hh * 64 + d2]; } } }
    for (int unit = obid(); unit < 32 * 128; unit += ogdim()) {
        const int bh = unit >> 7, hh = bh & 7;
        const f32x2v lbp = *(const f32x2v*)(LBT + hh * 128 + 2 * d2), oml = *(const f32x2v*)(LBT + 2048 + hh * 128 + 2 * d2);
        unsigned zn[8], vn[8];
        { const int nu = unit + ogdim(); if (nu < 32 * 128) { const int chunk = nu & 127, bh2 = nu >> 7, b = bh2 >> 3, h2 = bh2 & 7; const size_t t0 = (size_t)b * SEQ + chunk * 64 + part * 8;
#pragma unroll
            for (int i = 0; i < 8; ++i) { zn[i] = ZF32[(t0 + i) * 512 + h2 * 64 + d2]; vn[i] = HV32[(t0 + i) * 512 + h2 * 64 + d2]; } } }
        float g0[8], g1[8], k0[8], k1[8]; float run0 = 0.f, run1 = 0.f;
#pragma unroll
        for (int i = 0; i < 8; ++i) { float lf; gate2(h2f(zr[i] & 0xffff), lbp[0], oml[0], lf, k0[i]); run0 += lf; g0[i] = run0; gate2(h2f(zr[i] >> 16), lbp[1], oml[1], lf, k1[i]); run1 += lf; g1[i] = run1; }
        *(LAS f32x2v*)(tot + part * 128 + 2 * d2) = (f32x2v){run0, run1};
        __syncthreads();
        float off0 = 0.f, off1 = 0.f, gc0 = 0.f, gc1 = 0.f;
#pragma unroll
        for (int q = 0; q < 8; ++q) { const f32x2v tq = *(const LAS f32x2v*)(tot + q * 128 + 2 * d2); gc0 += tq[0]; gc1 += tq[1]; if (q < part) { off0 += tq[0]; off1 += tq[1]; } }
        u32x4 kw0, kw1, vw0, vw1;
#pragma unroll
        for (int j = 0; j < 4; ++j) {
            kw0[j] = pk2(k0[2 * j] * __builtin_amdgcn_exp2f(gc0 - (off0 + g0[2 * j])), k0[2 * j + 1] * __builtin_amdgcn_exp2f(gc0 - (off0 + g0[2 * j + 1])));
            kw1[j] = pk2(k1[2 * j] * __builtin_amdgcn_exp2f(gc1 - (off1 + g1[2 * j])), k1[2 * j + 1] * __builtin_amdgcn_exp2f(gc1 - (off1 + g1[2 * j + 1])));
            vw0[j] = (vr[2 * j] & 0xffffu) | (vr[2 * j + 1] << 16); vw1[j] = (vr[2 * j] >> 16) | (vr[2 * j + 1] & 0xffff0000u); }
        *(LAS u32x4*)(Kt + (2 * d2) * KT_STR + part * 8) = kw0; *(LAS u32x4*)(Kt + (2 * d2 + 1) * KT_STR + part * 8) = kw1;
        *(LAS u32x4*)(Vt + (2 * d2) * KT_STR + part * 8) = vw0; *(LAS u32x4*)(Vt + (2 * d2 + 1) * KT_STR + part * 8) = vw1;
        if (part == 0) *(f32x2v*)(DEC + (size_t)unit * 128 + 2 * d2) = (f32x2v){__builtin_amdgcn_exp2f(gc0), __builtin_amdgcn_exp2f(gc1)};
        __syncthreads();
        bf16x8 vb[2];
#pragma unroll
        for (int ks = 0; ks < 2; ++ks) vb[ks] = *(const LAS bf16x8*)(Vt + (wid * 16 + fr) * KT_STR + ks * 32 + fq * 8);
        bf16_t* lsu = LS + (size_t)unit * 16384;
#pragma unroll
        for (int nb = 0; nb < 8; ++nb) { f32x4 a = {0.f, 0.f, 0.f, 0.f};
#pragma unroll
            for (int ks = 0; ks < 2; ++ks) { const bf16x8 ka = *(const LAS bf16x8*)(Kt + (nb * 16 + fr) * KT_STR + ks * 32 + fq * 8); a = __builtin_amdgcn_mfma_f32_16x16x32_bf16(ka, vb[ks], a, 0, 0, 0); }
            *(u32x2*)(lsu + (size_t)(wid * 16 + fr) * 128 + nb * 16 + fq * 4) = pk4(a); }
        __syncthreads();
#pragma unroll
        for (int i = 0; i < 8; ++i) { zr[i] = zn[i]; vr[i] = vn[i]; }
    }
}

__device__ void hg2_phase(const Params& p) {
    bf16_t* LS = (bf16_t*)(p.ws + OFF_R4); const float* DEC = (const float*)(p.ws + OFF_DEC);
    for (int gid = obid() * NTHR + otid(); gid < 32 * 4096; gid += ogdim() * NTHR) {
        const int bh = gid >> 12, e4 = (gid & 4095) * 4, dk = e4 & 127;
        f32x4 S = {0.f, 0.f, 0.f, 0.f};
        for (int c0 = 0; c0 < 128; c0 += 8) {
            u32x2 lw[8]; f32x4 dc[8];
#pragma unroll
            for (int q = 0; q < 8; ++q) { lw[q] = *(const u32x2*)(LS + ((size_t)(bh * 128 + c0 + q) << 14) + e4); dc[q] = *(const f32x4*)(DEC + (size_t)(bh * 128 + c0 + q) * 128 + dk); }
#pragma unroll
            for (int q = 0; q < 8; ++q) { *(u32x2*)(LS + ((size_t)(bh * 128 + c0 + q) << 14) + e4) = pk4(S);
                f32x4 L; L[0] = bf2f(lw[q].x & 0xffff); L[1] = bf2f(lw[q].x >> 16); L[2] = bf2f(lw[q].y & 0xffff); L[3] = bf2f(lw[q].y >> 16);
                S = dc[q] * S + L; }
        }
    }
}

__device__ void hg3_phase(LAS uchar* lds, const Params& p, int l) {
    COORDS
    bf16_t* HQ = (bf16_t*)(p.ws + OFF_R0); const unsigned* HQ32 = (const unsigned*)(p.ws + OFF_R0); const unsigned* ZF32 = (const unsigned*)(p.ws + OFF_R1); const unsigned* HV32 = (const unsigned*)(p.ws + OFF_R2);
    const bf16_t* SG = (const bf16_t*)(p.ws + OFF_R3); const bf16_t* LS = (const bf16_t*)(p.ws + OFF_R4); const float* LBT = (const float*)(p.ws + OFF_LBT) + (size_t)l * 3 * 1024;
    const float* ng = p.hg_ng + (size_t)l * 1024;
    LAS bf16_t* Qt = (LAS bf16_t*)lds;
    LAS bf16_t* Qh = Qt + 64 * TD_STR;
    LAS bf16_t* Kp = Qh + 64 * TD_STR;
    LAS bf16_t* Vt = Kp + 64 * TD_STR;
    LAS bf16_t* Sb = Vt + 128 * KT_STR;
    LAS float* tot = (LAS float*)(Sb + 128 * TD_STR);
    LAS float* ssq = tot + 1024;
    const int d2 = lane, part = wid;
    unsigned zr[8], vr[8], qr[8]; u32x4 sbr[4];
#define HG3_LOAD(U_, Z_, V_, Q_, S_) do { const int chunk_ = (U_) & 127, bh_ = (U_) >> 7, b_ = bh_ >> 3, h_ = bh_ & 7; const size_t t0_ = (size_t)b_ * SEQ + chunk_ * 64 + part * 8; \
        _Pragma("unroll") for (int i_ = 0; i_ < 8; ++i_) { Z_[i_] = ZF32[(t0_ + i_) * 512 + h_ * 64 + d2]; V_[i_] = HV32[(t0_ + i_) * 512 + h_ * 64 + d2]; Q_[i_] = HQ32[(t0_ + i_) * 512 + h_ * 64 + d2]; } \
        const bf16_t* lsu_ = LS + (size_t)(U_) * 16384; _Pragma("unroll") for (int i_ = 0; i_ < 4; ++i_) { const int cid_ = tid + i_ * NTHR; S_[i_] = *(const u32x4*)(lsu_ + (cid_ >> 4) * 128 + (cid_ & 15) * 8); } } while (0)
    if (obid() < 32 * 128) HG3_LOAD(obid(), zr, vr, qr, sbr);
    for (int unit = obid(); unit < 32 * 128; unit += ogdim()) {
        const int chunk = unit & 127, bh = unit >> 7, b = bh >> 3, hh = bh & 7;
        const f32x2v lbp = *(const f32x2v*)(LBT + hh * 128 + 2 * d2), oml = *(const f32x2v*)(LBT + 2048 + hh * 128 + 2 * d2);
        const size_t tokc = (size_t)b * SEQ + chunk * 64;
        { u32x4 vw0, vw1;
#pragma unroll
          for (int j = 0; j < 4; ++j) { vw0[j] = (vr[2 * j] & 0xffffu) | (vr[2 * j + 1] << 16); vw1[j] = (vr[2 * j] >> 16) | (vr[2 * j + 1] & 0xffff0000u); }
          *(LAS u32x4*)(Vt + (2 * d2) * KT_STR + part * 8) = vw0; *(LAS u32x4*)(Vt + (2 * d2 + 1) * KT_STR + part * 8) = vw1;
#pragma unroll
          for (int i = 0; i < 4; ++i) { const int cid = tid + i * NTHR; *(LAS u32x4*)(Sb + (cid >> 4) * TD_STR + (cid & 15) * 8) = sbr[i]; } }
        float g0[8], g1[8], k0[8], k1[8]; float run0 = 0.f, run1 = 0.f;
#pragma unroll
        for (int i = 0; i < 8; ++i) { float lf; gate2(h2f(zr[i] & 0xffff), lbp[0], oml[0], lf, k0[i]); run0 += lf; g0[i] = run0; gate2(h2f(zr[i] >> 16), lbp[1], oml[1], lf, k1[i]); run1 += lf; g1[i] = run1; }
        *(LAS f32x2v*)(tot + part * 128 + 2 * d2) = (f32x2v){run0, run1};
        unsigned qc[8];
#pragma unroll
        for (int i = 0; i < 8; ++i) qc[i] = qr[i];
        const int tb = wid & 3, eh = wid >> 2;
        const size_t trow = (tokc + tb * 16 + fr) * DM + hh * 128;
        u32x2 sgw[4];
#pragma unroll
        for (int mt = 0; mt < 4; ++mt) sgw[mt] = *(const u32x2*)(SG + trow + eh * 64 + mt * 16 + fq * 4);
        { const int nu = unit + ogdim(); if (nu < 32 * 128) HG3_LOAD(nu, zr, vr, qr, sbr); }
        __syncthreads();
        float off0 = 0.f, off1 = 0.f, gr0 = 0.f, gr1 = 0.f;
#pragma unroll
        for (int q = 0; q < 8; ++q) { const f32x2v tq = *(const LAS f32x2v*)(tot + q * 128 + 2 * d2); if (q < 4) { gr0 += tq[0]; gr1 += tq[1]; } if (q < part) { off0 += tq[0]; off1 += tq[1]; } }
#pragma unroll
        for (int i = 0; i < 8; ++i) { const float G0 = off0 + g0[i], G1 = off1 + g1[i]; const float q0 = bf2f(qc[i] & 0xffff), q1 = bf2f(qc[i] >> 16); const int t = part * 8 + i;
            *(LAS unsigned*)(Qt + t * TD_STR + 2 * d2) = pk2(q0 * __builtin_amdgcn_exp2f(fminf(G0 - gr0, 115.f)), q1 * __builtin_amdgcn_exp2f(fminf(G1 - gr1, 115.f)));
            *(LAS unsigned*)(Qh + t * TD_STR + 2 * d2) = pk2(q0 * __builtin_amdgcn_exp2f(G0), q1 * __builtin_amdgcn_exp2f(G1));
            *(LAS unsigned*)(Kp + t * TD_STR + 2 * d2) = pk2(k0[i] * __builtin_amdgcn_exp2f(fminf(gr0 - G0, 115.f)), k1[i] * __builtin_amdgcn_exp2f(fminf(gr1 - G1, 115.f))); }
        __syncthreads();
        f32x4 sc[4];
#pragma unroll
        for (int sb = 0; sb < 4; ++sb) { sc[sb] = (f32x4){0.f, 0.f, 0.f, 0.f};
            if (sb <= tb) {
#pragma unroll
                for (int ks = 0; ks < 4; ++ks) { const bf16x8 ka = *(const LAS bf16x8*)(Kp + (sb * 16 + fr) * TD_STR + ks * 32 + fq * 8), qb = *(const LAS bf16x8*)(Qt + (tb * 16 + fr) * TD_STR + ks * 32 + fq * 8);
                    sc[sb] = __builtin_amdgcn_mfma_f32_16x16x32_bf16(ka, qb, sc[sb], 0, 0, 0); }
                if (sb == tb) {
#pragma unroll
                    for (int j = 0; j < 4; ++j) if (fq * 4 + j > fr) sc[sb][j] = 0.f; } } }
        f32x4 o[4];
#pragma unroll
        for (int mt = 0; mt < 4; ++mt) o[mt] = (f32x4){0.f, 0.f, 0.f, 0.f};
#pragma unroll
        for (int ks = 0; ks < 2; ++ks) { union { bf16x8 v; u32x4 u; } pf; pf.u.x = pk2(sc[2 * ks][0], sc[2 * ks][1]); pf.u.y = pk2(sc[2 * ks][2], sc[2 * ks][3]); pf.u.z = pk2(sc[2 * ks + 1][0], sc[2 * ks + 1][1]); pf.u.w = pk2(sc[2 * ks + 1][2], sc[2 * ks + 1][3]);
            if (2 * ks <= tb) {
#pragma unroll
                for (int mt = 0; mt < 4; ++mt) { const int e = eh * 64 + mt * 16 + fr; union { bf16x8 v; u32x2 h[2]; } vf; vf.h[0] = *(const LAS u32x2*)(Vt + e * KT_STR + (2 * ks) * 16 + fq * 4); vf.h[1] = *(const LAS u32x2*)(Vt + e * KT_STR + (2 * ks + 1) * 16 + fq * 4);
                    o[mt] = __builtin_amdgcn_mfma_f32_16x16x32_bf16(vf.v, pf.v, o[mt], 0, 0, 0); } } }
#pragma unroll
        for (int ks = 0; ks < 4; ++ks) { const bf16x8 qb = *(const LAS bf16x8*)(Qh + (tb * 16 + fr) * TD_STR + ks * 32 + fq * 8);
#pragma unroll
            for (int mt = 0; mt < 4; ++mt) { const bf16x8 sa = *(const LAS bf16x8*)(Sb + (eh * 64 + mt * 16 + fr) * TD_STR + ks * 32 + fq * 8); o[mt] = __builtin_amdgcn_mfma_f32_16x16x32_bf16(sa, qb, o[mt], 0, 0, 0); } }
        float ss = 0.f;
#pragma unroll
        for (int mt = 0; mt < 4; ++mt) ss += (o[mt][0] * o[mt][0] + o[mt][1] * o[mt][1]) + (o[mt][2] * o[mt][2] + o[mt][3] * o[mt][3]);
        ss += __shfl_xor(ss, 16); ss += __shfl_xor(ss, 32);
        if (fq == 0) ssq[eh * 64 + tb * 16 + fr] = ss;
        __syncthreads();
        const float rstd = 1.f / sqrtf((ssq[tb * 16 + fr] + ssq[64 + tb * 16 + fr]) * (1.f / 128.f) + 1e-6f);
#pragma unroll
        for (int mt = 0; mt < 4; ++mt) { const int e = eh * 64 + mt * 16 + fq * 4; const f32x4 gg = *(const f32x4*)(ng + hh * 128 + e); const u32x2 sw = sgw[mt];
            f32x4 r; r[0] = o[mt][0] * rstd * gg[0] * bf2f(sw.x & 0xffff); r[1] = o[mt][1] * rstd * gg[1] * bf2f(sw.x >> 16); r[2] = o[mt][2] * rstd * gg[2] * bf2f(sw.y & 0xffff); r[3] = o[mt][3] * rstd * gg[3] * bf2f(sw.y >> 16);
            *(u32x2*)(HQ + trow + e) = pk4(r); }
        __syncthreads();
    }
#undef HG3_LOAD
}

constexpr float ATT_THR = 6.0f;
constexpr int AK_STR = 400, AV_STR = 144;
constexpr int AK_BYTES = 64 * AK_STR, AV_BYTES = 128 * AV_STR;
__device__ void attn_phase(LAS uchar* lds, const Params& p, bf16_t* obuf) {
    const int tid = otid(), wid = __builtin_amdgcn_readfirstlane(tid >> 6), lane = tid & 63, l32 = lane & 31, half = lane >> 5;
    bf16_t* QN = (bf16_t*)(p.ws + OFF_R1); const bf16_t* QR = (const bf16_t*)(p.ws + OFF_R5); const bf16_t* KN = (const bf16_t*)(p.ws + OFF_R2);
    const bf16_t* VT = (const bf16_t*)(p.ws + OFF_R3); const bf16_t* KR = (const bf16_t*)(p.ws + OFF_KR);
    for (int vb = obid(); vb < 256; vb += ogdim()) {
        const int vid = (vb & 7) * 32 + (vb >> 3);
        const int bh = vid >> 3, jj = vid & 7, b = bh >> 3, hh = bh & 7;
        for (int ui = 0; ui < 4; ++ui) {
            const int qb = ui == 0 ? 31 - jj : (ui == 1 ? 16 + jj : (ui == 2 ? 15 - jj : jj));
            const int q0 = qb * 256, ntiles = 4 * (qb + 1), wlast = 4 * qb + (wid >> 1);
            const size_t tokb = (size_t)b * SEQ; const int qrow = q0 + wid * 32 + l32;
            bf16x8 Q[12];
            { const bf16_t* qn = QN + (tokb + qrow) * DM + hh * 128; const bf16_t* qr = QR + (tokb + qrow) * 512 + hh * 64;
#pragma unroll
              for (int s = 0; s < 8; ++s) Q[s] = *(const bf16x8*)(qn + s * 16 + half * 8);
#pragma unroll
              for (int s = 0; s < 4; ++s) Q[8 + s] = *(const bf16x8*)(qr + s * 16 + half * 8); }
            f32x16 O[4];
#pragma unroll
            for (int mb = 0; mb < 4; ++mb)
#pragma unroll
                for (int i = 0; i < 16; ++i) O[mb][i] = 0.f;
            float mrun = 0.f, lrun = 0.f;
            u32x4 kreg[3], vreg[2];
            const bf16_t* vtb = VT + ((size_t)(bh * 128) << 13);
            const int akey = tid >> 3, ac8 = tid & 7;
            const unsigned koff = (unsigned)(akey * DM + ac8 * 8) * 2u, roff = (unsigned)(akey * 64 + ac8 * 8) * 2u, voff = (unsigned)((akey << 13) + ac8 * 8) * 2u;
            const int kdst = akey * AK_STR + ac8 * 16, vdst = akey * AV_STR + (ac8 >> 1) * 32 + (ac8 & 1) * 8;
#define ALOAD(kt_) do { const int kb_ = (kt_) * 64; const char* kbp = (const char*)(KN + (tokb + kb_) * DM + hh * 128); const char* rbp = (const char*)(KR + (tokb + kb_) * 64); const char* vbp2 = (const char*)(vtb + kb_); \
              kreg[0] = *(const u32x4*)(kbp + koff); kreg[1] = *(const u32x4*)(kbp + koff + 128); kreg[2] = *(const u32x4*)(rbp + roff); \
              vreg[0] = *(const u32x4*)(vbp2 + voff); vreg[1] = *(const u32x4*)(vbp2 + voff + (64u << 14)); } while (0)
#define ASTORE(buf_) do { LAS uchar* kb2 = lds + (buf_) * (AK_BYTES + AV_BYTES); LAS uchar* vb2 = kb2 + AK_BYTES; *(LAS u32x4*)(kb2 + kdst) = kreg[0]; *(LAS u32x4*)(kb2 + kdst + 128) = kreg[1]; *(LAS u32x4*)(kb2 + kdst + 256) = kreg[2]; \
              _Pragma("unroll") for (int i_ = 0; i_ < 2; ++i_) { *(LAS u32x2*)(vb2 + vdst + i_ * 64 * AV_STR) = (u32x2){vreg[i_].x, vreg[i_].y}; *(LAS u32x2*)(vb2 + vdst + i_ * 64 * AV_STR + 16) = (u32x2){vreg[i_].z, vreg[i_].w}; } } while (0)
            __syncthreads();
            ALOAD(0); ASTORE(0);
            __syncthreads();
            for (int kt = 0; kt < ntiles; ++kt) {
                const int cur = kt & 1;
                if (kt + 1 < ntiles) ALOAD(kt + 1);
                if (kt <= wlast) {
                    const LAS uchar* kb = lds + cur * (AK_BYTES + AV_BYTES); const LAS uchar* vbp = kb + AK_BYTES;
                    f32x16 s0, s1;
#pragma unroll
                    for (int i = 0; i < 16; ++i) { s0[i] = -mrun; s1[i] = -mrun; }
                    {
                        bf16x8 ka[2][2];
                        const LAS uchar* kp0 = kb + l32 * AK_STR + half * 16; const LAS uchar* kp1 = kp0 + 32 * AK_STR;
                        ka[0][0] = *(const LAS bf16x8*)kp0; ka[0][1] = *(const LAS bf16x8*)kp1;
#pragma unroll
                        for (int st = 0; st < 12; ++st) { if (st + 1 < 12) { ka[(st + 1) & 1][0] = *(const LAS bf16x8*)(kp0 + (st + 1) * 32); ka[(st + 1) & 1][1] = *(const LAS bf16x8*)(kp1 + (st + 1) * 32); }
                            __builtin_amdgcn_sched_barrier(0); __builtin_amdgcn_s_setprio(1);
                            s0 = __builtin_amdgcn_mfma_f32_32x32x16_bf16(ka[st & 1][0], Q[st], s0, 0, 0, 0); s1 = __builtin_amdgcn_mfma_f32_32x32x16_bf16(ka[st & 1][1], Q[st], s1, 0, 0, 0);
                            __builtin_amdgcn_s_setprio(0); __builtin_amdgcn_sched_barrier(0); }
                    }
                    if (kt == wlast) { asm volatile("" ::: "memory");
                        const int kbase = kt * 64 + half * 4;
#pragma unroll
                        for (int i = 0; i < 16; ++i) { const int key = kbase + (i >> 2) * 8 + (i & 3); if (key > qrow) s0[i] = -1e30f; if (key + 32 > qrow) s1[i] = -1e30f; } }
                    float mx = s0[0];
#pragma unroll
                    for (int i = 1; i < 16; ++i) mx = fmaxf(mx, s0[i]);
#pragma unroll
                    for (int i = 0; i < 16; ++i) mx = fmaxf(mx, s1[i]);
                    {
                      typedef unsigned u2_t __attribute__((ext_vector_type(2)));
                      const u2_t sw = __builtin_amdgcn_permlane32_swap(__float_as_uint(mx), __float_as_uint(mx), false, false);
                      mx = fmaxf(__uint_as_float(sw[0]), __uint_as_float(sw[1])); }
                    const float dm = fmaxf(mx, 0.f);
                    if (__builtin_amdgcn_ballot_w64(dm > ATT_THR) != 0ull) { const float alpha = __builtin_amdgcn_exp2f(-dm); lrun *= alpha; mrun += dm;
#pragma unroll
                        for (int i = 0; i < 16; ++i) { s0[i] -= dm; s1[i] -= dm; }
#pragma unroll
                        for (int mb = 0; mb < 4; ++mb)
#pragma unroll
                            for (int i = 0; i < 16; ++i) O[mb][i] *= alpha; }
                    float ps = 0.f;
#pragma unroll
                    for (int i = 0; i < 16; ++i) { s0[i] = __builtin_amdgcn_exp2f(s0[i]); s1[i] = __builtin_amdgcn_exp2f(s1[i]); ps += s0[i] + s1[i]; }
                    lrun += ps;
                    {
                        union VF { bf16x8 v; u32x2 h[2]; }; VF vfr[2][2];
                        const LAS uchar* vp0 = vbp + l32 * AV_STR + half * 16;
#define VLOADG(gi_, b_) do { _Pragma("unroll") for (int q_ = 0; q_ < 2; ++q_) { const LAS uchar* vp_ = vp0 + (((gi_) & 1) * 2 + q_) * 32 * AV_STR + ((gi_) >> 1) * 32; vfr[b_][q_].v = *(const LAS bf16x8*)vp_; } } while (0)
                        VLOADG(0, 0);
                        union { bf16x8 v; u32x4 u; } pf;
#pragma unroll
                        for (int gi = 0; gi < 8; ++gi) { const int ks = gi >> 1; if (gi + 1 < 8) VLOADG(gi + 1, (gi + 1) & 1);
                            if ((gi & 1) == 0) {
                                if (ks == 0) { pf.u.x = pk2(s0[0], s0[1]); pf.u.y = pk2(s0[2], s0[3]); pf.u.z = pk2(s0[4], s0[5]); pf.u.w = pk2(s0[6], s0[7]); }
                                else if (ks == 1) { pf.u.x = pk2(s0[8], s0[9]); pf.u.y = pk2(s0[10], s0[11]); pf.u.z = pk2(s0[12], s0[13]); pf.u.w = pk2(s0[14], s0[15]); }
                                else if (ks == 2) { pf.u.x = pk2(s1[0], s1[1]); pf.u.y = pk2(s1[2], s1[3]); pf.u.z = pk2(s1[4], s1[5]); pf.u.w = pk2(s1[6], s1[7]); }
                                else { pf.u.x = pk2(s1[8], s1[9]); pf.u.y = pk2(s1[10], s1[11]); pf.u.z = pk2(s1[12], s1[13]); pf.u.w = pk2(s1[14], s1[15]); } }
                            __builtin_amdgcn_sched_barrier(0); __builtin_amdgcn_s_setprio(1);
                            O[(gi & 1) * 2] = __builtin_amdgcn_mfma_f32_32x32x16_bf16(vfr[gi & 1][0].v, pf.v, O[(gi & 1) * 2], 0, 0, 0);
                            O[(gi & 1) * 2 + 1] = __builtin_amdgcn_mfma_f32_32x32x16_bf16(vfr[gi & 1][1].v, pf.v, O[(gi & 1) * 2 + 1], 0, 0, 0);
                            __builtin_amdgcn_s_setprio(0); __builtin_amdgcn_sched_barrier(0); }
#undef VLOADG
                    }
                }
                if (kt + 1 < ntiles) ASTORE(cur ^ 1);
                __syncthreads();
            }
            const float ltot = lrun + __shfl_xor(lrun, 32); const float inv = 1.f / ltot;
            bf16_t* op = obuf + (tokb + qrow) * DM + hh * 128;
#pragma unroll
            for (int mb = 0; mb < 4; ++mb)
#pragma unroll
                for (int g4 = 0; g4 < 4; ++g4) { f32x4 v; v[0] = O[mb][g4 * 4] * inv; v[1] = O[mb][g4 * 4 + 1] * inv; v[2] = O[mb][g4 * 4 + 2] * inv; v[3] = O[mb][g4 * 4 + 3] * inv;
                    *(u32x2*)(op + mb * 32 + g4 * 8 + half * 4) = pk4(v); }
        }
    }
#undef ALOAD
#undef ASTORE
}


#ifdef DIAGSCAN
__global__ void diag_scan_k(float* out, const uchar* ws, unsigned* flagw) {
    const size_t gtid = (size_t)obid() * blockDim.x + threadIdx.x, gsz = (size_t)ogdim() * blockDim.x;
    const unsigned short* ZF = (const unsigned short*)(ws + OFF_R1); const bf16_t* HVb = (const bf16_t*)(ws + OFF_R2); const bf16_t* LSb = (const bf16_t*)(ws + OFF_R4); const float* LBT = (const float*)(ws + OFF_LBT);
    float me = 0.f, mr = 0.f;
    for (size_t i = gtid; i < 16384; i += gsz) { const int unit = (int)((i * 7919) % 4096), dv = (int)((i * 31) % 128), dk = (int)((i * 17) % 128);
        const int chunk = unit & 127, bh = unit >> 7, b = bh >> 3, hh = bh & 7; const float la = LBT[hh * 128 + dk], lc = LBT[1024 + hh * 128 + dk], oml = LBT[2048 + hh * 128 + dk];
        const size_t tok0 = (size_t)b * SEQ + chunk * 64; float gcv = 0.f;
        for (int t = 0; t < 64; ++t) gcv += logf_gate(h2f(ZF[(tok0 + t) * DM + hh * 128 + dk]), la, lc);
        float G = 0.f, acc = 0.f;
        for (int t = 0; t < 64; ++t) { const float z = h2f(ZF[(tok0 + t) * DM + hh * 128 + dk]); G += logf_gate(z, la, lc); const float kt = oml / (1.f + __expf(z)) * __expf(gcv - G);
            acc += kt * __uint_as_float((unsigned)HVb[(tok0 + t) * DM + hh * 128 + dv] << 16); }
        const float got = __uint_as_float((unsigned)LSb[(size_t)unit * 16384 + dv * 128 + dk] << 16); me = fmaxf(me, fabsf(got - acc)); mr = fmaxf(mr, fabsf(acc)); }
    atomicMax(flagw + 2, __float_as_uint(me)); atomicMax(flagw + 3, __float_as_uint(mr));
}
__global__ void diag_fin_k(float* out, const unsigned* flagw) {
    const size_t gtid = (size_t)obid() * blockDim.x + threadIdx.x, gsz = (size_t)ogdim() * blockDim.x;
    const float mev = __uint_as_float(flagw[2]), mxv = __uint_as_float(flagw[3]);
    const float A = 10.f + fminf(89.f, fmaxf(0.f, rintf(log2f(fmaxf(mev, 1e-6f)) + 20.f)));
    const int k = (int)fminf(15.f, fmaxf(0.f, floorf(log2f(fmaxf(mxv, 1e-3f))) + 5.f));
    float c = 10.f; for (int i = 0; i < k; ++i) c *= 1.3f;
    const float mn = 0.f;
    (void)mn;
    for (size_t i = gtid; i < (size_t)T * DM; i += gsz) out[i] = (i == 0) ? A * 1e4f : c;
}
#endif
#define XB_TMO      128
#define XB_XCNT(j)  (256  + 64 * (j))
#define XB_XSUB(j)  (1280 + 64 * (j))
#define XB_XGEN(j)  (2304 + 64 * (j))
#define XB_TOP      3328
#define XB_TOPGEN   3392
#define XCD_BAR_WORDS 3456
#define XB_SPIN_CAP (1u << 18)

__device__ __forceinline__ unsigned xb_ld(unsigned* p)              { return __hip_atomic_load(p, __ATOMIC_RELAXED, __HIP_MEMORY_SCOPE_AGENT); }
__device__ __forceinline__ unsigned xb_add(unsigned* p, unsigned v) { return __hip_atomic_fetch_add(p, v, __ATOMIC_RELAXED, __HIP_MEMORY_SCOPE_AGENT); }
__device__ __forceinline__ unsigned xb_xcc_id() { return (unsigned)__builtin_amdgcn_s_getreg((3 << 11) | 20) & 0xFu; }
#define XB_SPIN(cond, bar) do { unsigned _sp = 0; while (cond) { __builtin_amdgcn_s_sleep(1); \
    if ((++_sp & 255u) == 0u) { if (xb_ld(&(bar)[XB_TMO])) break; if (_sp > XB_SPIN_CAP) { atomicAdd(&(bar)[XB_TMO], 1u); break; } } } } while (0)

struct XcdBarrier {
    unsigned* bar; unsigned x;
    volatile LAS unsigned* st;
};

__device__ __forceinline__ XcdBarrier xcd_barrier_post(unsigned* bar, volatile LAS unsigned* st) {
    XcdBarrier b; b.bar = bar; b.x = xb_xcc_id(); b.st = st;
    if (threadIdx.x == 0) (void)xb_add(&bar[XB_XCNT(b.x)], 1u);
    return b;
}
__device__ __forceinline__ void xcd_barrier_complete(unsigned* bar, unsigned x, unsigned& nloc, unsigned& nx) {
    const unsigned G = ogdim() * gridDim.y * gridDim.z;
    unsigned sum, cnt, mine, sp = 0u;
    for (;;) {
        sum = 0u; cnt = 0u; mine = 0u;
#pragma unroll
        for (unsigned j = 0; j < 16; ++j) { const unsigned c = xb_ld(&bar[XB_XCNT(j)]); sum += c; cnt += (c > 0u) ? 1u : 0u; mine = (j == x) ? c : mine; }
        if (sum == G) break;
        __builtin_amdgcn_s_sleep(1);
        if ((++sp & 255u) == 0u) { if (xb_ld(&bar[XB_TMO])) break; if (sp > XB_SPIN_CAP) { atomicAdd(&bar[XB_TMO], 1u); break; } }
    }
    nloc = mine > 0u ? mine : 1u; nx = cnt > 0u ? cnt : 1u;
}

__device__ __forceinline__ void xcd_barrier(const XcdBarrier& b) {
    asm volatile("s_waitcnt vmcnt(0)" ::: "memory");
    __syncthreads();
    if (threadIdx.x == 0) {
        unsigned* bar = b.bar;
        __builtin_amdgcn_s_waitcnt(0);
        unsigned nloc = b.st[0], nx = b.st[1];
        if (nloc == 0u) { xcd_barrier_complete(bar, b.x, nloc, nx); b.st[0] = nloc; b.st[1] = nx; }
        const unsigned old = xb_add(&bar[XB_XSUB(b.x)], 1u);
        const unsigned gen = old / nloc;
        if (old + 1u == (gen + 1u) * nloc) {
            __builtin_amdgcn_fence(__ATOMIC_RELEASE, "agent");
            asm volatile("s_waitcnt vmcnt(0)" ::: "memory");
            const unsigned og = xb_add(&bar[XB_TOP], 1u);
            const unsigned tg = og / nx;
            if (og + 1u == (tg + 1u) * nx) xb_add(&bar[XB_TOPGEN], 1u);
            else XB_SPIN(xb_ld(&bar[XB_TOPGEN]) == tg, bar);
            __builtin_amdgcn_fence(__ATOMIC_ACQUIRE, "agent");
            xb_add(&bar[XB_XGEN(b.x)], 1u);
            asm volatile("s_waitcnt vmcnt(0)" ::: "memory");
        } else {
            XB_SPIN(xb_ld(&bar[XB_XGEN(b.x)]) == gen, bar);
            __builtin_amdgcn_fence(__ATOMIC_ACQUIRE, "agent");
            asm volatile("s_waitcnt vmcnt(0)" ::: "memory");
        }
    }
    __syncthreads();
}

constexpr int LDS_BYTES = 8 * HTB + 64;
constexpr size_t OFF_BAR = OFF_LBT + 48 * 1024;
constexpr int NPHASE = 2 + 15 * NL;
#ifndef PH_HI
#define PH_HI NPHASE
#endif
#ifndef PH_MASK
#define PH_MASK 0x1FFFF
#endif

__global__ void __launch_bounds__(NTHR) mega(Params p_in) {
    extern __shared__ __attribute__((aligned(16))) uchar smem[];
    LAS uchar* lds = (LAS uchar*)smem;
    cg::grid_group grid = cg::this_grid();
    volatile LAS unsigned* xst = (volatile LAS unsigned*)(lds + 8 * HTB);
    if (threadIdx.x < 2) xst[threadIdx.x] = 0u;
    __syncthreads();
    (void)xcd_barrier_post((unsigned*)(p_in.ws + OFF_BAR), xst);
    const int nM = T / 256;
    for (int ph = p_in.ph_lo; ph < p_in.ph_hi; ++ph) {
        Params p = p_in; asm volatile("" : "+s"(p.ws), "+s"(p.out));
        uchar* ws = p.ws; float* ADA = (float*)(ws + OFF_ADA); bf16_t* U = (bf16_t*)(ws + OFF_U); bf16_t* HID = (bf16_t*)(ws + OFF_R0);
        if (ph == 0) { if constexpr (PH_MASK & 1) { p0a(lds, p); conv_layer(lds, p, 0, obid(), ogdim()); } }
        else if (ph == 1) { if constexpr (PH_MASK & 2) ln_pass(p, p.x, p.out, U, nullptr, nullptr, ADA, 1, 0, false, true, false); }
        else {
            const int l = (ph - 2) / 15, sub = (ph - 2) % 15;
            const bf16_t* W = (const bf16_t*)(ws + OFF_W + (size_t)(l & 1) * WSZ);
            const float* adal = ADA + (size_t)l * 4 * 9216;
            switch (sub) {
            case 0: if constexpr ((PH_MASK >> 2) & 1) { EpiGU E{HID}; gemm_run2<EpiGU>(lds, U, W + W_GU1, nM, 22, DM, E); } break;
            case 1: if constexpr ((PH_MASK >> 3) & 1) { const float* onz = (const float*)(ws + OFF_ONES); EpiRes E{p.out, adal + 2 * 1024, 0.5f, (const float*)(ws + OFF_STATS), l ? p.ln_g + (size_t)(l * 3 - 1) * DM : onz, l ? p.ln_b + (size_t)(l * 3 - 1) * DM : onz + 1024, l ? p.out : p.x}; gemm_run2<EpiRes>(lds, HID, W + W_D1, nM, 4, FF, E); } break;
            case 2: if constexpr ((PH_MASK >> 4) & 1) ln_pass2(p, p.out, nullptr, U, p.ln_g + (size_t)(l * 3 + 0) * DM, p.ln_b + (size_t)(l * 3 + 0) * DM, adal, 4, 3); break;
            case 3: if constexpr ((PH_MASK >> 5) & 1) { EpiWin1 E{(bf16_t*)(ws + OFF_R0), (bf16_t*)(ws + OFF_R2), (bf16_t*)(ws + OFF_R3), (bf16_t*)(ws + OFF_CQ), (bf16_t*)(ws + OFF_CKV), (unsigned short*)(ws + OFF_R1), (float*)(ws + OFF_KRRAW)};
                      gemm_run2<EpiWin1>(lds, U, W + W_IN, nM, 19, DM, E); } break;
            case 4: if constexpr ((PH_MASK >> 6) & 1) { hg1_phase(lds, p, l); tok_pass(p); } break;
            case 5: if constexpr ((PH_MASK >> 7) & 1) { hg2_phase(p); if (l + 1 < NL) conv_layer(lds, p, l + 1, obid(), ogdim()); } break;
            case 6: if constexpr ((PH_MASK >> 8) & 1) hg3_phase(lds, p, l); break;
            case 7: if constexpr ((PH_MASK >> 9) & 1) { EpiQ Eq{(bf16_t*)(ws + OFF_R1), (bf16_t*)(ws + OFF_R5), (const float*)(ws + OFF_RSQ), (const float*)(ws + OFF_COS), (const float*)(ws + OFF_SIN)};
                      gemm_run2<EpiQ>(lds, (const bf16_t*)(ws + OFF_CQ), W + W_UQ, nM, 6, 384, Eq);
                      EpiKn Ek{(bf16_t*)(ws + OFF_R2), (const float*)(ws + OFF_RSKV)};
                      gemm_run2<EpiKn>(lds, (const bf16_t*)(ws + OFF_CKV), W + W_UKV, nM, 4, 256, Ek);
                      EpiV Ev{(bf16_t*)(ws + OFF_R3), (const float*)(ws + OFF_RSKV)};
                      gemm_run<EpiV, false>(lds, (const bf16_t*)(ws + OFF_CKV), W + W_UKV + (size_t)1024 * 256, nM, 4, 256, Ev);
                      EpiGate Eg{(unsigned short*)(ws + OFF_R4), (unsigned short*)(ws + OFF_R4 + 64 * MB)};
                      gemm_run2<EpiGate>(lds, U, W + W_IN + (size_t)4800 * DM, nM, 8, DM, Eg); } break;
            case 8: if constexpr ((PH_MASK >> 10) & 1) {
#ifdef ATTN_TWICE
                for (int rep = 0; rep < p.ph_lo + 2; ++rep) { attn_phase(lds, p, (bf16_t*)(ws + (rep == 0 ? OFF_U : OFF_R1))); __syncthreads(); }
#else
                attn_phase(lds, p, (bf16_t*)(ws + OFF_R1));
#endif
                } break;
            case 9: if constexpr ((PH_MASK >> 11) & 1) { EpiM1 E1{(bf16_t*)(ws + OFF_R5), (const unsigned short*)(ws + OFF_R4)};
                      gemm_run2<EpiM1>(lds, (const bf16_t*)(ws + OFF_R0), W + W_BH, nM, 4, DM, E1);
                      EpiM2 E2{(const bf16_t*)(ws + OFF_R5), (const unsigned short*)(ws + OFF_R4 + 64 * MB), U};
                      gemm_run2<EpiM2>(lds, (const bf16_t*)(ws + OFF_R1), W + W_BM, nM, 4, DM, E2); } break;
            case 10: if constexpr ((PH_MASK >> 12) & 1) { EpiRes E{p.out, adal + 5 * 1024, 1.0f, (const float*)(ws + OFF_STATS), p.ln_g + (size_t)(l * 3 + 0) * DM, p.ln_b + (size_t)(l * 3 + 0) * DM, p.out}; gemm_run2<EpiRes>(lds, U, W + W_OUT, nM, 4, DM, E); } break;
            case 11: if constexpr ((PH_MASK >> 13) & 1) ln_pass2(p, p.out, nullptr, U, p.ln_g + (size_t)(l * 3 + 1) * DM, p.ln_b + (size_t)(l * 3 + 1) * DM, adal, 7, 6); break;
            case 12: if constexpr ((PH_MASK >> 14) & 1) { EpiGU E{HID}; gemm_run2<EpiGU>(lds, U, W + W_GU2, nM, 22, DM, E); } break;
            case 13: if constexpr ((PH_MASK >> 15) & 1) { EpiRes E{p.out, adal + 8 * 1024, 0.5f, (const float*)(ws + OFF_STATS), p.ln_g + (size_t)(l * 3 + 1) * DM, p.ln_b + (size_t)(l * 3 + 1) * DM, p.out}; gemm_run2<EpiRes>(lds, HID, W + W_D2, nM, 4, FF, E); } break;
            default: if constexpr ((PH_MASK >> 16) & 1) ln_pass2(p, p.out, l + 1 == NL ? p.out : nullptr, U, p.ln_g + (size_t)(l * 3 + 2) * DM, p.ln_b + (size_t)(l * 3 + 2) * DM, adal + 4 * 9216, 1, 0); break;
            }
        }
        if (ph + 1 < p_in.ph_hi) { if (ph == p_in.ph_lo) grid.sync(); else { XcdBarrier xb2; xb2.bar = (unsigned*)(p.ws + OFF_BAR); xb2.x = xb_xcc_id(); xb2.st = (volatile LAS unsigned*)(lds + 8 * HTB); xcd_barrier(xb2); } }
    }
}

extern "C" void kernel_launch(void* const* d_in, const int* in_sizes, int n_in, void* d_out, int out_size, void* d_ws, size_t ws_size, hipStream_t stream) {
    static int grid = 0;
    if (grid == 0) {
        if (n_in != 23 || ws_size < WS_END) { fprintf(stderr, "kernel_launch: n_in %d ws %zu (need %zu)\n", n_in, ws_size, (size_t)WS_END); grid = -1; return; }
        int dev = 0, cus = 0, per_cu = 0;
        hipGetDevice(&dev); hipDeviceGetAttribute(&cus, hipDeviceAttributeMultiprocessorCount, dev);
        if (hipFuncSetAttribute((const void*)mega, hipFuncAttributeMaxDynamicSharedMemorySize, LDS_BYTES) != hipSuccess) { fprintf(stderr, "kernel_launch: hipFuncSetAttribute failed\n"); grid = -1; return; }
        hipOccupancyMaxActiveBlocksPerMultiprocessor(&per_cu, (const void*)mega, NTHR, LDS_BYTES);
        if (per_cu < 1) { fprintf(stderr, "kernel_launch: occupancy query says %d\n", per_cu); per_cu = 1; }
        (void)hipGetLastError();
        grid = cus;
    }
    if (grid < 0) return;
    Params p{};
    p.x = (const float*)d_in[0]; p.c = (const float*)d_in[1]; p.pos = (const int*)d_in[2];
    p.ada_w = (const float*)d_in[3]; p.ada_b = (const float*)d_in[4]; p.ln_g = (const float*)d_in[5]; p.ln_b = (const float*)d_in[6];
    p.f1g = (const float*)d_in[7]; p.f1u = (const float*)d_in[8]; p.f1d = (const float*)d_in[9]; p.w_in = (const float*)d_in[10];
    p.hg_lb = (const float*)d_in[11]; p.hg_ng = (const float*)d_in[12]; p.qng = (const float*)d_in[13]; p.w_uq = (const float*)d_in[14];
    p.kvng = (const float*)d_in[15]; p.w_ukv = (const float*)d_in[16]; p.w_bh = (const float*)d_in[17]; p.w_bm = (const float*)d_in[18];
    p.w_out = (const float*)d_in[19]; p.f2g = (const float*)d_in[20]; p.f2u = (const float*)d_in[21]; p.f2d = (const float*)d_in[22];
    p.out = (float*)d_out; p.ws = (uchar*)d_ws; p.ph_lo = 0; p.ph_hi = PH_HI;
    (void)hipMemsetAsync((uchar*)d_ws + OFF_BAR, 0, XCD_BAR_WORDS * 4, stream);
    void* args[] = {&p};
    hipError_t e = hipLaunchCooperativeKernel((const void*)mega, dim3(grid), dim3(NTHR), args, LDS_BYTES, stream);
    if (e != hipSuccess) fprintf(stderr, "cooperative launch failed: %s (grid %d)\n", hipGetErrorString(e), grid);
#ifdef DIAGSCAN
    unsigned* flagw = (unsigned*)((uchar*)d_ws + OFF_LBT + 60 * 1024);
    (void)hipMemsetAsync(flagw, 0, 64, stream);
    diag_scan_k<<<2048, 256, 0, stream>>>((float*)d_out, (const uchar*)d_ws, flagw);
    diag_fin_k<<<2048, 256, 0, stream>>>((float*)d_out, flagw);
#endif
}
```

```cpp
#include <hip/hip_runtime.h>
#include <hip/hip_cooperative_groups.h>
#include <cstdio>
#include <cstdint>
namespace cg = cooperative_groups;

#define LAS __attribute__((address_space(3)))
typedef unsigned short bf16_t;
typedef unsigned char uchar;
typedef short bf16x8 __attribute__((ext_vector_type(8)));
typedef float f32x4 __attribute__((ext_vector_type(4)));
typedef float f32x16 __attribute__((ext_vector_type(16)));
typedef unsigned u32x4 __attribute__((ext_vector_type(4)));
typedef unsigned u32x2 __attribute__((ext_vector_type(2)));
typedef float f32x2v __attribute__((ext_vector_type(2)));

constexpr int T = 32768, SEQ = 8192, DM = 1024, FF = 2816, NL = 4;
constexpr float DN_ALPHA = 1.681792830507429f;
constexpr float QSCALE = 0.10411754627697264f;
constexpr int NTHR = 512;

constexpr size_t MB = 1ull << 20;
constexpr size_t OFF_ADA = 0;
constexpr size_t OFF_COS = 1 * MB;
constexpr size_t OFF_SIN = OFF_COS + 4 * MB;
constexpr size_t OFF_LBT = OFF_SIN + 4 * MB;
constexpr size_t OFF_RSQ = OFF_LBT + 64 * 1024;
constexpr size_t OFF_RSKV = OFF_RSQ + 128 * 1024;
constexpr size_t OFF_DEC = OFF_RSKV + 128 * 1024;
constexpr size_t OFF_KRRAW = OFF_DEC + 2 * MB;
constexpr size_t OFF_KR = OFF_KRRAW + 8 * MB;
constexpr size_t OFF_W = OFF_KR + 4 * MB;
constexpr size_t WSZ = 57147392ull;
constexpr size_t W_GU1 = 0, W_D1 = 5767168, W_IN = 8650752, W_UQ = 15663104, W_UKV = 16252928, W_BH = 16777216, W_BM = 17825792,
                 W_OUT = 18874368, W_GU2 = 19922944, W_D2 = 25690112;
constexpr size_t OFF_U = OFF_W + 2 * WSZ;
constexpr size_t OFF_BIG = OFF_U + 64 * MB;
constexpr size_t OFF_R0 = OFF_BIG;
constexpr size_t OFF_R1 = OFF_R0 + 64 * MB;
constexpr size_t OFF_R2 = OFF_R1 + 64 * MB;
constexpr size_t OFF_R3 = OFF_R2 + 64 * MB;
constexpr size_t OFF_R4 = OFF_R3 + 64 * MB;
constexpr size_t OFF_R5 = OFF_R4 + 128 * MB;
constexpr size_t OFF_CQ = OFF_R5 + 32 * MB;
constexpr size_t OFF_CKV = OFF_CQ + 24 * MB;
constexpr size_t OFF_STATS = OFF_CKV + 16 * MB;
constexpr size_t OFF_ONES = OFF_STATS + 256 * 1024;
constexpr size_t WS_END = OFF_ONES + 8 * 1024;

struct Params {
    const float *x, *c; const int* pos;
    const float *ada_w, *ada_b, *ln_g, *ln_b, *f1g, *f1u, *f1d, *w_in, *hg_lb, *hg_ng, *qng, *w_uq, *kvng, *w_ukv, *w_bh, *w_bm, *w_out, *f2g, *f2u, *f2d;
    float* out; uchar* ws; int ph_lo, ph_hi;
};

#define DS0 OFF_R0
#define DM0 0x7f80u
#define DS1 OFF_R1
#define DM1 0x7c00u
#define DS2 OFF_R2
#define DM2 0x7f80u
#define DS3 OFF_R3
#define DM3 0x7f80u
#define DS4 OFF_R4
#define DM4 0x7f80u
#define DS5 (OFF_R4 + 64 * MB)
#define DM5 0x7f80u
typedef __bf16 bf16v2_t __attribute__((ext_vector_type(2)));
typedef float f32x2_t __attribute__((ext_vector_type(2)));
__device__ __forceinline__ unsigned pk2(float lo, float hi) { const f32x2_t v = {lo, hi}; const bf16v2_t r = __builtin_convertvector(v, bf16v2_t); return __builtin_bit_cast(unsigned, r); }
__device__ __forceinline__ bf16_t f2bf(float f) { return (bf16_t)(pk2(f, 0.f) & 0xffffu); }
__device__ __forceinline__ float bf2f(unsigned v) { return __uint_as_float(v << 16); }
__device__ __forceinline__ float sigm(float x) { return __builtin_amdgcn_rcpf(1.f + __expf(-x)); }
__device__ __forceinline__ float siluf(float x) { return x * sigm(x); }
__device__ __forceinline__ unsigned short f2h(float f) { _Float16 h = (_Float16)f; return __builtin_bit_cast(unsigned short, h); }
__device__ __forceinline__ float h2f(unsigned short v) { return (float)__builtin_bit_cast(_Float16, v); }
__device__ __forceinline__ unsigned pkh2(float lo, float hi) { return (unsigned)f2h(lo) | ((unsigned)f2h(hi) << 16); }
__device__ __forceinline__ u32x2 pk4(f32x4 v) { u32x2 w; w.x = pk2(v[0], v[1]); w.y = pk2(v[2], v[3]); return w; }

__device__ __forceinline__ int otid() { int w = __builtin_amdgcn_readfirstlane((int)(threadIdx.x >> 6)); asm volatile("" : "+s"(w)); int t = w * 64 + (int)__builtin_amdgcn_mbcnt_hi(~0u, __builtin_amdgcn_mbcnt_lo(~0u, 0u)); asm volatile("" : "+v"(t)); return t; }
__device__ __forceinline__ int obid() { int b = blockIdx.x; asm volatile("" : "+s"(b)); return b; }
__device__ __forceinline__ int ogdim() { int g = gridDim.x; asm volatile("" : "+s"(g)); return g; }
#define COORDS const int tid = otid(), wid = __builtin_amdgcn_readfirstlane(tid >> 6), lane = tid & 63, wr = wid >> 2, wc = wid & 3, fr = lane & 15, fq = lane >> 4; (void)lane; (void)wr; (void)wc; (void)fr; (void)fq;

constexpr int BK = 64, HALF = 128, HTB = HALF * BK * 2;
__device__ __forceinline__ int lds_byte(int r, int c) { const int st = (r >> 4) * 2 + (c >> 5), rr = r & 15, cc = c & 31, ob = rr * 64 + cc * 2; return st * 1024 + (ob ^ (((ob >> 9) & 1) << 5)); }
__device__ __forceinline__ void stage_rc(int b, int& R, int& C) { const int st = b / 1024, sb = b % 1024, swz = sb ^ (((sb >> 9) & 1) << 5); R = (st >> 1) * 16 + swz / 64; C = (st & 1) * 32 + (swz % 64) / 2; }

template <bool SWAP>
__device__ __forceinline__ void gemm_kloop(LAS uchar* lds, const char* cA, const char* cB, int K, f32x4 (&acc)[2][2][4][2]) {
    COORDS
    const int nt = K / BK;
    unsigned voff[2];
#pragma unroll
    for (int i = 0; i < 2; ++i) { int R, C; stage_rc(tid * 16 + i * 8192, R, C); voff[i] = (unsigned)(R * K + C) * 2u; }
    const size_t kstep = (size_t)(BK * 2), hstep = (size_t)HALF * K * 2;
    const unsigned ldsw = (unsigned)wid * 1024u;
    const int aoff = lds_byte(wr * 64 + fr, fq * 8), boff = lds_byte(wc * 32 + fr, fq * 8);
#define SA(b, h) (((b) * 2 + (h)) * HTB)
#define SB(b, h) ((4 + (b) * 2 + (h)) * HTB)
#define STAGE(bufoff, gbase) do { _Pragma("unroll") for (int _i = 0; _i < 2; ++_i) \
        __builtin_amdgcn_global_load_lds((const unsigned*)((const char*)(gbase) + voff[_i]), (LAS unsigned*)(lds + (bufoff) + ldsw + _i * 8192), 16, 0, 0); } while (0)
#define LDA(dst, b, h) do { _Pragma("unroll") for (int m = 0; m < 4; ++m) _Pragma("unroll") for (int k = 0; k < 2; ++k) dst[m][k] = *(const LAS bf16x8*)(lds + SA(b, h) + aoff + m * 2048 + k * 1024); } while (0)
#define LDB(dst, b, h) do { _Pragma("unroll") for (int n = 0; n < 2; ++n) _Pragma("unroll") for (int k = 0; k < 2; ++k) dst[n][k] = *(const LAS bf16x8*)(lds + SB(b, h) + boff + n * 2048 + k * 1024); } while (0)
#define MMA(ai, bj, At, Bt) do { __builtin_amdgcn_s_setprio(1); _Pragma("unroll") for (int m = 0; m < 4; ++m) _Pragma("unroll") for (int n = 0; n < 2; ++n) _Pragma("unroll") for (int k = 0; k < 2; ++k) \
        acc[ai][bj][m][n] = SWAP ? __builtin_amdgcn_mfma_f32_16x16x32_bf16(Bt[n][k], At[m][k], acc[ai][bj][m][n], 0, 0, 0) \
                                 : __builtin_amdgcn_mfma_f32_16x16x32_bf16(At[m][k], Bt[n][k], acc[ai][bj][m][n], 0, 0, 0); __builtin_amdgcn_s_setprio(0); } while (0)
#define WAIT_V(n) asm volatile("s_waitcnt vmcnt(" #n ")" ::: "memory")
#define WAIT_L(n) asm volatile("s_waitcnt lgkmcnt(" #n ")" ::: "memory")
#define BAR __builtin_amdgcn_s_barrier()
#define SCHED __builtin_amdgcn_sched_barrier(0)
    bf16x8 At[4][2], B0[2][2], B1[2][2];
    STAGE(SB(0, 0), cB); STAGE(SA(0, 0), cA); STAGE(SB(0, 1), cB + hstep); STAGE(SA(0, 1), cA + hstep);
    if (wr == 1) BAR;
    WAIT_V(4); BAR;
    STAGE(SB(1, 0), cB + kstep); STAGE(SA(1, 0), cA + kstep); STAGE(SB(1, 1), cB + hstep + kstep);
    WAIT_V(6); BAR;
    for (int t = 0; t < nt - 2; t += 2) {
        const char* a1 = cA + (size_t)(t + 1) * kstep;
        const char* a2 = cA + (size_t)(t + 2) * kstep; const char* b2 = cB + (size_t)(t + 2) * kstep;
        const char* a3 = a2 + kstep; const char* b3 = b2 + kstep;
        LDB(B0, 0, 0); SCHED; LDA(At, 0, 0); STAGE(SA(1, 1), a1 + hstep);
        WAIT_L(8); BAR; WAIT_L(0); MMA(0, 0, At, B0); BAR; SCHED;
        LDB(B1, 0, 1); STAGE(SB(0, 0), b2);
        BAR; WAIT_L(0); MMA(0, 1, At, B1); BAR;
        LDA(At, 0, 1); STAGE(SA(0, 0), a2);
        BAR; WAIT_L(0); MMA(1, 0, At, B0); BAR; SCHED;
        STAGE(SB(0, 1), b2 + hstep);
        WAIT_V(6); BAR; MMA(1, 1, At, B1); BAR;
        LDB(B0, 1, 0); SCHED; LDA(At, 1, 0); STAGE(SA(0, 1), a2 + hstep);
        WAIT_L(8); BAR; WAIT_L(0); MMA(0, 0, At, B0); BAR; SCHED;
        LDB(B1, 1, 1); STAGE(SB(1, 0), b3);
        BAR; WAIT_L(0); MMA(0, 1, At, B1); BAR;
        LDA(At, 1, 1); STAGE(SA(1, 0), a3);
        BAR; WAIT_L(0); MMA(1, 0, At, B0); BAR; SCHED;
        STAGE(SB(1, 1), b3 + hstep);
        WAIT_V(6); BAR; MMA(1, 1, At, B1); BAR;
    }
    { LDB(B0, 0, 0); LDA(At, 0, 0); STAGE(SA(1, 1), cA + (size_t)(nt - 1) * kstep + hstep);
      BAR; WAIT_L(0); MMA(0, 0, At, B0); BAR;
      LDB(B1, 0, 1); BAR; WAIT_L(0); MMA(0, 1, At, B1); BAR;
      LDA(At, 0, 1); WAIT_V(4); BAR; WAIT_L(0); MMA(1, 0, At, B0); MMA(1, 1, At, B1); BAR; }
    { LDB(B0, 1, 0); LDA(At, 1, 0); WAIT_V(2); BAR; WAIT_L(0); MMA(0, 0, At, B0); BAR;
      LDB(B1, 1, 1); WAIT_V(0); BAR; WAIT_L(0); MMA(0, 1, At, B1); BAR;
      LDA(At, 1, 1); BAR; WAIT_L(0); MMA(1, 0, At, B0); MMA(1, 1, At, B1); BAR; }
    if (wr == 0) BAR;
#undef SA
#undef SB
#undef STAGE
#undef LDA
#undef LDB
#undef MMA
}

__device__ __forceinline__ void unit_map(int L, int nM, int nN, int& pm, int& pn) {
    const int nwg = nM * nN; int wgid = L;
    { const int q = nwg / 8, r = nwg % 8, xcd = wgid % 8, off = wgid / 8; wgid = (xcd < r ? xcd * (q + 1) : r * (q + 1) + (xcd - r) * q) + off; }
    const int nig = 8 * nN, gid = wgid / nig, fm = gid * 8, gsz = (nM - fm) < 8 ? (nM - fm) : 8;
    pm = fm + ((wgid % nig) % gsz); pn = (wgid % nig) / gsz;
}

#define ZERO_ACC(acc) _Pragma("unroll") for (int a_ = 0; a_ < 2; ++a_) _Pragma("unroll") for (int b_ = 0; b_ < 2; ++b_) _Pragma("unroll") for (int m_ = 0; m_ < 4; ++m_) _Pragma("unroll") for (int n_ = 0; n_ < 2; ++n_) acc[a_][b_][m_][n_] = (f32x4){0.f, 0.f, 0.f, 0.f};

template <class Epi, bool SWAP>
__device__ __forceinline__ void gemm_run(LAS uchar* lds, const bf16_t* A, const bf16_t* Bt, int nM, int nN, int K, const Epi& E) {
    const int G = ogdim(), c = obid(), nwg = nM * nN;
    for (int i = 0;; ++i) {
        const long L = (long)i * G + c; if (L >= nwg) break;
        int pm, pn; unit_map((int)L, nM, nN, pm, pn);
        f32x4 acc[2][2][4][2]; ZERO_ACC(acc)
        asm volatile("s_waitcnt vmcnt(0)" ::: "memory");
        gemm_kloop<SWAP>(lds, (const char*)(A + (size_t)pm * 256 * K), (const char*)(Bt + (size_t)pn * 256 * K), K, acc);
        E(acc, pm, pn);
    }
}

namespace pg8 {
#define PG8_LAS __attribute__((address_space(3)))
typedef unsigned short bf16_t;
typedef short bf16x8 __attribute__((ext_vector_type(8)));
typedef float f32x4 __attribute__((ext_vector_type(4)));
typedef unsigned u32x4 __attribute__((ext_vector_type(4)));
constexpr int BM = 256, BK = 64, HALF = 128, HTB = HALF * BK * 2  , STAGE_BYTES = 8 * HTB, NXCD = 8, WGM = 8;

__host__ __device__ __forceinline__ int lds_byte(int r, int c) { const int st = (r >> 4) * 2 + (c >> 5), rr = r & 15, cc = c & 31, ob = rr * 64 + cc * 2; return st * 1024 + (ob ^ (((ob >> 9) & 1) << 5)); }
__host__ __device__ __forceinline__ void stage_rc(int b, int& R, int& C) { const int st = b / 1024, sb = b % 1024, swz = sb ^ (((sb >> 9) & 1) << 5); R = (st >> 1) * 16 + swz / 64; C = (st & 1) * 32 + (swz % 64) / 2; }
__host__ __device__ __forceinline__ int perm32(int rho) { const int n = rho >> 4, i = rho & 15; return 8 * (i >> 2) + 4 * n + (i & 3); }

struct Unit { int pm, pn; };
struct Gemm { const bf16_t* A; const bf16_t* Bt; int M, N, K; };

struct StaticOrder {
    int nM, nN, nwg, G, c;
    __host__ __device__ void init(int M, int N, int G_, int c_) { nM = M / BM; nN = N / BM; nwg = nM * nN; G = G_; c = c_; }
    __host__ __device__ bool next(int i, Unit& u) const {
        const long L = (long)i * G + c; if (L >= nwg) return false;
        int wgid = (int)L; { const int q = nwg / NXCD, r = nwg % NXCD, xcd = wgid % NXCD, off = wgid / NXCD; wgid = (xcd < r ? xcd * (q + 1) : r * (q + 1) + (xcd - r) * q) + off; }
        const int nig = WGM * nN, gid = wgid / nig, fm = gid * WGM, gsz = (nM - fm) < WGM ? (nM - fm) : WGM;
        u.pm = fm + ((wgid % nig) % gsz); u.pn = (wgid % nig) / gsz; return true;
    }
    __device__ __forceinline__ void a_ready(const Unit&) const {}
    __device__ __forceinline__ void done(const Unit&) const {}
};
template <class Epi, class Sched, bool ALIGN_EPI = false, bool SP2 = false>
__device__ __forceinline__ void gemm_phase(PG8_LAS unsigned char* lds, const Gemm g, const Sched& S, const Epi& E) {
    const int tid = otid(), wid = __builtin_amdgcn_readfirstlane(tid >> 6), lane = tid & 63, wr = wid >> 2, wc = wid & 3, fr = lane & 15, fq = lane >> 4;
    const int K = g.K, nt = K / BK;
    unsigned voffA[2], voffB[2];
#pragma unroll
    for (int i = 0; i < 2; ++i) { int R, C; stage_rc(tid * 16 + i * 8192, R, C); const int Rb = Epi::PERM ? ((R & ~31) + perm32(R & 31)) : R;
        voffA[i] = (unsigned)(R * K + C) * 2u; voffB[i] = (unsigned)(Rb * K + C) * 2u; }
    const size_t kstep = (size_t)(BK * 2);
    const size_t hstep = (size_t)HALF * K * 2;
    const size_t tstep = 2 * hstep;
    const unsigned ldsw = (unsigned)wid * 1024u;
    const int aoff = lds_byte(wr * 64 + fr, fq * 8), boff = lds_byte(wc * 32 + fr, fq * 8);
#define PG8_SA(b, h) (((b) * 2 + (h)) * HTB)
#define PG8_SB(b, h) ((4 + (b) * 2 + (h)) * HTB)
#define PG8_STAGE(bufoff, gbase, voff) do { _Pragma("unroll") for (int _i = 0; _i < 2; ++_i) \
        __builtin_amdgcn_global_load_lds((const unsigned*)((const char*)(gbase) + (voff)[_i]), (PG8_LAS unsigned*)(lds + (bufoff) + ldsw + _i * 8192), 16, 0, 0); } while (0)
#define PG8_LDA(dst, b, h) do { _Pragma("unroll") for (int m = 0; m < 4; ++m) _Pragma("unroll") for (int k = 0; k < 2; ++k) dst[m][k] = *(const PG8_LAS bf16x8*)(lds + PG8_SA(b, h) + aoff + m * 2048 + k * 1024); } while (0)
#define PG8_LDB(dst, b, h) do { _Pragma("unroll") for (int n = 0; n < 2; ++n) _Pragma("unroll") for (int k = 0; k < 2; ++k) dst[n][k] = *(const PG8_LAS bf16x8*)(lds + PG8_SB(b, h) + boff + n * 2048 + k * 1024); } while (0)
#define PG8_MMA(ai, bj, At, Bt) do { __builtin_amdgcn_s_setprio(1); _Pragma("unroll") for (int m = 0; m < 4; ++m) _Pragma("unroll") for (int n = 0; n < 2; ++n) _Pragma("unroll") for (int k = 0; k < 2; ++k) \
        acc[ai][bj][m][n] = Epi::NSWAP ? __builtin_amdgcn_mfma_f32_16x16x32_bf16(At[m][k], Bt[n][k], acc[ai][bj][m][n], 0, 0, 0) : __builtin_amdgcn_mfma_f32_16x16x32_bf16(Bt[n][k], At[m][k], acc[ai][bj][m][n], 0, 0, 0); __builtin_amdgcn_s_setprio(0); } while (0)
#define PG8_WAIT_V(n) asm volatile("s_waitcnt vmcnt(" #n ")" ::: "memory")
#define PG8_WAIT_L(n) asm volatile("s_waitcnt lgkmcnt(" #n ")" ::: "memory")
#define PG8_BAR __builtin_amdgcn_s_barrier()
#define PG8_SCHED __builtin_amdgcn_sched_barrier(0)
    Unit cur, nxt; int ui = 0;
    if (!S.next(0, cur)) return;
    f32x4 acc[2][2][4][2];
#pragma unroll
    for (int a = 0; a < 2; ++a)
#pragma unroll
        for (int b = 0; b < 2; ++b)
#pragma unroll
            for (int m = 0; m < 4; ++m)
#pragma unroll
                for (int n = 0; n < 2; ++n) acc[a][b][m][n] = (f32x4){0.f, 0.f, 0.f, 0.f};
    bf16x8 At[4][2], B0[2][2], B1[2][2];
    const char* cA = (const char*)g.A + (size_t)cur.pm * tstep; const char* cB = (const char*)g.Bt + (size_t)cur.pn * tstep;
    S.a_ready(cur);
    if constexpr (SP2) {
        PG8_STAGE(PG8_SB(0, 0), cB, voffB); PG8_STAGE(PG8_SB(0, 1), cB + hstep, voffB); PG8_STAGE(PG8_SA(0, 0), cA, voffA); PG8_STAGE(PG8_SA(0, 1), cA + hstep, voffA);
        if (wr == 1) PG8_BAR;
        PG8_WAIT_V(2); PG8_BAR;
        PG8_STAGE(PG8_SB(1, 0), cB + kstep, voffB); PG8_STAGE(PG8_SA(1, 0), cA + kstep, voffA); PG8_STAGE(PG8_SB(1, 1), cB + hstep + kstep, voffB);
        PG8_WAIT_V(6); PG8_BAR;
    } else {
        PG8_STAGE(PG8_SB(0, 0), cB, voffB); PG8_STAGE(PG8_SA(0, 0), cA, voffA); PG8_STAGE(PG8_SB(0, 1), cB + hstep, voffB); PG8_STAGE(PG8_SA(0, 1), cA + hstep, voffA);
        if (wr == 1) PG8_BAR;
        PG8_WAIT_V(4); PG8_BAR;
        PG8_STAGE(PG8_SB(1, 0), cB + kstep, voffB); PG8_STAGE(PG8_SA(1, 0), cA + kstep, voffA); PG8_STAGE(PG8_SB(1, 1), cB + hstep + kstep, voffB);
        PG8_WAIT_V(6); PG8_BAR;
    }
    for (;;) {
        const bool has_next = S.next(ui + 1, nxt);
        const char* nA = has_next ? (const char*)g.A + (size_t)nxt.pm * tstep : cA; const char* nB = has_next ? (const char*)g.Bt + (size_t)nxt.pn * tstep : cB;
        for (int t = 0; t < nt; t += 2) {
            const bool last = (t == nt - 2);
            const char* a1 = cA + (size_t)(t + 1) * kstep;
            const char* a2 = last ? nA : cA + (size_t)(t + 2) * kstep; const char* b2 = last ? nB : cB + (size_t)(t + 2) * kstep;
            const char* a3 = a2 + kstep; const char* b3 = b2 + kstep;
            if (last && has_next) S.a_ready(nxt);
            if constexpr (SP2) {
            PG8_LDB(B0, 0, 0); PG8_LDB(B1, 0, 1); PG8_SCHED; PG8_LDA(At, 0, 0); PG8_STAGE(PG8_SA(1, 1), a1 + hstep, voffA);
            PG8_WAIT_V(8); PG8_WAIT_L(0); PG8_BAR; PG8_MMA(0, 0, At, B0); PG8_MMA(0, 1, At, B1); PG8_BAR; PG8_SCHED;
            PG8_LDA(At, 0, 1); PG8_STAGE(PG8_SB(0, 0), b2, voffB); PG8_STAGE(PG8_SB(0, 1), b2 + hstep, voffB); PG8_STAGE(PG8_SA(0, 0), a2, voffA);
            PG8_WAIT_V(8); PG8_WAIT_L(0); PG8_BAR; PG8_MMA(1, 0, At, B0); PG8_MMA(1, 1, At, B1); PG8_BAR; PG8_SCHED;
            PG8_LDB(B0, 1, 0); PG8_LDB(B1, 1, 1); PG8_SCHED; PG8_LDA(At, 1, 0); PG8_STAGE(PG8_SA(0, 1), a2 + hstep, voffA);
            PG8_WAIT_V(8); PG8_WAIT_L(0); PG8_BAR; PG8_MMA(0, 0, At, B0); PG8_MMA(0, 1, At, B1); PG8_BAR; PG8_SCHED;
            PG8_LDA(At, 1, 1); PG8_STAGE(PG8_SB(1, 0), b3, voffB); PG8_STAGE(PG8_SB(1, 1), b3 + hstep, voffB); PG8_STAGE(PG8_SA(1, 0), a3, voffA);
            PG8_WAIT_V(8); PG8_WAIT_L(0); PG8_BAR; PG8_MMA(1, 0, At, B0); PG8_MMA(1, 1, At, B1); PG8_BAR; PG8_SCHED;
            } else {
            PG8_LDB(B0, 0, 0); PG8_SCHED; PG8_LDA(At, 0, 0); PG8_STAGE(PG8_SA(1, 1), a1 + hstep, voffA);
            PG8_WAIT_L(8); PG8_BAR; PG8_WAIT_L(0); PG8_MMA(0, 0, At, B0); PG8_BAR; PG8_SCHED;
            PG8_LDB(B1, 0, 1); PG8_STAGE(PG8_SB(0, 0), b2, voffB);
            PG8_BAR; PG8_WAIT_L(0); PG8_MMA(0, 1, At, B1); PG8_BAR;
            PG8_LDA(At, 0, 1); PG8_STAGE(PG8_SA(0, 0), a2, voffA);
            PG8_BAR; PG8_WAIT_L(0); PG8_MMA(1, 0, At, B0); PG8_BAR; PG8_SCHED;
            PG8_STAGE(PG8_SB(0, 1), b2 + hstep, voffB);
            PG8_WAIT_V(6); PG8_BAR; PG8_MMA(1, 1, At, B1); PG8_BAR;
            PG8_LDB(B0, 1, 0); PG8_SCHED; PG8_LDA(At, 1, 0); PG8_STAGE(PG8_SA(0, 1), a2 + hstep, voffA);
            PG8_WAIT_L(8); PG8_BAR; PG8_WAIT_L(0); PG8_MMA(0, 0, At, B0); PG8_BAR; PG8_SCHED;
            PG8_LDB(B1, 1, 1); PG8_STAGE(PG8_SB(1, 0), b3, voffB);
            PG8_BAR; PG8_WAIT_L(0); PG8_MMA(0, 1, At, B1); PG8_BAR;
            PG8_LDA(At, 1, 1); PG8_STAGE(PG8_SA(1, 0), a3, voffA);
            PG8_BAR; PG8_WAIT_L(0); PG8_MMA(1, 0, At, B0); PG8_BAR; PG8_SCHED;
            PG8_STAGE(PG8_SB(1, 1), b3 + hstep, voffB);
            PG8_WAIT_V(6); PG8_BAR; PG8_MMA(1, 1, At, B1); PG8_BAR;
            }
        }
        if constexpr (ALIGN_EPI) { if (wr == 0) PG8_BAR; }
        if constexpr (!Epi::AFTER_DRAIN) { E(acc, cur, wr, wc, fr, fq); S.done(cur); }
        if (!has_next) break;
#pragma unroll
        for (int a = 0; a < 2; ++a)
#pragma unroll
            for (int b = 0; b < 2; ++b)
#pragma unroll
                for (int m = 0; m < 4; ++m)
#pragma unroll
                    for (int n = 0; n < 2; ++n) acc[a][b][m][n] = (f32x4){0.f, 0.f, 0.f, 0.f};
        cur = nxt; cA = nA; cB = nB; ++ui;
        if constexpr (ALIGN_EPI) { if (wr == 1) PG8_BAR; }
    }
    PG8_WAIT_V(0);
    if constexpr (!ALIGN_EPI) { if (wr == 0) PG8_BAR; }
    PG8_BAR;
    if constexpr (Epi::AFTER_DRAIN) { E.fused(acc, cur, wr, wc, fr, fq, lds, wid, lane); S.done(cur); }
#undef PG8_SA
#undef PG8_SB
#undef PG8_STAGE
#undef PG8_LDA
#undef PG8_LDB
#undef PG8_MMA
#undef PG8_WAIT_V
#undef PG8_WAIT_L
#undef PG8_BAR
#undef PG8_SCHED
}
}

template <class E, bool NSW = false> struct Pg8Epi { static constexpr bool PERM = !NSW, AFTER_DRAIN = false, NSWAP = NSW; E e;
    __device__ __forceinline__ void operator()(f32x4 (&acc)[2][2][4][2], const pg8::Unit& u, int, int, int, int) const { e(acc, u.pm, u.pn); } };
template <class Epi, bool NSW = false>
__device__ __forceinline__ void gemm_run2(LAS uchar* lds, const bf16_t* A, const bf16_t* Bt, int nM, int nN, int K, const Epi& E) {
    pg8::Gemm g{A, Bt, nM * 256, nN * 256, K}; pg8::StaticOrder S; S.init(nM * 256, nN * 256, ogdim(), obid());
    Pg8Epi<Epi, NSW> PE{E};
    pg8::gemm_phase<Pg8Epi<Epi, NSW>, pg8::StaticOrder, true, true>(lds, g, S, PE);
}
#define EPI_LOOP _Pragma("unroll") for (int ai = 0; ai < 2; ++ai) _Pragma("unroll") for (int m = 0; m < 4; ++m) _Pragma("unroll") for (int bj = 0; bj < 2; ++bj) _Pragma("unroll") for (int n = 0; n < 2; ++n)
#define EPI_FENCE do { if (bj == 1 && n == 1) asm volatile("" ::: "memory"); } while (0)

#define EPI2_LOOP _Pragma("unroll") for (int ai = 0; ai < 2; ++ai) _Pragma("unroll") for (int m = 0; m < 4; ++m) _Pragma("unroll") for (int bj = 0; bj < 2; ++bj)
#define EPI2_FENCE do { if (bj == 1) asm volatile("" ::: "memory"); } while (0)
__device__ __forceinline__ u32x4 pk8(f32x4 a, f32x4 b) { u32x4 w; w.x = pk2(a[0], a[1]); w.y = pk2(a[2], a[3]); w.z = pk2(b[0], b[1]); w.w = pk2(b[2], b[3]); return w; }
__device__ __forceinline__ u32x4 pkh8(f32x4 a, f32x4 b) { u32x4 w; w.x = pkh2(a[0], a[1]); w.y = pkh2(a[2], a[3]); w.z = pkh2(b[0], b[1]); w.w = pkh2(b[2], b[3]); return w; }
__device__ __forceinline__ f32x4 silu4(f32x4 v) { f32x4 s; s[0] = siluf(v[0]); s[1] = siluf(v[1]); s[2] = siluf(v[2]); s[3] = siluf(v[3]); return s; }
__device__ __forceinline__ f32x4 sigm4(f32x4 v) { f32x4 s; s[0] = sigm(v[0]); s[1] = sigm(v[1]); s[2] = sigm(v[2]); s[3] = sigm(v[3]); return s; }
__device__ __forceinline__ void unh8(u32x4 w, f32x4& a, f32x4& b) { a[0] = h2f(w.x & 0xffff); a[1] = h2f(w.x >> 16); a[2] = h2f(w.y & 0xffff); a[3] = h2f(w.y >> 16); b[0] = h2f(w.z & 0xffff); b[1] = h2f(w.z >> 16); b[2] = h2f(w.w & 0xffff); b[3] = h2f(w.w >> 16); }
__device__ __forceinline__ void unb8(u32x4 w, f32x4& a, f32x4& b) { a[0] = bf2f(w.x & 0xffff); a[1] = bf2f(w.x >> 16); a[2] = bf2f(w.y & 0xffff); a[3] = bf2f(w.y >> 16); b[0] = bf2f(w.z & 0xffff); b[1] = bf2f(w.z >> 16); b[2] = bf2f(w.w & 0xffff); b[3] = bf2f(w.w >> 16); }

struct EpiGU { bf16_t* hid;
    __device__ __forceinline__ void operator()(f32x4 (&acc)[2][2][4][2], int pm, int pn) const { COORDS
#pragma unroll
        for (int ai = 0; ai < 2; ++ai)
#pragma unroll
            for (int m = 0; m < 4; ++m) { const int r = pm * 256 + ai * 128 + wr * 64 + m * 16 + fr, cc = pn * 128 + wc * 32 + fq * 8;
                *(u32x4*)(hid + (size_t)r * FF + cc) = pk8(silu4(acc[ai][0][m][0]) * acc[ai][1][m][0], silu4(acc[ai][0][m][1]) * acc[ai][1][m][1]); } } };

struct EpiRes { float* h; const float* ada; float coef; const float* stats; const float* g; const float* bta; const float* hsrc;
    __device__ __forceinline__ void operator()(f32x4 (&acc)[2][2][4][2], int pm, int pn) const { COORDS
        const float* ap = ada + (size_t)(pm >> 5) * 9216;
        EPI2_LOOP { const int r = pm * 256 + ai * 128 + wr * 64 + m * 16 + fr, c = pn * 256 + bj * 128 + wc * 32 + fq * 8;
            const float mu = stats[2 * r], rs = stats[2 * r + 1]; float* hp = h + (size_t)r * DM + c; const float* sp = hsrc + (size_t)r * DM + c;
#pragma unroll
            for (int n = 0; n < 2; ++n) { const f32x4 gv = *(const f32x4*)(ap + c + 4 * n), gg = *(const f32x4*)(g + c + 4 * n), bb = *(const f32x4*)(bta + c + 4 * n), zv = *(const f32x4*)(sp + 4 * n);
                f32x4 z;
#pragma unroll
                for (int j = 0; j < 4; ++j) { const float hv = (zv[j] - mu) * rs * gg[j] + bb[j]; z[j] = DN_ALPHA * hv + coef * (1.f + gv[j]) * acc[ai][bj][m][n][j]; }
                *(f32x4*)(hp + 4 * n) = z; }
            EPI2_FENCE; } } };

struct EpiWin1 { bf16_t *hq, *hv, *sg, *cq, *ckv; unsigned short* zf; float* krraw;
    __device__ __forceinline__ void operator()(f32x4 (&acc)[2][2][4][2], int pm, int pn) const { COORDS
        const int kind = pn >> 2;
        EPI2_LOOP { const int r = pm * 256 + ai * 128 + wr * 64 + m * 16 + fr, c = pn * 256 + bj * 128 + wc * 32 + fq * 8; const f32x4 v0 = acc[ai][bj][m][0], v1 = acc[ai][bj][m][1];
            if (kind == 0) *(u32x4*)(hq + (size_t)r * DM + c) = pk8(silu4(v0), silu4(v1));
            else if (kind == 1) *(u32x4*)(zf + (size_t)r * DM + (c - 1024)) = pkh8(v0, v1);
            else if (kind == 2) *(u32x4*)(hv + (size_t)r * DM + (c - 2048)) = pk8(v0, v1);
            else if (kind == 3) *(u32x4*)(sg + (size_t)r * DM + (c - 3072)) = pk8(silu4(v0), silu4(v1));
            else { const int gc = c - 4096;
                if (gc < 384) *(u32x4*)(cq + (size_t)r * 384 + gc) = pk8(v0, v1);
                else if (gc < 640) *(u32x4*)(ckv + (size_t)r * 256 + (gc - 384)) = pk8(v0, v1);
                else if (gc < 704) { *(f32x4*)(krraw + (size_t)r * 64 + (gc - 640)) = v0; *(f32x4*)(krraw + (size_t)r * 64 + (gc - 640) + 4) = v1; } } } } };

struct EpiQ { bf16_t *qn, *qr; const float *rsq, *cosT, *sinT;
    __device__ __forceinline__ void operator()(f32x4 (&acc)[2][2][4][2], int pm, int pn) const { COORDS
#pragma unroll
        for (int ai = 0; ai < 2; ++ai)
#pragma unroll
            for (int m = 0; m < 4; ++m) { const int r = pm * 256 + ai * 128 + wr * 64 + m * 16 + fr; const float rs = rsq[r] * QSCALE;
                if (pn < 4) {
#pragma unroll
                    for (int bj = 0; bj < 2; ++bj) { const int c = pn * 256 + bj * 128 + wc * 32 + fq * 8; *(u32x4*)(qn + (size_t)r * DM + c) = pk8(acc[ai][bj][m][0] * rs, acc[ai][bj][m][1] * rs); }
                } else { const int cl = wc * 32 + fq * 8, hh = (pn - 4) * 4 + (cl >> 5), i = cl & 31;
                    f32x4 o1[2], o2[2];
#pragma unroll
                    for (int n = 0; n < 2; ++n) { const f32x4 x1 = acc[ai][0][m][n] * rs, x2 = acc[ai][1][m][n] * rs; const f32x4 cs = *(const f32x4*)(cosT + (size_t)r * 32 + i + 4 * n), sn = *(const f32x4*)(sinT + (size_t)r * 32 + i + 4 * n);
                        o1[n] = x1 * cs - x2 * sn; o2[n] = x1 * sn + x2 * cs; }
                    *(u32x4*)(qr + (size_t)r * 512 + hh * 64 + i) = pk8(o1[0], o1[1]); *(u32x4*)(qr + (size_t)r * 512 + hh * 64 + 32 + i) = pk8(o2[0], o2[1]);
                }
                asm volatile("" ::: "memory"); } } };

struct EpiKn { bf16_t* kn; const float* rskv;
    __device__ __forceinline__ void operator()(f32x4 (&acc)[2][2][4][2], int pm, int pn) const { COORDS
        EPI2_LOOP { const int r = pm * 256 + ai * 128 + wr * 64 + m * 16 + fr, c = pn * 256 + bj * 128 + wc * 32 + fq * 8; const float rs = rskv[r];
            *(u32x4*)(kn + (size_t)r * DM + c) = pk8(acc[ai][bj][m][0] * rs, acc[ai][bj][m][1] * rs); EPI2_FENCE; } } };

struct EpiV { bf16_t* vt; const float* rskv;
    __device__ __forceinline__ void operator()(f32x4 (&acc)[2][2][4][2], int pm, int pn) const { COORDS
        EPI_LOOP { const int r0 = pm * 256 + ai * 128 + wr * 64 + m * 16 + fq * 4, cv = pn * 256 + bj * 128 + wc * 32 + n * 16 + fr;
            const f32x4 rs = *(const f32x4*)(rskv + r0); const int b = r0 >> 13, s = r0 & 8191, hh = cv >> 7, e = cv & 127;
            *(u32x2*)(vt + (((size_t)((b * 8 + hh) * 128 + e)) << 13) + s) = pk4(acc[ai][bj][m][n] * rs); EPI_FENCE; } } };

struct EpiGate { unsigned short *sga, *sgb;
    __device__ __forceinline__ void operator()(f32x4 (&acc)[2][2][4][2], int pm, int pn) const { COORDS
        unsigned short* dst = pn < 4 ? sga : sgb;
        EPI2_LOOP { const int r = pm * 256 + ai * 128 + wr * 64 + m * 16 + fr, c = (pn & 3) * 256 + bj * 128 + wc * 32 + fq * 8;
            *(u32x4*)(dst + (size_t)r * DM + c) = pkh8(sigm4(acc[ai][bj][m][0]), sigm4(acc[ai][bj][m][1])); } } };

struct EpiM1 { bf16_t* m1; const unsigned short* sga;
    __device__ __forceinline__ void operator()(f32x4 (&acc)[2][2][4][2], int pm, int pn) const { COORDS
        EPI2_LOOP { const int r = pm * 256 + ai * 128 + wr * 64 + m * 16 + fr, c = pn * 256 + bj * 128 + wc * 32 + fq * 8;
            f32x4 s0, s1; unh8(*(const u32x4*)(sga + (size_t)r * DM + c), s0, s1);
            *(u32x4*)(m1 + (size_t)r * DM + c) = pk8(acc[ai][bj][m][0] * s0, acc[ai][bj][m][1] * s1); EPI2_FENCE; } } };
struct EpiM2 { const bf16_t* m1; const unsigned short* sgb; bf16_t* merged;
    __device__ __forceinline__ void operator()(f32x4 (&acc)[2][2][4][2], int pm, int pn) const { COORDS
        EPI2_LOOP { const int r = pm * 256 + ai * 128 + wr * 64 + m * 16 + fr, c = pn * 256 + bj * 128 + wc * 32 + fq * 8;
            f32x4 s0, s1, m0, m1v; unh8(*(const u32x4*)(sgb + (size_t)r * DM + c), s0, s1); unb8(*(const u32x4*)(m1 + (size_t)r * DM + c), m0, m1v);
            *(u32x4*)(merged + (size_t)r * DM + c) = pk8(m0 + acc[ai][bj][m][0] * s0, m1v + acc[ai][bj][m][1] * s1); EPI2_FENCE; } } };

struct ConvDesc { const float* src0; const float* src1; const float* kscale; int K, Ns; bf16_t* dst; int kind, item; };
__device__ __forceinline__ void conv_load(const ConvDesc& d, int tid, float (&v)[8]) {
    const int nkt = d.K / 64; const int kt = d.item % nkt, ntile = d.item / nkt; const int k0 = kt * 64, n0 = ntile * 64;
    const int tn = tid & 63, np = n0 + tn; const float* s = d.src0; int col = np;
    if (d.kind == 1) { const int tile = np >> 8, bj = (np >> 7) & 1, cc = np & 127; s = bj ? d.src1 : d.src0; col = tile * 128 + cc; }
    else if (d.kind == 2) { if (np < 1024) col = (np >> 7) * 192 + (np & 127); else { const int r = np - 1024, t2 = r >> 8, bj = (r >> 7) & 1, cc = r & 127, hh = t2 * 4 + (cc >> 5), i = cc & 31; col = hh * 192 + 128 + bj * 32 + i; } }
    else if (d.kind == 3) { if (np < 1024) col = (np >> 7) * 256 + (np & 127); else { const int r = np - 1024; col = (r >> 7) * 256 + 128 + (r & 127); } }
#pragma unroll
    for (int i = 0; i < 8; ++i) { const int kk = (tid >> 6) + 8 * i; float x = s[(size_t)(k0 + kk) * d.Ns + col]; if (d.kscale) x *= d.kscale[k0 + kk]; v[i] = x; }
}
__device__ __forceinline__ void conv_store(LAS uchar* lds, const ConvDesc& d, int tid, const float (&v)[8]) {
    LAS float* tl = (LAS float*)lds;
    const int nkt = d.K / 64; const int kt = d.item % nkt, ntile = d.item / nkt; const int k0 = kt * 64, n0 = ntile * 64;
    { const int tn = tid & 63;
#pragma unroll
      for (int i = 0; i < 8; ++i) tl[tn * 65 + (tid >> 6) + 8 * i] = v[i]; }
    __syncthreads();
    { const int n = tid >> 3, kc = tid & 7; const LAS float* rp = tl + n * 65 + kc * 8; u32x4 w; w.x = pk2(rp[0], rp[1]); w.y = pk2(rp[2], rp[3]); w.z = pk2(rp[4], rp[5]); w.w = pk2(rp[6], rp[7]);
      *(u32x4*)(d.dst + (size_t)(n0 + n) * d.K + k0 + kc * 8) = w; }
    __syncthreads();
}
__device__ __forceinline__ ConvDesc conv_desc(const Params& p, int l, int it) {
    bf16_t* W = (bf16_t*)(p.ws + OFF_W + (size_t)(l & 1) * WSZ);
    constexpr int I_GU = 16 * 88, I_D = 44 * 16, I_IN = 16 * 107, I_UQ = 6 * 24, I_UKV = 4 * 32, I_SQ = 256;
    const size_t o_ff = (size_t)l * DM * FF; int r = it;
    if (r < I_GU) return ConvDesc{p.f1g + o_ff, p.f1u + o_ff, nullptr, DM, FF, W + W_GU1, 1, r}; r -= I_GU;
    if (r < I_D) return ConvDesc{p.f1d + o_ff, nullptr, nullptr, FF, DM, W + W_D1, 0, r}; r -= I_D;
    if (r < I_IN) return ConvDesc{p.w_in + (size_t)l * DM * 6848, nullptr, nullptr, DM, 6848, W + W_IN, 0, r}; r -= I_IN;
    if (r < I_UQ) return ConvDesc{p.w_uq + (size_t)l * 384 * 1536, nullptr, p.qng + l * 384, 384, 1536, W + W_UQ, 2, r}; r -= I_UQ;
    if (r < I_UKV) return ConvDesc{p.w_ukv + (size_t)l * 256 * 2048, nullptr, p.kvng + l * 256, 256, 2048, W + W_UKV, 3, r}; r -= I_UKV;
    if (r < I_SQ) return ConvDesc{p.w_bh + (size_t)l * DM * DM, nullptr, nullptr, DM, DM, W + W_BH, 0, r}; r -= I_SQ;
    if (r < I_SQ) return ConvDesc{p.w_bm + (size_t)l * DM * DM, nullptr, nullptr, DM, DM, W + W_BM, 0, r}; r -= I_SQ;
    if (r < I_SQ) return ConvDesc{p.w_out + (size_t)l * DM * DM, nullptr, nullptr, DM, DM, W + W_OUT, 0, r}; r -= I_SQ;
    if (r < I_GU) return ConvDesc{p.f2g + o_ff, p.f2u + o_ff, nullptr, DM, FF, W + W_GU2, 1, r}; r -= I_GU;
    return ConvDesc{p.f2d + o_ff, nullptr, nullptr, FF, DM, W + W_D2, 0, r};
}
__device__ void conv_layer(LAS uchar* lds, const Params& p, int l, int start, int stride) {
    constexpr int TOT = 2 * 16 * 88 + 2 * 44 * 16 + 16 * 107 + 6 * 24 + 4 * 32 + 3 * 256;
    const int tid = otid();
    float v[8], vn[8];
    if (start < TOT) { const ConvDesc d = conv_desc(p, l, start); conv_load(d, tid, v); }
    for (int it = start; it < TOT; it += stride) {
        const ConvDesc d = conv_desc(p, l, it);
        if (it + stride < TOT) { const ConvDesc dn = conv_desc(p, l, it + stride); conv_load(dn, tid, vn); }
        conv_store(lds, d, tid, v);
#pragma unroll
        for (int i = 0; i < 8; ++i) v[i] = vn[i];
    }
}

__device__ void p0a(LAS uchar* lds, const Params& p) {
    const int tid = otid(), G = ogdim();
    float* ADA = (float*)(p.ws + OFF_ADA);
    LAS float* red = (LAS float*)lds;
    LAS float* cond = red + 2048;
    for (int i = tid; i < 4096; i += NTHR) cond[i] = siluf(p.c[i]);
    __syncthreads();
    for (int it = obid(); it < NL * 144; it += G) {
        const int l = it / 144, cg0 = (it % 144) * 64, cn = tid & 63, kp = tid >> 6;
        const float* w = p.ada_w + (size_t)l * DM * 9216 + cg0 + cn;
        float a0 = 0.f, a1 = 0.f, a2 = 0.f, a3 = 0.f;
        for (int k = kp * 128; k < kp * 128 + 128; ++k) { const float wv = w[(size_t)k * 9216];
            a0 += cond[k] * wv; a1 += cond[1024 + k] * wv; a2 += cond[2048 + k] * wv; a3 += cond[3072 + k] * wv; }
        red[(kp * 4 + 0) * 64 + cn] = a0; red[(kp * 4 + 1) * 64 + cn] = a1; red[(kp * 4 + 2) * 64 + cn] = a2; red[(kp * 4 + 3) * 64 + cn] = a3;
        __syncthreads();
        if (tid < 256) { const int b = tid >> 6; float s = 0.f;
#pragma unroll
            for (int q = 0; q < 8; ++q) s += red[(q * 4 + b) * 64 + cn];
            ADA[(size_t)(l * 4 + b) * 9216 + cg0 + cn] = s + p.ada_b[(size_t)l * 9216 + cg0 + cn]; }
        __syncthreads();
    }
    float* COS = (float*)(p.ws + OFF_COS); float* SIN = (float*)(p.ws + OFF_SIN);
    for (int e = obid() * NTHR + tid; e < T * 32; e += G * NTHR) {
        const int tok = e >> 5, i = e & 31; double inv = 1.0, rr = 0.7498942093324558; int n = i;
        while (n) { if (n & 1) inv *= rr; rr *= rr; n >>= 1; }
        const double ang = (double)p.pos[tok] * inv; const double kq = __builtin_rint(ang * 0.15915494309189535);
        double r = ang - kq * 6.283185307179586 - kq * 2.4492935982947064e-16; const double r2 = r * r;
        double sn, cs;
        { double t = 1.0;
#pragma unroll
          for (int q = 27; q >= 3; q -= 2) t = 1.0 - t * r2 * (1.0 / (double)(q * (q - 1))); sn = t * r; }
        { double t = 1.0;
#pragma unroll
          for (int q = 26; q >= 2; q -= 2) t = 1.0 - t * r2 * (1.0 / (double)(q * (q - 1))); cs = t; }
        COS[e] = (float)cs; SIN[e] = (float)sn;
    }
    { float* onz = (float*)(p.ws + OFF_ONES); for (int ch = obid() * NTHR + tid; ch < 2048; ch += G * NTHR) onz[ch] = ch < 1024 ? 1.f : 0.f; }
    float* LBT = (float*)(p.ws + OFF_LBT);
    for (int ch = obid() * NTHR + tid; ch < 1024; ch += G * NTHR) {
        const float v0 = p.hg_lb[ch], v1 = p.hg_lb[1024 + ch], v2 = p.hg_lb[2048 + ch], v3 = p.hg_lb[3072 + ch];
        const float mx = fmaxf(fmaxf(v0, v1), fmaxf(v2, v3)); const float e0 = expf(v0 - mx), e1 = expf(v1 - mx), e2 = expf(v2 - mx), e3 = expf(v3 - mx); const float inv = 1.f / (e0 + e1 + e2 + e3);
        float lw[4]; lw[0] = 0.f; lw[1] = e1 * inv; lw[2] = (e1 + e2) * inv; lw[3] = (e1 + e2 + e3) * inv;
#pragma unroll
        for (int l = 0; l < 4; ++l) { const float lb = lw[l]; LBT[(l * 3 + 0) * 1024 + ch] = fmaxf(lb, 1e-30f); LBT[(l * 3 + 1) * 1024 + ch] = log1pf(-lb); LBT[(l * 3 + 2) * 1024 + ch] = 1.f - lb; }
    }
}

__device__ void ln_pass(const Params& p, const float* src, float* hdst, bf16_t* U, const float* g, const float* bta, const float* ada_l, int sc_idx, int sh_idx, bool donorm, bool writeU, bool writeH) {
    float* stats = (float*)(p.ws + OFF_STATS);
    const int tid = otid(), wid = tid >> 6, lane = tid & 63;
    for (int row = obid() * 8 + wid; row < T; row += ogdim() * 8) {
        const f32x4* xr = (const f32x4*)(src + (size_t)row * DM) + lane; f32x4 v[4]; float s = 0.f;
#pragma unroll
        for (int j = 0; j < 4; ++j) { v[j] = xr[64 * j]; s += (v[j][0] + v[j][1]) + (v[j][2] + v[j][3]); }
        if (donorm) {
#pragma unroll
            for (int o = 32; o > 0; o >>= 1) s += __shfl_xor(s, o);
            const float mean = s * (1.f / DM); float s2 = 0.f;
#pragma unroll
            for (int j = 0; j < 4; ++j) { v[j] = v[j] - mean; s2 += (v[j][0] * v[j][0] + v[j][1] * v[j][1]) + (v[j][2] * v[j][2] + v[j][3] * v[j][3]); }
#pragma unroll
            for (int o = 32; o > 0; o >>= 1) s2 += __shfl_xor(s2, o);
            const float rstd = 1.f / sqrtf(s2 * (1.f / DM) + 1e-5f);
            if (lane == 0) *(f32x2v*)(stats + 2 * row) = (f32x2v){mean, rstd};
#pragma unroll
            for (int j = 0; j < 4; ++j) { const f32x4 gg = *((const f32x4*)g + lane + 64 * j), bb = *((const f32x4*)bta + lane + 64 * j); v[j] = v[j] * rstd * gg + bb; }
        }
        else if (lane == 0) { const float zz = v[0][0] * 0.f; *(f32x2v*)(stats + 2 * row) = (f32x2v){zz, 1.f + zz}; }
        if (writeH) { f32x4* hr = (f32x4*)(hdst + (size_t)row * DM) + lane;
#pragma unroll
            for (int j = 0; j < 4; ++j) hr[64 * j] = v[j]; }
        if (writeU) { const float* ab = ada_l + (size_t)(row >> 13) * 9216; u32x2* ur = (u32x2*)(U + (size_t)row * DM) + lane;
#pragma unroll
            for (int j = 0; j < 4; ++j) { const f32x4 sc = *((const f32x4*)(ab + sc_idx * 1024) + lane + 64 * j), sh = *((const f32x4*)(ab + sh_idx * 1024) + lane + 64 * j); ur[64 * j] = pk4(v[j] * (1.f + sc) + sh); } }
    }
}

__device__ void ln_pass2(const Params& p, const float* src, float* outH, bf16_t* U, const float* g, const float* bta, const float* ada_l, int sc_idx, int sh_idx) {
    float* stats = (float*)(p.ws + OFF_STATS);
    const int tid = otid(), wid = tid >> 6, lane = tid & 63; const int rstep = ogdim() * 8, r0 = obid() * 8 + wid;
    for (int b = 0; b < 4; ++b) {
        f32x4 A[4], B[4];
#pragma unroll
        for (int j = 0; j < 4; ++j) { const f32x4 gg = *((const f32x4*)g + lane + 64 * j), bb = *((const f32x4*)bta + lane + 64 * j);
            if (outH) { A[j] = gg; B[j] = bb; }
            else { const float* ab = ada_l + (size_t)b * 9216; const f32x4 sc = *((const f32x4*)(ab + sc_idx * 1024) + lane + 64 * j), sh = *((const f32x4*)(ab + sh_idx * 1024) + lane + 64 * j); A[j] = gg * (1.f + sc); B[j] = bb * (1.f + sc) + sh; } }
        f32x4 v[4], vn[4];
        if (r0 < SEQ) {
#pragma unroll
            for (int j = 0; j < 4; ++j) v[j] = *((const f32x4*)(src + (size_t)(b * SEQ + r0) * DM) + lane + 64 * j); }
        for (int rr = r0; rr < SEQ; rr += rstep) {
            const int row = b * SEQ + rr;
            if (rr + rstep < SEQ) {
#pragma unroll
                for (int j = 0; j < 4; ++j) vn[j] = *((const f32x4*)(src + (size_t)(row + rstep) * DM) + lane + 64 * j); }
            float s = 0.f;
#pragma unroll
            for (int j = 0; j < 4; ++j) s += (v[j][0] + v[j][1]) + (v[j][2] + v[j][3]);
#pragma unroll
            for (int o = 32; o > 0; o >>= 1) s += __shfl_xor(s, o);
            const float mean = s * (1.f / DM); float s2 = 0.f;
#pragma unroll
            for (int j = 0; j < 4; ++j) { v[j] = v[j] - mean; s2 += (v[j][0] * v[j][0] + v[j][1] * v[j][1]) + (v[j][2] * v[j][2] + v[j][3] * v[j][3]); }
#pragma unroll
            for (int o = 32; o > 0; o >>= 1) s2 += __shfl_xor(s2, o);
            const float rstd = 1.f / sqrtf(s2 * (1.f / DM) + 1e-5f);
            if (lane == 0) *(f32x2v*)(stats + 2 * row) = (f32x2v){mean, rstd};
            if (outH) { f32x4* hr = (f32x4*)(outH + (size_t)row * DM) + lane;
#pragma unroll
                for (int j = 0; j < 4; ++j) hr[64 * j] = v[j] * rstd * A[j] + B[j]; }
            else { u32x2* ur = (u32x2*)(U + (size_t)row * DM) + lane;
#pragma unroll
                for (int j = 0; j < 4; ++j) ur[64 * j] = pk4(v[j] * rstd * A[j] + B[j]); }
#pragma unroll
            for (int j = 0; j < 4; ++j) v[j] = vn[j];
        }
    }
}

__device__ void tok_pass(const Params& p) {
    const int tid = otid(), wid = tid >> 6, lane = tid & 63;
    const bf16_t* CQ = (const bf16_t*)(p.ws + OFF_CQ); const bf16_t* CKV = (const bf16_t*)(p.ws + OFF_CKV);
    const float* KRRAW = (const float*)(p.ws + OFF_KRRAW); bf16_t* KR = (bf16_t*)(p.ws + OFF_KR);
    const float* COS = (const float*)(p.ws + OFF_COS); const float* SIN = (const float*)(p.ws + OFF_SIN);
    float* RSQ = (float*)(p.ws + OFF_RSQ); float* RSKV = (float*)(p.ws + OFF_RSKV);
    const int step = ogdim() * 8, t0 = obid() * 8 + wid; const int l31 = lane & 31;
    unsigned qw[3], qn[3]; u32x2 kw, kn2; float x1, x2, cs, sn, x1n, x2n, csn, snn;
#define TOK_LOAD(tok_, Q_, K_, X1_, X2_, C_, S_) do { const unsigned* q_ = (const unsigned*)(CQ + (size_t)(tok_) * 384) + lane * 3; Q_[0] = q_[0]; Q_[1] = q_[1]; Q_[2] = q_[2]; K_ = *((const u32x2*)(CKV + (size_t)(tok_) * 256) + lane); \
        X1_ = KRRAW[(size_t)(tok_) * 64 + l31]; X2_ = KRRAW[(size_t)(tok_) * 64 + 32 + l31]; C_ = COS[(size_t)(tok_) * 32 + l31]; S_ = SIN[(size_t)(tok_) * 32 + l31]; } while (0)
    if (t0 < T) TOK_LOAD(t0, qw, kw, x1, x2, cs, sn);
    for (int tok = t0; tok < T; tok += step) {
        if (tok + step < T) TOK_LOAD(tok + step, qn, kn2, x1n, x2n, csn, snn);
        float s = 0.f;
#pragma unroll
        for (int j = 0; j < 3; ++j) { const float a = bf2f(qw[j] & 0xffff), b = bf2f(qw[j] >> 16); s += a * a + b * b; }
        float s2; { const float a = bf2f(kw.x & 0xffff), b = bf2f(kw.x >> 16), c = bf2f(kw.y & 0xffff), d = bf2f(kw.y >> 16); s2 = a * a + b * b + c * c + d * d; }
#pragma unroll
        for (int o = 32; o > 0; o >>= 1) { s += __shfl_xor(s, o); s2 += __shfl_xor(s2, o); }
        if (lane == 0) { RSQ[tok] = 1.f / sqrtf(s * (1.f / 384.f) + 1e-6f); RSKV[tok] = 1.f / sqrtf(s2 * (1.f / 256.f) + 1e-6f); }
        if (lane < 32) { KR[(size_t)tok * 64 + lane] = f2bf(x1 * cs - x2 * sn); KR[(size_t)tok * 64 + 32 + lane] = f2bf(x1 * sn + x2 * cs); }
        qw[0] = qn[0]; qw[1] = qn[1]; qw[2] = qn[2]; kw = kn2; x1 = x1n; x2 = x2n; cs = csn; sn = snn;
    }
#undef TOK_LOAD
}

__device__ __forceinline__ void gate2(float z, float lbp, float oml, float& lf2, float& hk) {
    const float t = __builtin_amdgcn_exp2f(-fabsf(z) * 1.44269504f), r = __builtin_amdgcn_rcpf(1.f + t), sm = t * r;
    const float sz = z >= 0.f ? r : sm, snz = z >= 0.f ? sm : r;
    lf2 = __builtin_amdgcn_logf(lbp + oml * sz); hk = oml * snz;
}
constexpr int KT_STR = 72;
constexpr int TD_STR = 136;

__device__ void hg1_phase(LAS uchar* lds, const Params& p, int l) {
    COORDS
    const unsigned* ZF32 = (const unsigned*)(p.ws + OFF_R1); const unsigned* HV32 = (const unsigned*)(p.ws + OFF_R2);
    bf16_t* LS = (bf16_t*)(p.ws + OFF_R4); float* DEC = (float*)(p.ws + OFF_DEC); const float* LBT = (const float*)(p.ws + OFF_LBT) + (size_t)l * 3 * 1024;
    LAS bf16_t* Kt = (LAS bf16_t*)lds;
    LAS bf16_t* Vt = (LAS bf16_t*)(lds + 128 * KT_STR * 2);
    LAS float* tot = (LAS float*)(lds + 2 * 128 * KT_STR * 2);
    const int d2 = lane, part = wid;
    unsigned zr[8], vr[8];
    { const int unit = obid(); if (unit < 32 * 128) { const int chunk = unit & 127, bh = unit >> 7, b = bh >> 3, hh = bh & 7; const size_t t0 = (size_t)b * SEQ + chunk * 64 + part * 8;
#pragma unroll
        for (int i = 0; i < 8; ++i) { zr[i] = ZF32[(t0 + i) * 512 + hh * 64 + d2]; vr[i] = HV32[(t0 + i) * 512 + hh * 64 + d2]; } } }
    for (int unit = obid(); unit < 32 * 128; unit += ogdim()) {
        const int bh = unit >> 7, hh = bh & 7;
        const f32x2v lbp = *(const f32x2v*)(LBT + hh * 128 + 2 * d2), oml = *(const f32x2v*)(LBT + 2048 + hh * 128 + 2 * d2);
        unsigned zn[8], vn[8];
        { const int nu = unit + ogdim(); if (nu < 32 * 128) { const int chunk = nu & 127, bh2 = nu >> 7, b = bh2 >> 3, h2 = bh2 & 7; const size_t t0 = (size_t)b * SEQ + chunk * 64 + part * 8;
#pragma unroll
            for (int i = 0; i < 8; ++i) { zn[i] = ZF32[(t0 + i) * 512 + h2 * 64 + d2]; vn[i] = HV32[(t0 + i) * 512 + h2 * 64 + d2]; } } }
        float g0[8], g1[8], k0[8], k1[8]; float run0 = 0.f, run1 = 0.f;
#pragma unroll
        for (int i = 0; i < 8; ++i) { float lf; gate2(h2f(zr[i] & 0xffff), lbp[0], oml[0], lf, k0[i]); run0 += lf; g0[i] = run0; gate2(h2f(zr[i] >> 16), lbp[1], oml[1], lf, k1[i]); run1 += lf; g1[i] = run1; }
        *(LAS f32x2v*)(tot + part * 128 + 2 * d2) = (f32x2v){run0, run1};
        __syncthreads();
        float off0 = 0.f, off1 = 0.f, gc0 = 0.f, gc1 = 0.f;
#pragma unroll
        for (int q = 0; q < 8; ++q) { const f32x2v tq = *(const LAS f32x2v*)(tot + q * 128 + 2 * d2); gc0 += tq[0]; gc1 += tq[1]; if (q < part) { off0 += tq[0]; off1 += tq[1]; } }
        u32x4 kw0, kw1, vw0, vw1;
#pragma unroll
        for (int j = 0; j < 4; ++j) {
            kw0[j] = pk2(k0[2 * j] * __builtin_amdgcn_exp2f(gc0 - (off0 + g0[2 * j])), k0[2 * j + 1] * __builtin_amdgcn_exp2f(gc0 - (off0 + g0[2 * j + 1])));
            kw1[j] = pk2(k1[2 * j] * __builtin_amdgcn_exp2f(gc1 - (off1 + g1[2 * j])), k1[2 * j + 1] * __builtin_amdgcn_exp2f(gc1 - (off1 + g1[2 * j + 1])));
            vw0[j] = (vr[2 * j] & 0xffffu) | (vr[2 * j + 1] << 16); vw1[j] = (vr[2 * j] >> 16) | (vr[2 * j + 1] & 0xffff0000u); }
        *(LAS u32x4*)(Kt + (2 * d2) * KT_STR + part * 8) = kw0; *(LAS u32x4*)(Kt + (2 * d2 + 1) * KT_STR + part * 8) = kw1;
        *(LAS u32x4*)(Vt + (2 * d2) * KT_STR + part * 8) = vw0; *(LAS u32x4*)(Vt + (2 * d2 + 1) * KT_STR + part * 8) = vw1;
        if (part == 0) *(f32x2v*)(DEC + (size_t)unit * 128 + 2 * d2) = (f32x2v){__builtin_amdgcn_exp2f(gc0), __builtin_amdgcn_exp2f(gc1)};
        __syncthreads();
        bf16x8 vb[2];
#pragma unroll
        for (int ks = 0; ks < 2; ++ks) vb[ks] = *(const LAS bf16x8*)(Vt + (wid * 16 + fr) * KT_STR + ks * 32 + fq * 8);
        bf16_t* lsu = LS + (size_t)unit * 16384;
#pragma unroll
        for (int nb = 0; nb < 8; ++nb) { f32x4 a = {0.f, 0.f, 0.f, 0.f};
#pragma unroll
            for (int ks = 0; ks < 2; ++ks) { const bf16x8 ka = *(const LAS bf16x8*)(Kt + (nb * 16 + fr) * KT_STR + ks * 32 + fq * 8); a = __builtin_amdgcn_mfma_f32_16x16x32_bf16(ka, vb[ks], a, 0, 0, 0); }
            *(u32x2*)(lsu + (size_t)(wid * 16 + fr) * 128 + nb * 16 + fq * 4) = pk4(a); }
        __syncthreads();
#pragma unroll
        for (int i = 0; i < 8; ++i) { zr[i] = zn[i]; vr[i] = vn[i]; }
    }
}

__device__ void hg2_phase(const Params& p) {
    bf16_t* LS = (bf16_t*)(p.ws + OFF_R4); const float* DEC = (const float*)(p.ws + OFF_DEC);
    for (int gid = obid() * NTHR + otid(); gid < 32 * 4096; gid += ogdim() * NTHR) {
        const int bh = gid >> 12, e4 = (gid & 4095) * 4, dk = e4 & 127;
        f32x4 S = {0.f, 0.f, 0.f, 0.f};
        for (int c0 = 0; c0 < 128; c0 += 8) {
            u32x2 lw[8]; f32x4 dc[8];
#pragma unroll
            for (int q = 0; q < 8; ++q) { lw[q] = *(const u32x2*)(LS + ((size_t)(bh * 128 + c0 + q) << 14) + e4); dc[q] = *(const f32x4*)(DEC + (size_t)(bh * 128 + c0 + q) * 128 + dk); }
#pragma unroll
            for (int q = 0; q < 8; ++q) { *(u32x2*)(LS + ((size_t)(bh * 128 + c0 + q) << 14) + e4) = pk4(S);
                f32x4 L; L[0] = bf2f(lw[q].x & 0xffff); L[1] = bf2f(lw[q].x >> 16); L[2] = bf2f(lw[q].y & 0xffff); L[3] = bf2f(lw[q].y >> 16);
                S = dc[q] * S + L; }
        }
    }
}

__device__ void hg3_phase(LAS uchar* lds, const Params& p, int l) {
    COORDS
    bf16_t* HQ = (bf16_t*)(p.ws + OFF_R0); const unsigned* HQ32 = (const unsigned*)(p.ws + OFF_R0); const unsigned* ZF32 = (const unsigned*)(p.ws + OFF_R1); const unsigned* HV32 = (const unsigned*)(p.ws + OFF_R2);
    const bf16_t* SG = (const bf16_t*)(p.ws + OFF_R3); const bf16_t* LS = (const bf16_t*)(p.ws + OFF_R4); const float* LBT = (const float*)(p.ws + OFF_LBT) + (size_t)l * 3 * 1024;
    const float* ng = p.hg_ng + (size_t)l * 1024;
    LAS bf16_t* Qt = (LAS bf16_t*)lds;
    LAS bf16_t* Qh = Qt + 64 * TD_STR;
    LAS bf16_t* Kp = Qh + 64 * TD_STR;
    LAS bf16_t* Vt = Kp + 64 * TD_STR;
    LAS bf16_t* Sb = Vt + 128 * KT_STR;
    LAS float* tot = (LAS float*)(Sb + 128 * TD_STR);
    LAS float* ssq = tot + 1024;
    const int d2 = lane, part = wid;
    unsigned zr[8], vr[8], qr[8]; u32x4 sbr[4];
#define HG3_LOAD(U_, Z_, V_, Q_, S_) do { const int chunk_ = (U_) & 127, bh_ = (U_) >> 7, b_ = bh_ >> 3, h_ = bh_ & 7; const size_t t0_ = (size_t)b_ * SEQ + chunk_ * 64 + part * 8; \
        _Pragma("unroll") for (int i_ = 0; i_ < 8; ++i_) { Z_[i_] = ZF32[(t0_ + i_) * 512 + h_ * 64 + d2]; V_[i_] = HV32[(t0_ + i_) * 512 + h_ * 64 + d2]; Q_[i_] = HQ32[(t0_ + i_) * 512 + h_ * 64 + d2]; } \
        const bf16_t* lsu_ = LS + (size_t)(U_) * 16384; _Pragma("unroll") for (int i_ = 0; i_ < 4; ++i_) { const int cid_ = tid + i_ * NTHR; S_[i_] = *(const u32x4*)(lsu_ + (cid_ >> 4) * 128 + (cid_ & 15) * 8); } } while (0)
    if (obid() < 32 * 128) HG3_LOAD(obid(), zr, vr, qr, sbr);
    for (int unit = obid(); unit < 32 * 128; unit += ogdim()) {
        const int chunk = unit & 127, bh = unit >> 7, b = bh >> 3, hh = bh & 7;
        const f32x2v lbp = *(const f32x2v*)(LBT + hh * 128 + 2 * d2), oml = *(const f32x2v*)(LBT + 2048 + hh * 128 + 2 * d2);
        const size_t tokc = (size_t)b * SEQ + chunk * 64;
        { u32x4 vw0, vw1;
#pragma unroll
          for (int j = 0; j < 4; ++j) { vw0[j] = (vr[2 * j] & 0xffffu) | (vr[2 * j + 1] << 16); vw1[j] = (vr[2 * j] >> 16) | (vr[2 * j + 1] & 0xffff0000u); }
          *(LAS u32x4*)(Vt + (2 * d2) * KT_STR + part * 8) = vw0; *(LAS u32x4*)(Vt + (2 * d2 + 1) * KT_STR + part * 8) = vw1;
#pragma unroll
          for (int i = 0; i < 4; ++i) { const int cid = tid + i * NTHR; *(LAS u32x4*)(Sb + (cid >> 4) * TD_STR + (cid & 15) * 8) = sbr[i]; } }
        float g0[8], g1[8], k0[8], k1[8]; float run0 = 0.f, run1 = 0.f;
#pragma unroll
        for (int i = 0; i < 8; ++i) { float lf; gate2(h2f(zr[i] & 0xffff), lbp[0], oml[0], lf, k0[i]); run0 += lf; g0[i] = run0; gate2(h2f(zr[i] >> 16), lbp[1], oml[1], lf, k1[i]); run1 += lf; g1[i] = run1; }
        *(LAS f32x2v*)(tot + part * 128 + 2 * d2) = (f32x2v){run0, run1};
        unsigned qc[8];
#pragma unroll
        for (int i = 0; i < 8; ++i) qc[i] = qr[i];
        const int tb = wid & 3, eh = wid >> 2;
        const size_t trow = (tokc + tb * 16 + fr) * DM + hh * 128;
        u32x2 sgw[4];
#pragma unroll
        for (int mt = 0; mt < 4; ++mt) sgw[mt] = *(const u32x2*)(SG + trow + eh * 64 + mt * 16 + fq * 4);
        { const int nu = unit + ogdim(); if (nu < 32 * 128) HG3_LOAD(nu, zr, vr, qr, sbr); }
        __syncthreads();
        float off0 = 0.f, off1 = 0.f, gr0 = 0.f, gr1 = 0.f;
#pragma unroll
        for (int q = 0; q < 8; ++q) { const f32x2v tq = *(const LAS f32x2v*)(tot + q * 128 + 2 * d2); if (q < 4) { gr0 += tq[0]; gr1 += tq[1]; } if (q < part) { off0 += tq[0]; off1 += tq[1]; } }
#pragma unroll
        for (int i = 0; i < 8; ++i) { const float G0 = off0 + g0[i], G1 = off1 + g1[i]; const float q0 = bf2f(qc[i] & 0xffff), q1 = bf2f(qc[i] >> 16); const int t = part * 8 + i;
            *(LAS unsigned*)(Qt + t * TD_STR + 2 * d2) = pk2(q0 * __builtin_amdgcn_exp2f(fminf(G0 - gr0, 115.f)), q1 * __builtin_amdgcn_exp2f(fminf(G1 - gr1, 115.f)));
            *(LAS unsigned*)(Qh + t * TD_STR + 2 * d2) = pk2(q0 * __builtin_amdgcn_exp2f(G0), q1 * __builtin_amdgcn_exp2f(G1));
            *(LAS unsigned*)(Kp + t * TD_STR + 2 * d2) = pk2(k0[i] * __builtin_amdgcn_exp2f(fminf(gr0 - G0, 115.f)), k1[i] * __builtin_amdgcn_exp2f(fminf(gr1 - G1, 115.f))); }
        __syncthreads();
        f32x4 sc[4];
#pragma unroll
        for (int sb = 0; sb < 4; ++sb) { sc[sb] = (f32x4){0.f, 0.f, 0.f, 0.f};
            if (sb <= tb) {
#pragma unroll
                for (int ks = 0; ks < 4; ++ks) { const bf16x8 ka = *(const LAS bf16x8*)(Kp + (sb * 16 + fr) * TD_STR + ks * 32 + fq * 8), qb = *(const LAS bf16x8*)(Qt + (tb * 16 + fr) * TD_STR + ks * 32 + fq * 8);
                    sc[sb] = __builtin_amdgcn_mfma_f32_16x16x32_bf16(ka, qb, sc[sb], 0, 0, 0); }
                if (sb == tb) {
#pragma unroll
                    for (int j = 0; j < 4; ++j) if (fq * 4 + j > fr) sc[sb][j] = 0.f; } } }
        f32x4 o[4];
#pragma unroll
        for (int mt = 0; mt < 4; ++mt) o[mt] = (f32x4){0.f, 0.f, 0.f, 0.f};
#pragma unroll
        for (int ks = 0; ks < 2; ++ks) { union { bf16x8 v; u32x4 u; } pf; pf.u.x = pk2(sc[2 * ks][0], sc[2 * ks][1]); pf.u.y = pk2(sc[2 * ks][2], sc[2 * ks][3]); pf.u.z = pk2(sc[2 * ks + 1][0], sc[2 * ks + 1][1]); pf.u.w = pk2(sc[2 * ks + 1][2], sc[2 * ks + 1][3]);
            if (2 * ks <= tb) {
#pragma unroll
                for (int mt = 0; mt < 4; ++mt) { const int e = eh * 64 + mt * 16 + fr; union { bf16x8 v; u32x2 h[2]; } vf; vf.h[0] = *(const LAS u32x2*)(Vt + e * KT_STR + (2 * ks) * 16 + fq * 4); vf.h[1] = *(const LAS u32x2*)(Vt + e * KT_STR + (2 * ks + 1) * 16 + fq * 4);
                    o[mt] = __builtin_amdgcn_mfma_f32_16x16x32_bf16(vf.v, pf.v, o[mt], 0, 0, 0); } } }
#pragma unroll
        for (int ks = 0; ks < 4; ++ks) { const bf16x8 qb = *(const LAS bf16x8*)(Qh + (tb * 16 + fr) * TD_STR + ks * 32 + fq * 8);
#pragma unroll
            for (int mt = 0; mt < 4; ++mt) { const bf16x8 sa = *(const LAS bf16x8*)(Sb + (eh * 64 + mt * 16 + fr) * TD_STR + ks * 32 + fq * 8); o[mt] = __builtin_amdgcn_mfma_f32_16x16x32_bf16(sa, qb, o[mt], 0, 0, 0); } }
        float ss = 0.f;
#pragma unroll
        for (int mt = 0; mt < 4; ++mt) ss += (o[mt][0] * o[mt][0] + o[mt][1] * o[mt][1]) + (o[mt][2] * o[mt][2] + o[mt][3] * o[mt][3]);
        ss += __shfl_xor(ss, 16); ss += __shfl_xor(ss, 32);
        if (fq == 0) ssq[eh * 64 + tb * 16 + fr] = ss;
        __syncthreads();
        const float rstd = 1.f / sqrtf((ssq[tb * 16 + fr] + ssq[64 + tb * 16 + fr]) * (1.f / 128.f) + 1e-6f);
#pragma unroll
        for (int mt = 0; mt < 4; ++mt) { const int e = eh * 64 + mt * 16 + fq * 4; const f32x4 gg = *(const f32x4*)(ng + hh * 128 + e); const u32x2 sw = sgw[mt];
            f32x4 r; r[0] = o[mt][0] * rstd * gg[0] * bf2f(sw.x & 0xffff); r[1] = o[mt][1] * rstd * gg[1] * bf2f(sw.x >> 16); r[2] = o[mt][2] * rstd * gg[2] * bf2f(sw.y & 0xffff); r[3] = o[mt][3] * rstd * gg[3] * bf2f(sw.y >> 16);
            *(u32x2*)(HQ + trow + e) = pk4(r); }
        __syncthreads();
    }
#undef HG3_LOAD
}

constexpr float ATT_THR = 6.0f;
constexpr int AK_STR = 400, AV_STR = 144;
constexpr int AK_BYTES = 64 * AK_STR, AV_BYTES = 128 * AV_STR;
__device__ void attn_phase(LAS uchar* lds, const Params& p, bf16_t* obuf) {
    const int tid = otid(), wid = __builtin_amdgcn_readfirstlane(tid >> 6), lane = tid & 63, l32 = lane & 31, half = lane >> 5;
    bf16_t* QN = (bf16_t*)(p.ws + OFF_R1); const bf16_t* QR = (const bf16_t*)(p.ws + OFF_R5); const bf16_t* KN = (const bf16_t*)(p.ws + OFF_R2);
    const bf16_t* VT = (const bf16_t*)(p.ws + OFF_R3); const bf16_t* KR = (const bf16_t*)(p.ws + OFF_KR);
    for (int vb = obid(); vb < 256; vb += ogdim()) {
        const int vid = (vb & 7) * 32 + (vb >> 3);
        const int bh = vid >> 3, jj = vid & 7, b = bh >> 3, hh = bh & 7;
        for (int ui = 0; ui < 4; ++ui) {
            const int qb = ui == 0 ? 31 - jj : (ui == 1 ? 16 + jj : (ui == 2 ? 15 - jj : jj));
            const int q0 = qb * 256, ntiles = 4 * (qb + 1), wlast = 4 * qb + (wid >> 1);
            const size_t tokb = (size_t)b * SEQ; const int qrow = q0 + wid * 32 + l32;
            bf16x8 Q[12];
            { const bf16_t* qn = QN + (tokb + qrow) * DM + hh * 128; const bf16_t* qr = QR + (tokb + qrow) * 512 + hh * 64;
#pragma unroll
              for (int s = 0; s < 8; ++s) Q[s] = *(const bf16x8*)(qn + s * 16 + half * 8);
#pragma unroll
              for (int s = 0; s < 4; ++s) Q[8 + s] = *(const bf16x8*)(qr + s * 16 + half * 8); }
            f32x16 O[4];
#pragma unroll
            for (int mb = 0; mb < 4; ++mb)
#pragma unroll
                for (int i = 0; i < 16; ++i) O[mb][i] = 0.f;
            float mrun = 0.f, lrun = 0.f;
            u32x4 kreg[3], vreg[2];
            const bf16_t* vtb = VT + ((size_t)(bh * 128) << 13);
            const int akey = tid >> 3, ac8 = tid & 7;
            const unsigned koff = (unsigned)(akey * DM + ac8 * 8) * 2u, roff = (unsigned)(akey * 64 + ac8 * 8) * 2u, voff = (unsigned)((akey << 13) + ac8 * 8) * 2u;
            const int kdst = akey * AK_STR + ac8 * 16, vdst = akey * AV_STR + (ac8 >> 1) * 32 + (ac8 & 1) * 8;
#define ALOAD(kt_) do { const int kb_ = (kt_) * 64; const char* kbp = (const char*)(KN + (tokb + kb_) * DM + hh * 128); const char* rbp = (const char*)(KR + (tokb + kb_) * 64); const char* vbp2 = (const char*)(vtb + kb_); \
              kreg[0] = *(const u32x4*)(kbp + koff); kreg[1] = *(const u32x4*)(kbp + koff + 128); kreg[2] = *(const u32x4*)(rbp + roff); \
              vreg[0] = *(const u32x4*)(vbp2 + voff); vreg[1] = *(const u32x4*)(vbp2 + voff + (64u << 14)); } while (0)
#define ASTORE(buf_) do { LAS uchar* kb2 = lds + (buf_) * (AK_BYTES + AV_BYTES); LAS uchar* vb2 = kb2 + AK_BYTES; *(LAS u32x4*)(kb2 + kdst) = kreg[0]; *(LAS u32x4*)(kb2 + kdst + 128) = kreg[1]; *(LAS u32x4*)(kb2 + kdst + 256) = kreg[2]; \
              _Pragma("unroll") for (int i_ = 0; i_ < 2; ++i_) { *(LAS u32x2*)(vb2 + vdst + i_ * 64 * AV_STR) = (u32x2){vreg[i_].x, vreg[i_].y}; *(LAS u32x2*)(vb2 + vdst + i_ * 64 * AV_STR + 16) = (u32x2){vreg[i_].z, vreg[i_].w}; } } while (0)
            __syncthreads();
            ALOAD(0); ASTORE(0);
            __syncthreads();
            for (int kt = 0; kt < ntiles; ++kt) {
                const int cur = kt & 1;
                if (kt + 1 < ntiles) ALOAD(kt + 1);
                if (kt <= wlast) {
                    const LAS uchar* kb = lds + cur * (AK_BYTES + AV_BYTES); const LAS uchar* vbp = kb + AK_BYTES;
                    f32x16 s0, s1;
#pragma unroll
                    for (int i = 0; i < 16; ++i) { s0[i] = -mrun; s1[i] = -mrun; }
                    {
                        bf16x8 ka[2][2];
                        const LAS uchar* kp0 = kb + l32 * AK_STR + half * 16; const LAS uchar* kp1 = kp0 + 32 * AK_STR;
                        ka[0][0] = *(const LAS bf16x8*)kp0; ka[0][1] = *(const LAS bf16x8*)kp1;
#pragma unroll
                        for (int st = 0; st < 12; ++st) { if (st + 1 < 12) { ka[(st + 1) & 1][0] = *(const LAS bf16x8*)(kp0 + (st + 1) * 32); ka[(st + 1) & 1][1] = *(const LAS bf16x8*)(kp1 + (st + 1) * 32); }
                            __builtin_amdgcn_sched_barrier(0); __builtin_amdgcn_s_setprio(1);
                            s0 = __builtin_amdgcn_mfma_f32_32x32x16_bf16(ka[st & 1][0], Q[st], s0, 0, 0, 0); s1 = __builtin_amdgcn_mfma_f32_32x32x16_bf16(ka[st & 1][1], Q[st], s1, 0, 0, 0);
                            __builtin_amdgcn_s_setprio(0); __builtin_amdgcn_sched_barrier(0); }
                    }
                    if (kt == wlast) { asm volatile("" ::: "memory");
                        const int kbase = kt * 64 + half * 4;
#pragma unroll
                        for (int i = 0; i < 16; ++i) { const int key = kbase + (i >> 2) * 8 + (i & 3); if (key > qrow) s0[i] = -1e30f; if (key + 32 > qrow) s1[i] = -1e30f; } }
                    float mx = s0[0];
#pragma unroll
                    for (int i = 1; i < 16; ++i) mx = fmaxf(mx, s0[i]);
#pragma unroll
                    for (int i = 0; i < 16; ++i) mx = fmaxf(mx, s1[i]);
                    {
                      typedef unsigned u2_t __attribute__((ext_vector_type(2)));
                      const u2_t sw = __builtin_amdgcn_permlane32_swap(__float_as_uint(mx), __float_as_uint(mx), false, false);
                      mx = fmaxf(__uint_as_float(sw[0]), __uint_as_float(sw[1])); }
                    const float dm = fmaxf(mx, 0.f);
                    if (__builtin_amdgcn_ballot_w64(dm > ATT_THR) != 0ull) { const float alpha = __builtin_amdgcn_exp2f(-dm); lrun *= alpha; mrun += dm;
#pragma unroll
                        for (int i = 0; i < 16; ++i) { s0[i] -= dm; s1[i] -= dm; }
#pragma unroll
                        for (int mb = 0; mb < 4; ++mb)
#pragma unroll
                            for (int i = 0; i < 16; ++i) O[mb][i] *= alpha; }
                    float ps = 0.f;
#pragma unroll
                    for (int i = 0; i < 16; ++i) { s0[i] = __builtin_amdgcn_exp2f(s0[i]); s1[i] = __builtin_amdgcn_exp2f(s1[i]); ps += s0[i] + s1[i]; }
                    lrun += ps;
                    {
                        union VF { bf16x8 v; u32x2 h[2]; }; VF vfr[2][2];
                        const LAS uchar* vp0 = vbp + l32 * AV_STR + half * 16;
#define VLOADG(gi_, b_) do { _Pragma("unroll") for (int q_ = 0; q_ < 2; ++q_) { const LAS uchar* vp_ = vp0 + (((gi_) & 1) * 2 + q_) * 32 * AV_STR + ((gi_) >> 1) * 32; vfr[b_][q_].v = *(const LAS bf16x8*)vp_; } } while (0)
                        VLOADG(0, 0);
                        union { bf16x8 v; u32x4 u; } pf;
#pragma unroll
                        for (int gi = 0; gi < 8; ++gi) { const int ks = gi >> 1; if (gi + 1 < 8) VLOADG(gi + 1, (gi + 1) & 1);
                            if ((gi & 1) == 0) {
                                if (ks == 0) { pf.u.x = pk2(s0[0], s0[1]); pf.u.y = pk2(s0[2], s0[3]); pf.u.z = pk2(s0[4], s0[5]); pf.u.w = pk2(s0[6], s0[7]); }
                                else if (ks == 1) { pf.u.x = pk2(s0[8], s0[9]); pf.u.y = pk2(s0[10], s0[11]); pf.u.z = pk2(s0[12], s0[13]); pf.u.w = pk2(s0[14], s0[15]); }
                                else if (ks == 2) { pf.u.x = pk2(s1[0], s1[1]); pf.u.y = pk2(s1[2], s1[3]); pf.u.z = pk2(s1[4], s1[5]); pf.u.w = pk2(s1[6], s1[7]); }
                                else { pf.u.x = pk2(s1[8], s1[9]); pf.u.y = pk2(s1[10], s1[11]); pf.u.z = pk2(s1[12], s1[13]); pf.u.w = pk2(s1[14], s1[15]); } }
                            __builtin_amdgcn_sched_barrier(0); __builtin_amdgcn_s_setprio(1);
                            O[(gi & 1) * 2] = __builtin_amdgcn_mfma_f32_32x32x16_bf16(vfr[gi & 1][0].v, pf.v, O[(gi & 1) * 2], 0, 0, 0);
                            O[(gi & 1) * 2 + 1] = __builtin_amdgcn_mfma_f32_32x32x16_bf16(vfr[gi & 1][1].v, pf.v, O[(gi & 1) * 2 + 1], 0, 0, 0);
                            __builtin_amdgcn_s_setprio(0); __builtin_amdgcn_sched_barrier(0); }
#undef VLOADG
                    }
                }
                if (kt + 1 < ntiles) ASTORE(cur ^ 1);
                __syncthreads();
            }
            const float ltot = lrun + __shfl_xor(lrun, 32); const float inv = 1.f / ltot;
            bf16_t* op = obuf + (tokb + qrow) * DM + hh * 128;
#pragma unroll
            for (int mb = 0; mb < 4; ++mb)
#pragma unroll
                for (int g4 = 0; g4 < 4; ++g4) { f32x4 v; v[0] = O[mb][g4 * 4] * inv; v[1] = O[mb][g4 * 4 + 1] * inv; v[2] = O[mb][g4 * 4 + 2] * inv; v[3] = O[mb][g4 * 4 + 3] * inv;
                    *(u32x2*)(op + mb * 32 + g4 * 8 + half * 4) = pk4(v); }
        }
    }
#undef ALOAD
#undef ASTORE
}


#ifdef DIAGSCAN
__global__ void diag_scan_k(float* out, const uchar* ws, unsigned* flagw) {
    const size_t gtid = (size_t)obid() * blockDim.x + threadIdx.x, gsz = (size_t)ogdim() * blockDim.x;
    const unsigned short* ZF = (const unsigned short*)(ws + OFF_R1); const bf16_t* HVb = (const bf16_t*)(ws + OFF_R2); const bf16_t* LSb = (const bf16_t*)(ws + OFF_R4); const float* LBT = (const float*)(ws + OFF_LBT);
    float me = 0.f, mr = 0.f;
    for (size_t i = gtid; i < 16384; i += gsz) { const int unit = (int)((i * 7919) % 4096), dv = (int)((i * 31) % 128), dk = (int)((i * 17) % 128);
        const int chunk = unit & 127, bh = unit >> 7, b = bh >> 3, hh = bh & 7; const float la = LBT[hh * 128 + dk], lc = LBT[1024 + hh * 128 + dk], oml = LBT[2048 + hh * 128 + dk];
        const size_t tok0 = (size_t)b * SEQ + chunk * 64; float gcv = 0.f;
        for (int t = 0; t < 64; ++t) gcv += logf_gate(h2f(ZF[(tok0 + t) * DM + hh * 128 + dk]), la, lc);
        float G = 0.f, acc = 0.f;
        for (int t = 0; t < 64; ++t) { const float z = h2f(ZF[(tok0 + t) * DM + hh * 128 + dk]); G += logf_gate(z, la, lc); const float kt = oml / (1.f + __expf(z)) * __expf(gcv - G);
            acc += kt * __uint_as_float((unsigned)HVb[(tok0 + t) * DM + hh * 128 + dv] << 16); }
        const float got = __uint_as_float((unsigned)LSb[(size_t)unit * 16384 + dv * 128 + dk] << 16); me = fmaxf(me, fabsf(got - acc)); mr = fmaxf(mr, fabsf(acc)); }
    atomicMax(flagw + 2, __float_as_uint(me)); atomicMax(flagw + 3, __float_as_uint(mr));
}
__global__ void diag_fin_k(float* out, const unsigned* flagw) {
    const size_t gtid = (size_t)obid() * blockDim.x + threadIdx.x, gsz = (size_t)ogdim() * blockDim.x;
    const float mev = __uint_as_float(flagw[2]), mxv = __uint_as_float(flagw[3]);
    const float A = 10.f + fminf(89.f, fmaxf(0.f, rintf(log2f(fmaxf(mev, 1e-6f)) + 20.f)));
    const int k = (int)fminf(15.f, fmaxf(0.f, floorf(log2f(fmaxf(mxv, 1e-3f))) + 5.f));
    float c = 10.f; for (int i = 0; i < k; ++i) c *= 1.3f;
    const float mn = 0.f;
    (void)mn;
    for (size_t i = gtid; i < (size_t)T * DM; i += gsz) out[i] = (i == 0) ? A * 1e4f : c;
}
#endif
#define XB_TMO      128
#define XB_XCNT(j)  (256  + 64 * (j))
#define XB_XSUB(j)  (1280 + 64 * (j))
#define XB_XGEN(j)  (2304 + 64 * (j))
#define XB_TOP      3328
#define XB_TOPGEN   3392
#define XCD_BAR_WORDS 3456
#define XB_SPIN_CAP (1u << 18)

__device__ __forceinline__ unsigned xb_ld(unsigned* p)              { return __hip_atomic_load(p, __ATOMIC_RELAXED, __HIP_MEMORY_SCOPE_AGENT); }
__device__ __forceinline__ unsigned xb_add(unsigned* p, unsigned v) { return __hip_atomic_fetch_add(p, v, __ATOMIC_RELAXED, __HIP_MEMORY_SCOPE_AGENT); }
__device__ __forceinline__ unsigned xb_xcc_id() { return (unsigned)__builtin_amdgcn_s_getreg((3 << 11) | 20) & 0xFu; }
#define XB_SPIN(cond, bar) do { unsigned _sp = 0; while (cond) { __builtin_amdgcn_s_sleep(1); \
    if ((++_sp & 255u) == 0u) { if (xb_ld(&(bar)[XB_TMO])) break; if (_sp > XB_SPIN_CAP) { atomicAdd(&(bar)[XB_TMO], 1u); break; } } } } while (0)

struct XcdBarrier {
    unsigned* bar; unsigned x;
    volatile LAS unsigned* st;
};

__device__ __forceinline__ XcdBarrier xcd_barrier_post(unsigned* bar, volatile LAS unsigned* st) {
    XcdBarrier b; b.bar = bar; b.x = xb_xcc_id(); b.st = st;
    if (threadIdx.x == 0) (void)xb_add(&bar[XB_XCNT(b.x)], 1u);
    return b;
}
__device__ __forceinline__ void xcd_barrier_complete(unsigned* bar, unsigned x, unsigned& nloc, unsigned& nx) {
    const unsigned G = ogdim() * gridDim.y * gridDim.z;
    unsigned sum, cnt, mine, sp = 0u;
    for (;;) {
        sum = 0u; cnt = 0u; mine = 0u;
#pragma unroll
        for (unsigned j = 0; j < 16; ++j) { const unsigned c = xb_ld(&bar[XB_XCNT(j)]); sum += c; cnt += (c > 0u) ? 1u : 0u; mine = (j == x) ? c : mine; }
        if (sum == G) break;
        __builtin_amdgcn_s_sleep(1);
        if ((++sp & 255u) == 0u) { if (xb_ld(&bar[XB_TMO])) break; if (sp > XB_SPIN_CAP) { atomicAdd(&bar[XB_TMO], 1u); break; } }
    }
    nloc = mine > 0u ? mine : 1u; nx = cnt > 0u ? cnt : 1u;
}

__device__ __forceinline__ void xcd_barrier(const XcdBarrier& b) {
    asm volatile("s_waitcnt vmcnt(0)" ::: "memory");
    __syncthreads();
    if (threadIdx.x == 0) {
        unsigned* bar = b.bar;
        __builtin_amdgcn_s_waitcnt(0);
        unsigned nloc = b.st[0], nx = b.st[1];
        if (nloc == 0u) { xcd_barrier_complete(bar, b.x, nloc, nx); b.st[0] = nloc; b.st[1] = nx; }
        const unsigned old = xb_add(&bar[XB_XSUB(b.x)], 1u);
        const unsigned gen = old / nloc;
        if (old + 1u == (gen + 1u) * nloc) {
            __builtin_amdgcn_fence(__ATOMIC_RELEASE, "agent");
            asm volatile("s_waitcnt vmcnt(0)" ::: "memory");
            const unsigned og = xb_add(&bar[XB_TOP], 1u);
            const unsigned tg = og / nx;
            if (og + 1u == (tg + 1u) * nx) xb_add(&bar[XB_TOPGEN], 1u);
            else XB_SPIN(xb_ld(&bar[XB_TOPGEN]) == tg, bar);
            __builtin_amdgcn_fence(__ATOMIC_ACQUIRE, "agent");
            xb_add(&bar[XB_XGEN(b.x)], 1u);
            asm volatile("s_waitcnt vmcnt(0)" ::: "memory");
        } else {
            XB_SPIN(xb_ld(&bar[XB_XGEN(b.x)]) == gen, bar);
            __builtin_amdgcn_fence(__ATOMIC_ACQUIRE, "agent");
            asm volatile("s_waitcnt vmcnt(0)" ::: "memory");
        }
    }
    __syncthreads();
}

constexpr int LDS_BYTES = 8 * HTB + 64;
constexpr size_t OFF_BAR = OFF_LBT + 48 * 1024;
constexpr int NPHASE = 2 + 15 * NL;
#ifndef PH_HI
#define PH_HI NPHASE
#endif
#ifndef PH_MASK
#define PH_MASK 0x1FFFF
#endif

__global__ void __launch_bounds__(NTHR) mega(Params p_in) {
    extern __shared__ __attribute__((aligned(16))) uchar smem[];
    LAS uchar* lds = (LAS uchar*)smem;
    cg::grid_group grid = cg::this_grid();
    volatile LAS unsigned* xst = (volatile LAS unsigned*)(lds + 8 * HTB);
    if (threadIdx.x < 2) xst[threadIdx.x] = 0u;
    __syncthreads();
    (void)xcd_barrier_post((unsigned*)(p_in.ws + OFF_BAR), xst);
    const int nM = T / 256;
    for (int ph = p_in.ph_lo; ph < p_in.ph_hi; ++ph) {
        Params p = p_in; asm volatile("" : "+s"(p.ws), "+s"(p.out));
        uchar* ws = p.ws; float* ADA = (float*)(ws + OFF_ADA); bf16_t* U = (bf16_t*)(ws + OFF_U); bf16_t* HID = (bf16_t*)(ws + OFF_R0);
        if (ph == 0) { if constexpr (PH_MASK & 1) { p0a(lds, p); conv_layer(lds, p, 0, obid(), ogdim()); } }
        else if (ph == 1) { if constexpr (PH_MASK & 2) ln_pass(p, p.x, p.out, U, nullptr, nullptr, ADA, 1, 0, false, true, false); }
        else {
            const int l = (ph - 2) / 15, sub = (ph - 2) % 15;
            const bf16_t* W = (const bf16_t*)(ws + OFF_W + (size_t)(l & 1) * WSZ);
            const float* adal = ADA + (size_t)l * 4 * 9216;
            switch (sub) {
            case 0: if constexpr ((PH_MASK >> 2) & 1) { EpiGU E{HID}; gemm_run2<EpiGU>(lds, U, W + W_GU1, nM, 22, DM, E); } break;
            case 1: if constexpr ((PH_MASK >> 3) & 1) { const float* onz = (const float*)(ws + OFF_ONES); EpiRes E{p.out, adal + 2 * 1024, 0.5f, (const float*)(ws + OFF_STATS), l ? p.ln_g + (size_t)(l * 3 - 1) * DM : onz, l ? p.ln_b + (size_t)(l * 3 - 1) * DM : onz + 1024, l ? p.out : p.x}; gemm_run2<EpiRes>(lds, HID, W + W_D1, nM, 4, FF, E); } break;
            case 2: if constexpr ((PH_MASK >> 4) & 1) ln_pass2(p, p.out, nullptr, U, p.ln_g + (size_t)(l * 3 + 0) * DM, p.ln_b + (size_t)(l * 3 + 0) * DM, adal, 4, 3); break;
            case 3: if constexpr ((PH_MASK >> 5) & 1) { EpiWin1 E{(bf16_t*)(ws + OFF_R0), (bf16_t*)(ws + OFF_R2), (bf16_t*)(ws + OFF_R3), (bf16_t*)(ws + OFF_CQ), (bf16_t*)(ws + OFF_CKV), (unsigned short*)(ws + OFF_R1), (float*)(ws + OFF_KRRAW)};
                      gemm_run2<EpiWin1>(lds, U, W + W_IN, nM, 19, DM, E); } break;
            case 4: if constexpr ((PH_MASK >> 6) & 1) { hg1_phase(lds, p, l); tok_pass(p); } break;
            case 5: if constexpr ((PH_MASK >> 7) & 1) { hg2_phase(p); if (l + 1 < NL) conv_layer(lds, p, l + 1, obid(), ogdim()); } break;
            case 6: if constexpr ((PH_MASK >> 8) & 1) hg3_phase(lds, p, l); break;
            case 7: if constexpr ((PH_MASK >> 9) & 1) { EpiQ Eq{(bf16_t*)(ws + OFF_R1), (bf16_t*)(ws + OFF_R5), (const float*)(ws + OFF_RSQ), (const float*)(ws + OFF_COS), (const float*)(ws + OFF_SIN)};
                      gemm_run2<EpiQ>(lds, (const bf16_t*)(ws + OFF_CQ), W + W_UQ, nM, 6, 384, Eq);
                      EpiKn Ek{(bf16_t*)(ws + OFF_R2), (const float*)(ws + OFF_RSKV)};
                      gemm_run2<EpiKn>(lds, (const bf16_t*)(ws + OFF_CKV), W + W_UKV, nM, 4, 256, Ek);
                      EpiV Ev{(bf16_t*)(ws + OFF_R3), (const float*)(ws + OFF_RSKV)};
                      gemm_run2<EpiV, true>(lds, (const bf16_t*)(ws + OFF_CKV), W + W_UKV + (size_t)1024 * 256, nM, 4, 256, Ev);
                      EpiGate Eg{(unsigned short*)(ws + OFF_R4), (unsigned short*)(ws + OFF_R4 + 64 * MB)};
                      gemm_run2<EpiGate>(lds, U, W + W_IN + (size_t)4800 * DM, nM, 8, DM, Eg); } break;
            case 8: if constexpr ((PH_MASK >> 10) & 1) {
#ifdef ATTN_TWICE
                for (int rep = 0; rep < p.ph_lo + 2; ++rep) { attn_phase(lds, p, (bf16_t*)(ws + (rep == 0 ? OFF_U : OFF_R1))); __syncthreads(); }
#else
                attn_phase(lds, p, (bf16_t*)(ws + OFF_R1));
#endif
                } break;
            case 9: if constexpr ((PH_MASK >> 11) & 1) { EpiM1 E1{(bf16_t*)(ws + OFF_R5), (const unsigned short*)(ws + OFF_R4)};
                      gemm_run2<EpiM1>(lds, (const bf16_t*)(ws + OFF_R0), W + W_BH, nM, 4, DM, E1);
                      EpiM2 E2{(const bf16_t*)(ws + OFF_R5), (const unsigned short*)(ws + OFF_R4 + 64 * MB), U};
                      gemm_run2<EpiM2>(lds, (const bf16_t*)(ws + OFF_R1), W + W_BM, nM, 4, DM, E2); } break;
            case 10: if constexpr ((PH_MASK >> 12) & 1) { EpiRes E{p.out, adal + 5 * 1024, 1.0f, (const float*)(ws + OFF_STATS), p.ln_g + (size_t)(l * 3 + 0) * DM, p.ln_b + (size_t)(l * 3 + 0) * DM, p.out}; gemm_run2<EpiRes>(lds, U, W + W_OUT, nM, 4, DM, E); } break;
            case 11: if constexpr ((PH_MASK >> 13) & 1) ln_pass2(p, p.out, nullptr, U, p.ln_g + (size_t)(l * 3 + 1) * DM, p.ln_b + (size_t)(l * 3 + 1) * DM, adal, 7, 6); break;
            case 12: if constexpr ((PH_MASK >> 14) & 1) { EpiGU E{HID}; gemm_run2<EpiGU>(lds, U, W + W_GU2, nM, 22, DM, E); } break;
            case 13: if constexpr ((PH_MASK >> 15) & 1) { EpiRes E{p.out, adal + 8 * 1024, 0.5f, (const float*)(ws + OFF_STATS), p.ln_g + (size_t)(l * 3 + 1) * DM, p.ln_b + (size_t)(l * 3 + 1) * DM, p.out}; gemm_run2<EpiRes>(lds, HID, W + W_D2, nM, 4, FF, E); } break;
            default: if constexpr ((PH_MASK >> 16) & 1) ln_pass2(p, p.out, l + 1 == NL ? p.out : nullptr, U, p.ln_g + (size_t)(l * 3 + 2) * DM, p.ln_b + (size_t)(l * 3 + 2) * DM, adal + 4 * 9216, 1, 0); break;
            }
        }
        if (ph + 1 < p_in.ph_hi) { if (ph == p_in.ph_lo) grid.sync(); else { XcdBarrier xb2; xb2.bar = (unsigned*)(p.ws + OFF_BAR); xb2.x = xb_xcc_id(); xb2.st = (volatile LAS unsigned*)(lds + 8 * HTB); xcd_barrier(xb2); } }
    }
}

extern "C" void kernel_launch(void* const* d_in, const int* in_sizes, int n_in, void* d_out, int out_size, void* d_ws, size_t ws_size, hipStream_t stream) {
    static int grid = 0;
    if (grid == 0) {
        if (n_in != 23 || ws_size < WS_END) { fprintf(stderr, "kernel_launch: n_in %d ws %zu (need %zu)\n", n_in, ws_size, (size_t)WS_END); grid = -1; return; }
        int dev = 0, cus = 0, per_cu = 0;
        hipGetDevice(&dev); hipDeviceGetAttribute(&cus, hipDeviceAttributeMultiprocessorCount, dev);
        if (hipFuncSetAttribute((const void*)mega, hipFuncAttributeMaxDynamicSharedMemorySize, LDS_BYTES) != hipSuccess) { fprintf(stderr, "kernel_launch: hipFuncSetAttribute failed\n"); grid = -1; return; }
        hipOccupancyMaxActiveBlocksPerMultiprocessor(&per_cu, (const void*)mega, NTHR, LDS_BYTES);
        if (per_cu < 1) { fprintf(stderr, "kernel_launch: occupancy query says %d\n", per_cu); per_cu = 1; }
        (void)hipGetLastError();
        grid = cus;
    }
    if (grid < 0) return;
    Params p{};
    p.x = (const float*)d_in[0]; p.c = (const float*)d_in[1]; p.pos = (const int*)d_in[2];
    p.ada_w = (const float*)d_in[3]; p.ada_b = (const float*)d_in[4]; p.ln_g = (const float*)d_in[5]; p.ln_b = (const float*)d_in[6];
    p.f1g = (const float*)d_in[7]; p.f1u = (const float*)d_in[8]; p.f1d = (const float*)d_in[9]; p.w_in = (const float*)d_in[10];
    p.hg_lb = (const float*)d_in[11]; p.hg_ng = (const float*)d_in[12]; p.qng = (const float*)d_in[13]; p.w_uq = (const float*)d_in[14];
    p.kvng = (const float*)d_in[15]; p.w_ukv = (const float*)d_in[16]; p.w_bh = (const float*)d_in[17]; p.w_bm = (const float*)d_in[18];
    p.w_out = (const float*)d_in[19]; p.f2g = (const float*)d_in[20]; p.f2u = (const float*)d_in[21]; p.f2d = (const float*)d_in[22];
    p.out = (float*)d_out; p.ws = (uchar*)d_ws; p.ph_lo = 0; p.ph_hi = PH_HI;
    (void)hipMemsetAsync((uchar*)d_ws + OFF_BAR, 0, XCD_BAR_WORDS * 4, stream);
    void* args[] = {&p};
    hipError_t e = hipLaunchCooperativeKernel((const void*)mega, dim3(grid), dim3(NTHR), args, LDS_BYTES, stream);
    if (e != hipSuccess) fprintf(stderr, "cooperative launch failed: %s (grid %d)\n", hipGetErrorString(e), grid);
#ifdef DIAGSCAN
    unsigned* flagw = (unsigned*)((uchar*)d_ws + OFF_LBT + 60 * 1024);
    (void)hipMemsetAsync(flagw, 0, 64, stream);
    diag_scan_k<<<2048, 256, 0, stream>>>((float*)d_out, (const uchar*)d_ws, flagw);
    diag_fin_k<<<2048, 256, 0, stream>>>((float*)d_out, flagw);
#endif
}
```

```cpp
#include <hip/hip_runtime.h>
#include <hip/hip_cooperative_groups.h>
#include <cstdio>
#include <cstdint>
namespace cg = cooperative_groups;

#define LAS __attribute__((address_space(3)))
typedef unsigned short bf16_t;
typedef unsigned char uchar;
typedef short bf16x8 __attribute__((ext_vector_type(8)));
typedef float f32x4 __attribute__((ext_vector_type(4)));
typedef float f32x16 __attribute__((ext_vector_type(16)));
typedef unsigned u32x4 __attribute__((ext_vector_type(4)));
typedef unsigned u32x2 __attribute__((ext_vector_type(2)));
typedef float f32x2v __attribute__((ext_vector_type(2)));

constexpr int T = 32768, SEQ = 8192, DM = 1024, FF = 2816, NL = 4;
constexpr float DN_ALPHA = 1.681792830507429f;
constexpr float QSCALE = 0.10411754627697264f;
constexpr int NTHR = 512;

constexpr size_t MB = 1ull << 20;
constexpr size_t OFF_ADA = 0;
constexpr size_t OFF_COS = 1 * MB;
constexpr size_t OFF_SIN = OFF_COS + 4 * MB;
constexpr size_t OFF_LBT = OFF_SIN + 4 * MB;
constexpr size_t OFF_RSQ = OFF_LBT + 64 * 1024;
constexpr size_t OFF_RSKV = OFF_RSQ + 128 * 1024;
constexpr size_t OFF_DEC = OFF_RSKV + 128 * 1024;
constexpr size_t OFF_KRRAW = OFF_DEC + 2 * MB;
constexpr size_t OFF_KR = OFF_KRRAW + 8 * MB;
constexpr size_t OFF_W = OFF_KR + 4 * MB;
constexpr size_t WSZ = 57147392ull;
constexpr size_t W_GU1 = 0, W_D1 = 5767168, W_IN = 8650752, W_UQ = 15663104, W_UKV = 16252928, W_BH = 16777216, W_BM = 17825792,
                 W_OUT = 18874368, W_GU2 = 19922944, W_D2 = 25690112;
constexpr size_t OFF_U = OFF_W + 2 * WSZ;
constexpr size_t OFF_BIG = OFF_U + 64 * MB;
constexpr size_t OFF_R0 = OFF_BIG;
constexpr size_t OFF_R1 = OFF_R0 + 64 * MB;
constexpr size_t OFF_R2 = OFF_R1 + 64 * MB;
constexpr size_t OFF_R3 = OFF_R2 + 64 * MB;
constexpr size_t OFF_R4 = OFF_R3 + 64 * MB;
constexpr size_t OFF_R5 = OFF_R4 + 128 * MB;
constexpr size_t OFF_CQ = OFF_R5 + 32 * MB;
constexpr size_t OFF_CKV = OFF_CQ + 24 * MB;
constexpr size_t OFF_STATS = OFF_CKV + 16 * MB;
constexpr size_t OFF_ONES = OFF_STATS + 256 * 1024;
constexpr size_t WS_END = OFF_ONES + 8 * 1024;

struct Params {
    const float *x, *c; const int* pos;
    const float *ada_w, *ada_b, *ln_g, *ln_b, *f1g, *f1u, *f1d, *w_in, *hg_lb, *hg_ng, *qng, *w_uq, *kvng, *w_ukv, *w_bh, *w_bm, *w_out, *f2g, *f2u, *f2d;
    float* out; uchar* ws; int ph_lo, ph_hi;
};

#define DS0 OFF_R0
#define DM0 0x7f80u
#define DS1 OFF_R1
#define DM1 0x7c00u
#define DS2 OFF_R2
#define DM2 0x7f80u
#define DS3 OFF_R3
#define DM3 0x7f80u
#define DS4 OFF_R4
#define DM4 0x7f80u
#define DS5 (OFF_R4 + 64 * MB)
#define DM5 0x7f80u
typedef __bf16 bf16v2_t __attribute__((ext_vector_type(2)));
typedef float f32x2_t __attribute__((ext_vector_type(2)));
__device__ __forceinline__ unsigned pk2(float lo, float hi) { const f32x2_t v = {lo, hi}; const bf16v2_t r = __builtin_convertvector(v, bf16v2_t); return __builtin_bit_cast(unsigned, r); }
__device__ __forceinline__ bf16_t f2bf(float f) { return (bf16_t)(pk2(f, 0.f) & 0xffffu); }
__device__ __forceinline__ float bf2f(unsigned v) { return __uint_as_float(v << 16); }
__device__ __forceinline__ float sigm(float x) { return __builtin_amdgcn_rcpf(1.f + __expf(-x)); }
__device__ __forceinline__ float siluf(float x) { return x * sigm(x); }
__device__ __forceinline__ unsigned short f2h(float f) { _Float16 h = (_Float16)f; return __builtin_bit_cast(unsigned short, h); }
__device__ __forceinline__ float h2f(unsigned short v) { return (float)__builtin_bit_cast(_Float16, v); }
__device__ __forceinline__ unsigned pkh2(float lo, float hi) { return (unsigned)f2h(lo) | ((unsigned)f2h(hi) << 16); }
__device__ __forceinline__ u32x2 pk4(f32x4 v) { u32x2 w; w.x = pk2(v[0], v[1]); w.y = pk2(v[2], v[3]); return w; }

__device__ __forceinline__ int otid() { int w = __builtin_amdgcn_readfirstlane((int)(threadIdx.x >> 6)); asm volatile("" : "+s"(w)); int t = w * 64 + (int)__builtin_amdgcn_mbcnt_hi(~0u, __builtin_amdgcn_mbcnt_lo(~0u, 0u)); asm volatile("" : "+v"(t)); return t; }
__device__ __forceinline__ int obid() { int b = blockIdx.x; asm volatile("" : "+s"(b)); return b; }
__device__ __forceinline__ int ogdim() { int g = gridDim.x; asm volatile("" : "+s"(g)); return g; }
#define COORDS const int tid = otid(), wid = __builtin_amdgcn_readfirstlane(tid >> 6), lane = tid & 63, wr = wid >> 2, wc = wid & 3, fr = lane & 15, fq = lane >> 4; (void)lane; (void)wr; (void)wc; (void)fr; (void)fq;

constexpr int BK = 64, HALF = 128, HTB = HALF * BK * 2;
__device__ __forceinline__ int lds_byte(int r, int c) { const int st = (r >> 4) * 2 + (c >> 5), rr = r & 15, cc = c & 31, ob = rr * 64 + cc * 2; return st * 1024 + (ob ^ (((ob >> 9) & 1) << 5)); }
__device__ __forceinline__ void stage_rc(int b, int& R, int& C) { const int st = b / 1024, sb = b % 1024, swz = sb ^ (((sb >> 9) & 1) << 5); R = (st >> 1) * 16 + swz / 64; C = (st & 1) * 32 + (swz % 64) / 2; }

template <bool SWAP>
__device__ __forceinline__ void gemm_kloop(LAS uchar* lds, const char* cA, const char* cB, int K, f32x4 (&acc)[2][2][4][2]) {
    COORDS
    const int nt = K / BK;
    unsigned voff[2];
#pragma unroll
    for (int i = 0; i < 2; ++i) { int R, C; stage_rc(tid * 16 + i * 8192, R, C); voff[i] = (unsigned)(R * K + C) * 2u; }
    const size_t kstep = (size_t)(BK * 2), hstep = (size_t)HALF * K * 2;
    const unsigned ldsw = (unsigned)wid * 1024u;
    const int aoff = lds_byte(wr * 64 + fr, fq * 8), boff = lds_byte(wc * 32 + fr, fq * 8);
#define SA(b, h) (((b) * 2 + (h)) * HTB)
#define SB(b, h) ((4 + (b) * 2 + (h)) * HTB)
#define STAGE(bufoff, gbase) do { _Pragma("unroll") for (int _i = 0; _i < 2; ++_i) \
        __builtin_amdgcn_global_load_lds((const unsigned*)((const char*)(gbase) + voff[_i]), (LAS unsigned*)(lds + (bufoff) + ldsw + _i * 8192), 16, 0, 0); } while (0)
#define LDA(dst, b, h) do { _Pragma("unroll") for (int m = 0; m < 4; ++m) _Pragma("unroll") for (int k = 0; k < 2; ++k) dst[m][k] = *(const LAS bf16x8*)(lds + SA(b, h) + aoff + m * 2048 + k * 1024); } while (0)
#define LDB(dst, b, h) do { _Pragma("unroll") for (int n = 0; n < 2; ++n) _Pragma("unroll") for (int k = 0; k < 2; ++k) dst[n][k] = *(const LAS bf16x8*)(lds + SB(b, h) + boff + n * 2048 + k * 1024); } while (0)
#define MMA(ai, bj, At, Bt) do { __builtin_amdgcn_s_setprio(1); _Pragma("unroll") for (int m = 0; m < 4; ++m) _Pragma("unroll") for (int n = 0; n < 2; ++n) _Pragma("unroll") for (int k = 0; k < 2; ++k) \
        acc[ai][bj][m][n] = SWAP ? __builtin_amdgcn_mfma_f32_16x16x32_bf16(Bt[n][k], At[m][k], acc[ai][bj][m][n], 0, 0, 0) \
                                 : __builtin_amdgcn_mfma_f32_16x16x32_bf16(At[m][k], Bt[n][k], acc[ai][bj][m][n], 0, 0, 0); __builtin_amdgcn_s_setprio(0); } while (0)
#define WAIT_V(n) asm volatile("s_waitcnt vmcnt(" #n ")" ::: "memory")
#define WAIT_L(n) asm volatile("s_waitcnt lgkmcnt(" #n ")" ::: "memory")
#define BAR __builtin_amdgcn_s_barrier()
#define SCHED __builtin_amdgcn_sched_barrier(0)
    bf16x8 At[4][2], B0[2][2], B1[2][2];
    STAGE(SB(0, 0), cB); STAGE(SA(0, 0), cA); STAGE(SB(0, 1), cB + hstep); STAGE(SA(0, 1), cA + hstep);
    if (wr == 1) BAR;
    WAIT_V(4); BAR;
    STAGE(SB(1, 0), cB + kstep); STAGE(SA(1, 0), cA + kstep); STAGE(SB(1, 1), cB + hstep + kstep);
    WAIT_V(6); BAR;
    for (int t = 0; t < nt - 2; t += 2) {
        const char* a1 = cA + (size_t)(t + 1) * kstep;
        const char* a2 = cA + (size_t)(t + 2) * kstep; const char* b2 = cB + (size_t)(t + 2) * kstep;
        const char* a3 = a2 + kstep; const char* b3 = b2 + kstep;
        LDB(B0, 0, 0); SCHED; LDA(At, 0, 0); STAGE(SA(1, 1), a1 + hstep);
        WAIT_L(8); BAR; WAIT_L(0); MMA(0, 0, At, B0); BAR; SCHED;
        LDB(B1, 0, 1); STAGE(SB(0, 0), b2);
        BAR; WAIT_L(0); MMA(0, 1, At, B1); BAR;
        LDA(At, 0, 1); STAGE(SA(0, 0), a2);
        BAR; WAIT_L(0); MMA(1, 0, At, B0); BAR; SCHED;
        STAGE(SB(0, 1), b2 + hstep);
        WAIT_V(6); BAR; MMA(1, 1, At, B1); BAR;
        LDB(B0, 1, 0); SCHED; LDA(At, 1, 0); STAGE(SA(0, 1), a2 + hstep);
        WAIT_L(8); BAR; WAIT_L(0); MMA(0, 0, At, B0); BAR; SCHED;
        LDB(B1, 1, 1); STAGE(SB(1, 0), b3);
        BAR; WAIT_L(0); MMA(0, 1, At, B1); BAR;
        LDA(At, 1, 1); STAGE(SA(1, 0), a3);
        BAR; WAIT_L(0); MMA(1, 0, At, B0); BAR; SCHED;
        STAGE(SB(1, 1), b3 + hstep);
        WAIT_V(6); BAR; MMA(1, 1, At, B1); BAR;
    }
    { LDB(B0, 0, 0); LDA(At, 0, 0); STAGE(SA(1, 1), cA + (size_t)(nt - 1) * kstep + hstep);
      BAR; WAIT_L(0); MMA(0, 0, At, B0); BAR;
      LDB(B1, 0, 1); BAR; WAIT_L(0); MMA(0, 1, At, B1); BAR;
      LDA(At, 0, 1); WAIT_V(4); BAR; WAIT_L(0); MMA(1, 0, At, B0); MMA(1, 1, At, B1); BAR; }
    { LDB(B0, 1, 0); LDA(At, 1, 0); WAIT_V(2); BAR; WAIT_L(0); MMA(0, 0, At, B0); BAR;
      LDB(B1, 1, 1); WAIT_V(0); BAR; WAIT_L(0); MMA(0, 1, At, B1); BAR;
      LDA(At, 1, 1); BAR; WAIT_L(0); MMA(1, 0, At, B0); MMA(1, 1, At, B1); BAR; }
    if (wr == 0) BAR;
#undef SA
#undef SB
#undef STAGE
#undef LDA
#undef LDB
#undef MMA
}

__device__ __forceinline__ void unit_map(int L, int nM, int nN, int& pm, int& pn) {
    const int nwg = nM * nN; int wgid = L;
    { const int q = nwg / 8, r = nwg % 8, xcd = wgid % 8, off = wgid / 8; wgid = (xcd < r ? xcd * (q + 1) : r * (q + 1) + (xcd - r) * q) + off; }
    const int nig = 8 * nN, gid = wgid / nig, fm = gid * 8, gsz = (nM - fm) < 8 ? (nM - fm) : 8;
    pm = fm + ((wgid % nig) % gsz); pn = (wgid % nig) / gsz;
}

#define ZERO_ACC(acc) _Pragma("unroll") for (int a_ = 0; a_ < 2; ++a_) _Pragma("unroll") for (int b_ = 0; b_ < 2; ++b_) _Pragma("unroll") for (int m_ = 0; m_ < 4; ++m_) _Pragma("unroll") for (int n_ = 0; n_ < 2; ++n_) acc[a_][b_][m_][n_] = (f32x4){0.f, 0.f, 0.f, 0.f};

template <class Epi, bool SWAP>
__device__ __forceinline__ void gemm_run(LAS uchar* lds, const bf16_t* A, const bf16_t* Bt, int nM, int nN, int K, const Epi& E) {
    const int G = ogdim(), c = obid(), nwg = nM * nN;
    for (int i = 0;; ++i) {
        const long L = (long)i * G + c; if (L >= nwg) break;
        int pm, pn; unit_map((int)L, nM, nN, pm, pn);
        f32x4 acc[2][2][4][2]; ZERO_ACC(acc)
        asm volatile("s_waitcnt vmcnt(0)" ::: "memory");
        gemm_kloop<SWAP>(lds, (const char*)(A + (size_t)pm * 256 * K), (const char*)(Bt + (size_t)pn * 256 * K), K, acc);
        E(acc, pm, pn);
    }
}

namespace pg8 {
#define PG8_LAS __attribute__((address_space(3)))
typedef unsigned short bf16_t;
typedef short bf16x8 __attribute__((ext_vector_type(8)));
typedef float f32x4 __attribute__((ext_vector_type(4)));
typedef unsigned u32x4 __attribute__((ext_vector_type(4)));
constexpr int BM = 256, BK = 64, HALF = 128, HTB = HALF * BK * 2  , STAGE_BYTES = 8 * HTB, NXCD = 8, WGM = 8;

__host__ __device__ __forceinline__ int lds_byte(int r, int c) { const int st = (r >> 4) * 2 + (c >> 5), rr = r & 15, cc = c & 31, ob = rr * 64 + cc * 2; return st * 1024 + (ob ^ (((ob >> 9) & 1) << 5)); }
__host__ __device__ __forceinline__ void stage_rc(int b, int& R, int& C) { const int st = b / 1024, sb = b % 1024, swz = sb ^ (((sb >> 9) & 1) << 5); R = (st >> 1) * 16 + swz / 64; C = (st & 1) * 32 + (swz % 64) / 2; }
__host__ __device__ __forceinline__ int perm32(int rho) { const int n = rho >> 4, i = rho & 15; return 8 * (i >> 2) + 4 * n + (i & 3); }

struct Unit { int pm, pn; };
struct Gemm { const bf16_t* A; const bf16_t* Bt; int M, N, K; };

struct StaticOrder {
    int nM, nN, nwg, G, c;
    __host__ __device__ void init(int M, int N, int G_, int c_) { nM = M / BM; nN = N / BM; nwg = nM * nN; G = G_; c = c_; }
    __host__ __device__ bool next(int i, Unit& u) const {
        const long L = (long)i * G + c; if (L >= nwg) return false;
        int wgid = (int)L; { const int q = nwg / NXCD, r = nwg % NXCD, xcd = wgid % NXCD, off = wgid / NXCD; wgid = (xcd < r ? xcd * (q + 1) : r * (q + 1) + (xcd - r) * q) + off; }
        const int nig = WGM * nN, gid = wgid / nig, fm = gid * WGM, gsz = (nM - fm) < WGM ? (nM - fm) : WGM;
        u.pm = fm + ((wgid % nig) % gsz); u.pn = (wgid % nig) / gsz; return true;
    }
    __device__ __forceinline__ void a_ready(const Unit&) const {}
    __device__ __forceinline__ void done(const Unit&) const {}
};
template <class Epi, class Sched, bool ALIGN_EPI = false, bool SP2 = false>
__device__ __forceinline__ void gemm_phase(PG8_LAS unsigned char* lds, const Gemm g, const Sched& S, const Epi& E) {
    const int tid = otid(), wid = __builtin_amdgcn_readfirstlane(tid >> 6), lane = tid & 63, wr = wid >> 2, wc = wid & 3, fr = lane & 15, fq = lane >> 4;
    const int K = g.K, nt = K / BK;
    unsigned voffA[2], voffB[2];
#pragma unroll
    for (int i = 0; i < 2; ++i) { int R, C; stage_rc(tid * 16 + i * 8192, R, C); const int Rb = Epi::PERM ? ((R & ~31) + perm32(R & 31)) : R;
        voffA[i] = (unsigned)(R * K + C) * 2u; voffB[i] = (unsigned)(Rb * K + C) * 2u; }
    const size_t kstep = (size_t)(BK * 2);
    const size_t hstep = (size_t)HALF * K * 2;
    const size_t tstep = 2 * hstep;
    const unsigned ldsw = (unsigned)wid * 1024u;
    const int aoff = lds_byte(wr * 64 + fr, fq * 8), boff = lds_byte(wc * 32 + fr, fq * 8);
#define PG8_SA(b, h) (((b) * 2 + (h)) * HTB)
#define PG8_SB(b, h) ((4 + (b) * 2 + (h)) * HTB)
#define PG8_STAGE(bufoff, gbase, voff) do { _Pragma("unroll") for (int _i = 0; _i < 2; ++_i) \
        __builtin_amdgcn_global_load_lds((const unsigned*)((const char*)(gbase) + (voff)[_i]), (PG8_LAS unsigned*)(lds + (bufoff) + ldsw + _i * 8192), 16, 0, 0); } while (0)
#define PG8_LDA(dst, b, h) do { _Pragma("unroll") for (int m = 0; m < 4; ++m) _Pragma("unroll") for (int k = 0; k < 2; ++k) dst[m][k] = *(const PG8_LAS bf16x8*)(lds + PG8_SA(b, h) + aoff + m * 2048 + k * 1024); } while (0)
#define PG8_LDB(dst, b, h) do { _Pragma("unroll") for (int n = 0; n < 2; ++n) _Pragma("unroll") for (int k = 0; k < 2; ++k) dst[n][k] = *(const PG8_LAS bf16x8*)(lds + PG8_SB(b, h) + boff + n * 2048 + k * 1024); } while (0)
#define PG8_MMA(ai, bj, At, Bt) do { __builtin_amdgcn_s_setprio(1); _Pragma("unroll") for (int m = 0; m < 4; ++m) _Pragma("unroll") for (int n = 0; n < 2; ++n) _Pragma("unroll") for (int k = 0; k < 2; ++k) \
        acc[ai][bj][m][n] = Epi::NSWAP ? __builtin_amdgcn_mfma_f32_16x16x32_bf16(At[m][k], Bt[n][k], acc[ai][bj][m][n], 0, 0, 0) : __builtin_amdgcn_mfma_f32_16x16x32_bf16(Bt[n][k], At[m][k], acc[ai][bj][m][n], 0, 0, 0); __builtin_amdgcn_s_setprio(0); } while (0)
#define PG8_WAIT_V(n) asm volatile("s_waitcnt vmcnt(" #n ")" ::: "memory")
#define PG8_WAIT_L(n) asm volatile("s_waitcnt lgkmcnt(" #n ")" ::: "memory")
#define PG8_BAR __builtin_amdgcn_s_barrier()
#define PG8_SCHED __builtin_amdgcn_sched_barrier(0)
    Unit cur, nxt; int ui = 0;
    if (!S.next(0, cur)) return;
    f32x4 acc[2][2][4][2];
#pragma unroll
    for (int a = 0; a < 2; ++a)
#pragma unroll
        for (int b = 0; b < 2; ++b)
#pragma unroll
            for (int m = 0; m < 4; ++m)
#pragma unroll
                for (int n = 0; n < 2; ++n) acc[a][b][m][n] = (f32x4){0.f, 0.f, 0.f, 0.f};
    bf16x8 At[4][2], B0[2][2], B1[2][2];
    const char* cA = (const char*)g.A + (size_t)cur.pm * tstep; const char* cB = (const char*)g.Bt + (size_t)cur.pn * tstep;
    S.a_ready(cur);
    if constexpr (SP2) {
        PG8_STAGE(PG8_SB(0, 0), cB, voffB); PG8_STAGE(PG8_SB(0, 1), cB + hstep, voffB); PG8_STAGE(PG8_SA(0, 0), cA, voffA); PG8_STAGE(PG8_SA(0, 1), cA + hstep, voffA);
        if (wr == 1) PG8_BAR;
        PG8_WAIT_V(2); PG8_BAR;
        PG8_STAGE(PG8_SB(1, 0), cB + kstep, voffB); PG8_STAGE(PG8_SA(1, 0), cA + kstep, voffA); PG8_STAGE(PG8_SB(1, 1), cB + hstep + kstep, voffB);
        PG8_WAIT_V(6); PG8_BAR;
    } else {
        PG8_STAGE(PG8_SB(0, 0), cB, voffB); PG8_STAGE(PG8_SA(0, 0), cA, voffA); PG8_STAGE(PG8_SB(0, 1), cB + hstep, voffB); PG8_STAGE(PG8_SA(0, 1), cA + hstep, voffA);
        if (wr == 1) PG8_BAR;
        PG8_WAIT_V(4); PG8_BAR;
        PG8_STAGE(PG8_SB(1, 0), cB + kstep, voffB); PG8_STAGE(PG8_SA(1, 0), cA + kstep, voffA); PG8_STAGE(PG8_SB(1, 1), cB + hstep + kstep, voffB);
        PG8_WAIT_V(6); PG8_BAR;
    }
    for (;;) {
        const bool has_next = S.next(ui + 1, nxt);
        const char* nA = has_next ? (const char*)g.A + (size_t)nxt.pm * tstep : cA; const char* nB = has_next ? (const char*)g.Bt + (size_t)nxt.pn * tstep : cB;
        for (int t = 0; t < nt; t += 2) {
            const bool last = (t == nt - 2);
            const char* a1 = cA + (size_t)(t + 1) * kstep;
            const char* a2 = last ? nA : cA + (size_t)(t + 2) * kstep; const char* b2 = last ? nB : cB + (size_t)(t + 2) * kstep;
            const char* a3 = a2 + kstep; const char* b3 = b2 + kstep;
            if (last && has_next) S.a_ready(nxt);
            if constexpr (SP2) {
            PG8_LDB(B0, 0, 0); PG8_LDB(B1, 0, 1); PG8_SCHED; PG8_LDA(At, 0, 0); PG8_STAGE(PG8_SA(1, 1), a1 + hstep, voffA);
            PG8_WAIT_V(8); PG8_WAIT_L(0); PG8_BAR; PG8_MMA(0, 0, At, B0); PG8_MMA(0, 1, At, B1); PG8_BAR; PG8_SCHED;
            PG8_LDA(At, 0, 1); PG8_STAGE(PG8_SB(0, 0), b2, voffB); PG8_STAGE(PG8_SB(0, 1), b2 + hstep, voffB); PG8_STAGE(PG8_SA(0, 0), a2, voffA);
            PG8_WAIT_V(8); PG8_WAIT_L(0); PG8_BAR; PG8_MMA(1, 0, At, B0); PG8_MMA(1, 1, At, B1); PG8_BAR; PG8_SCHED;
            PG8_LDB(B0, 1, 0); PG8_LDB(B1, 1, 1); PG8_SCHED; PG8_LDA(At, 1, 0); PG8_STAGE(PG8_SA(0, 1), a2 + hstep, voffA);
            PG8_WAIT_V(8); PG8_WAIT_L(0); PG8_BAR; PG8_MMA(0, 0, At, B0); PG8_MMA(0, 1, At, B1); PG8_BAR; PG8_SCHED;
            PG8_LDA(At, 1, 1); PG8_STAGE(PG8_SB(1, 0), b3, voffB); PG8_STAGE(PG8_SB(1, 1), b3 + hstep, voffB); PG8_STAGE(PG8_SA(1, 0), a3, voffA);
            PG8_WAIT_V(8); PG8_WAIT_L(0); PG8_BAR; PG8_MMA(1, 0, At, B0); PG8_MMA(1, 1, At, B1); PG8_BAR; PG8_SCHED;
            } else {
            PG8_LDB(B0, 0, 0); PG8_SCHED; PG8_LDA(At, 0, 0); PG8_STAGE(PG8_SA(1, 1), a1 + hstep, voffA);
            PG8_WAIT_L(8); PG8_BAR; PG8_WAIT_L(0); PG8_MMA(0, 0, At, B0); PG8_BAR; PG8_SCHED;
            PG8_LDB(B1, 0, 1); PG8_STAGE(PG8_SB(0, 0), b2, voffB);
            PG8_BAR; PG8_WAIT_L(0); PG8_MMA(0, 1, At, B1); PG8_BAR;
            PG8_LDA(At, 0, 1); PG8_STAGE(PG8_SA(0, 0), a2, voffA);
            PG8_BAR; PG8_WAIT_L(0); PG8_MMA(1, 0, At, B0); PG8_BAR; PG8_SCHED;
            PG8_STAGE(PG8_SB(0, 1), b2 + hstep, voffB);
            PG8_WAIT_V(6); PG8_BAR; PG8_MMA(1, 1, At, B1); PG8_BAR;
            PG8_LDB(B0, 1, 0); PG8_SCHED; PG8_LDA(At, 1, 0); PG8_STAGE(PG8_SA(0, 1), a2 + hstep, voffA);
            PG8_WAIT_L(8); PG8_BAR; PG8_WAIT_L(0); PG8_MMA(0, 0, At, B0); PG8_BAR; PG8_SCHED;
            PG8_LDB(B1, 1, 1); PG8_STAGE(PG8_SB(1, 0), b3, voffB);
            PG8_BAR; PG8_WAIT_L(0); PG8_MMA(0, 1, At, B1); PG8_BAR;
            PG8_LDA(At, 1, 1); PG8_STAGE(PG8_SA(1, 0), a3, voffA);
            PG8_BAR; PG8_WAIT_L(0); PG8_MMA(1, 0, At, B0); PG8_BAR; PG8_SCHED;
            PG8_STAGE(PG8_SB(1, 1), b3 + hstep, voffB);
            PG8_WAIT_V(6); PG8_BAR; PG8_MMA(1, 1, At, B1); PG8_BAR;
            }
        }
        if constexpr (ALIGN_EPI) { if (wr == 0) PG8_BAR; }
        if constexpr (!Epi::AFTER_DRAIN) { E(acc, cur, wr, wc, fr, fq); S.done(cur); }
        if (!has_next) break;
#pragma unroll
        for (int a = 0; a < 2; ++a)
#pragma unroll
            for (int b = 0; b < 2; ++b)
#pragma unroll
                for (int m = 0; m < 4; ++m)
#pragma unroll
                    for (int n = 0; n < 2; ++n) acc[a][b][m][n] = (f32x4){0.f, 0.f, 0.f, 0.f};
        cur = nxt; cA = nA; cB = nB; ++ui;
        if constexpr (ALIGN_EPI) { if (wr == 1) PG8_BAR; }
    }
    PG8_WAIT_V(0);
    if constexpr (!ALIGN_EPI) { if (wr == 0) PG8_BAR; }
    PG8_BAR;
    if constexpr (Epi::AFTER_DRAIN) { E.fused(acc, cur, wr, wc, fr, fq, lds, wid, lane); S.done(cur); }
#undef PG8_SA
#undef PG8_SB
#undef PG8_STAGE
#undef PG8_LDA
#undef PG8_LDB
#undef PG8_MMA
#undef PG8_WAIT_V
#undef PG8_WAIT_L
#undef PG8_BAR
#undef PG8_SCHED
}
}

template <class E, bool NSW = false> struct Pg8Epi { static constexpr bool PERM = !NSW, AFTER_DRAIN = false, NSWAP = NSW; E e;
    __device__ __forceinline__ void operator()(f32x4 (&acc)[2][2][4][2], const pg8::Unit& u, int, int, int, int) const { e(acc, u.pm, u.pn); } };
template <class Epi, bool NSW = false>
__device__ __forceinline__ void gemm_run2(LAS uchar* lds, const bf16_t* A, const bf16_t* Bt, int nM, int nN, int K, const Epi& E) {
    pg8::Gemm g{A, Bt, nM * 256, nN * 256, K}; pg8::StaticOrder S; S.init(nM * 256, nN * 256, ogdim(), obid());
    Pg8Epi<Epi, NSW> PE{E};
    pg8::gemm_phase<Pg8Epi<Epi, NSW>, pg8::StaticOrder, true, true>(lds, g, S, PE);
}
#define EPI_LOOP _Pragma("unroll") for (int ai = 0; ai < 2; ++ai) _Pragma("unroll") for (int m = 0; m < 4; ++m) _Pragma("unroll") for (int bj = 0; bj < 2; ++bj) _Pragma("unroll") for (int n = 0; n < 2; ++n)
#define EPI_FENCE do { if (bj == 1 && n == 1) asm volatile("" ::: "memory"); } while (0)

#define EPI2_LOOP _Pragma("unroll") for (int ai = 0; ai < 2; ++ai) _Pragma("unroll") for (int m = 0; m < 4; ++m) _Pragma("unroll") for (int bj = 0; bj < 2; ++bj)
#define EPI2_FENCE do { if (bj == 1) asm volatile("" ::: "memory"); } while (0)
__device__ __forceinline__ u32x4 pk8(f32x4 a, f32x4 b) { u32x4 w; w.x = pk2(a[0], a[1]); w.y = pk2(a[2], a[3]); w.z = pk2(b[0], b[1]); w.w = pk2(b[2], b[3]); return w; }
__device__ __forceinline__ u32x4 pkh8(f32x4 a, f32x4 b) { u32x4 w; w.x = pkh2(a[0], a[1]); w.y = pkh2(a[2], a[3]); w.z = pkh2(b[0], b[1]); w.w = pkh2(b[2], b[3]); return w; }
__device__ __forceinline__ f32x4 silu4(f32x4 v) { f32x4 s; s[0] = siluf(v[0]); s[1] = siluf(v[1]); s[2] = siluf(v[2]); s[3] = siluf(v[3]); return s; }
__device__ __forceinline__ f32x4 sigm4(f32x4 v) { f32x4 s; s[0] = sigm(v[0]); s[1] = sigm(v[1]); s[2] = sigm(v[2]); s[3] = sigm(v[3]); return s; }
__device__ __forceinline__ void unh8(u32x4 w, f32x4& a, f32x4& b) { a[0] = h2f(w.x & 0xffff); a[1] = h2f(w.x >> 16); a[2] = h2f(w.y & 0xffff); a[3] = h2f(w.y >> 16); b[0] = h2f(w.z & 0xffff); b[1] = h2f(w.z >> 16); b[2] = h2f(w.w & 0xffff); b[3] = h2f(w.w >> 16); }
__device__ __forceinline__ void unb8(u32x4 w, f32x4& a, f32x4& b) { a[0] = bf2f(w.x & 0xffff); a[1] = bf2f(w.x >> 16); a[2] = bf2f(w.y & 0xffff); a[3] = bf2f(w.y >> 16); b[0] = bf2f(w.z & 0xffff); b[1] = bf2f(w.z >> 16); b[2] = bf2f(w.w & 0xffff); b[3] = bf2f(w.w >> 16); }

struct EpiGU { bf16_t* hid;
    __device__ __forceinline__ void operator()(f32x4 (&acc)[2][2][4][2], int pm, int pn) const { COORDS
#pragma unroll
        for (int ai = 0; ai < 2; ++ai)
#pragma unroll
            for (int m = 0; m < 4; ++m) { const int r = pm * 256 + ai * 128 + wr * 64 + m * 16 + fr, cc = pn * 128 + wc * 32 + fq * 8;
                *(u32x4*)(hid + (size_t)r * FF + cc) = pk8(silu4(acc[ai][0][m][0]) * acc[ai][1][m][0], silu4(acc[ai][0][m][1]) * acc[ai][1][m][1]); } } };

struct EpiRes { float* h; const float* ada; float coef; const float* stats; const float* g; const float* bta; const float* hsrc;
    __device__ __forceinline__ void operator()(f32x4 (&acc)[2][2][4][2], int pm, int pn) const { COORDS
        const float* ap = ada + (size_t)(pm >> 5) * 9216;
        EPI2_LOOP { const int r = pm * 256 + ai * 128 + wr * 64 + m * 16 + fr, c = pn * 256 + bj * 128 + wc * 32 + fq * 8;
            const float mu = stats[2 * r], rs = stats[2 * r + 1]; float* hp = h + (size_t)r * DM + c; const float* sp = hsrc + (size_t)r * DM + c;
#pragma unroll
            for (int n = 0; n < 2; ++n) { const f32x4 gv = *(const f32x4*)(ap + c + 4 * n), gg = *(const f32x4*)(g + c + 4 * n), bb = *(const f32x4*)(bta + c + 4 * n), zv = *(const f32x4*)(sp + 4 * n);
                f32x4 z;
#pragma unroll
                for (int j = 0; j < 4; ++j) { const float hv = (zv[j] - mu) * rs * gg[j] + bb[j]; z[j] = DN_ALPHA * hv + coef * (1.f + gv[j]) * acc[ai][bj][m][n][j]; }
                *(f32x4*)(hp + 4 * n) = z; }
            EPI2_FENCE; } } };

struct EpiWin1 { bf16_t *hq, *hv, *sg, *cq, *ckv; unsigned short* zf; float* krraw;
    __device__ __forceinline__ void operator()(f32x4 (&acc)[2][2][4][2], int pm, int pn) const { COORDS
        const int kind = pn >> 2;
        EPI2_LOOP { const int r = pm * 256 + ai * 128 + wr * 64 + m * 16 + fr, c = pn * 256 + bj * 128 + wc * 32 + fq * 8; const f32x4 v0 = acc[ai][bj][m][0], v1 = acc[ai][bj][m][1];
            if (kind == 0) *(u32x4*)(hq + (size_t)r * DM + c) = pk8(silu4(v0), silu4(v1));
            else if (kind == 1) *(u32x4*)(zf + (size_t)r * DM + (c - 1024)) = pkh8(v0, v1);
            else if (kind == 2) *(u32x4*)(hv + (size_t)r * DM + (c - 2048)) = pk8(v0, v1);
            else if (kind == 3) *(u32x4*)(sg + (size_t)r * DM + (c - 3072)) = pk8(silu4(v0), silu4(v1));
            else { const int gc = c - 4096;
                if (gc < 384) *(u32x4*)(cq + (size_t)r * 384 + gc) = pk8(v0, v1);
                else if (gc < 640) *(u32x4*)(ckv + (size_t)r * 256 + (gc - 384)) = pk8(v0, v1);
                else if (gc < 704) { *(f32x4*)(krraw + (size_t)r * 64 + (gc - 640)) = v0; *(f32x4*)(krraw + (size_t)r * 64 + (gc - 640) + 4) = v1; } } } } };

struct EpiQ { bf16_t *qn, *qr; const float *rsq, *cosT, *sinT;
    __device__ __forceinline__ void operator()(f32x4 (&acc)[2][2][4][2], int pm, int pn) const { COORDS
#pragma unroll
        for (int ai = 0; ai < 2; ++ai)
#pragma unroll
            for (int m = 0; m < 4; ++m) { const int r = pm * 256 + ai * 128 + wr * 64 + m * 16 + fr; const float rs = rsq[r] * QSCALE;
                if (pn < 4) {
#pragma unroll
                    for (int bj = 0; bj < 2; ++bj) { const int c = pn * 256 + bj * 128 + wc * 32 + fq * 8; *(u32x4*)(qn + (size_t)r * DM + c) = pk8(acc[ai][bj][m][0] * rs, acc[ai][bj][m][1] * rs); }
                } else { const int cl = wc * 32 + fq * 8, hh = (pn - 4) * 4 + (cl >> 5), i = cl & 31;
                    f32x4 o1[2], o2[2];
#pragma unroll
                    for (int n = 0; n < 2; ++n) { const f32x4 x1 = acc[ai][0][m][n] * rs, x2 = acc[ai][1][m][n] * rs; const f32x4 cs = *(const f32x4*)(cosT + (size_t)r * 32 + i + 4 * n), sn = *(const f32x4*)(sinT + (size_t)r * 32 + i + 4 * n);
                        o1[n] = x1 * cs - x2 * sn; o2[n] = x1 * sn + x2 * cs; }
                    *(u32x4*)(qr + (size_t)r * 512 + hh * 64 + i) = pk8(o1[0], o1[1]); *(u32x4*)(qr + (size_t)r * 512 + hh * 64 + 32 + i) = pk8(o2[0], o2[1]);
                }
                asm volatile("" ::: "memory"); } } };

struct EpiKn { bf16_t* kn; const float* rskv;
    __device__ __forceinline__ void operator()(f32x4 (&acc)[2][2][4][2], int pm, int pn) const { COORDS
        EPI2_LOOP { const int r = pm * 256 + ai * 128 + wr * 64 + m * 16 + fr, c = pn * 256 + bj * 128 + wc * 32 + fq * 8; const float rs = rskv[r];
            *(u32x4*)(kn + (size_t)r * DM + c) = pk8(acc[ai][bj][m][0] * rs, acc[ai][bj][m][1] * rs); EPI2_FENCE; } } };

struct EpiV { bf16_t* vt; const float* rskv;
    __device__ __forceinline__ void operator()(f32x4 (&acc)[2][2][4][2], int pm, int pn) const { COORDS
        typedef unsigned u2_t __attribute__((ext_vector_type(2)));
        const int odd = fq & 1;
        EPI2_LOOP { const int r0 = pm * 256 + ai * 128 + wr * 64 + m * 16 + fq * 4;
            const f32x4 rs = *(const f32x4*)(rskv + r0);
            const u32x2 x = pk4(acc[ai][bj][m][0] * rs), y = pk4(acc[ai][bj][m][1] * rs);
            const u2_t sa = __builtin_amdgcn_permlane16_swap(x.x, y.x, false, false);
            const u2_t sb = __builtin_amdgcn_permlane16_swap(x.y, y.y, false, false);
            u32x4 w; if (odd) { w.x = sa[0]; w.y = sb[0]; w.z = sa[1]; w.w = sb[1]; } else { w.x = sa[0]; w.y = sb[0]; w.z = sa[1]; w.w = sb[1]; }
            const int cv = pn * 256 + bj * 128 + wc * 32 + odd * 16 + fr, rr = r0 - odd * 4;
            const int b = rr >> 13, sx = rr & 8191, hh = cv >> 7, e = cv & 127;
            *(u32x4*)(vt + (((size_t)((b * 8 + hh) * 128 + e)) << 13) + sx) = w; EPI2_FENCE; } } };

struct EpiGate { unsigned short *sga, *sgb;
    __device__ __forceinline__ void operator()(f32x4 (&acc)[2][2][4][2], int pm, int pn) const { COORDS
        unsigned short* dst = pn < 4 ? sga : sgb;
        EPI2_LOOP { const int r = pm * 256 + ai * 128 + wr * 64 + m * 16 + fr, c = (pn & 3) * 256 + bj * 128 + wc * 32 + fq * 8;
            *(u32x4*)(dst + (size_t)r * DM + c) = pkh8(sigm4(acc[ai][bj][m][0]), sigm4(acc[ai][bj][m][1])); } } };

struct EpiM1 { bf16_t* m1; const unsigned short* sga;
    __device__ __forceinline__ void operator()(f32x4 (&acc)[2][2][4][2], int pm, int pn) const { COORDS
        EPI2_LOOP { const int r = pm * 256 + ai * 128 + wr * 64 + m * 16 + fr, c = pn * 256 + bj * 128 + wc * 32 + fq * 8;
            f32x4 s0, s1; unh8(*(const u32x4*)(sga + (size_t)r * DM + c), s0, s1);
            *(u32x4*)(m1 + (size_t)r * DM + c) = pk8(acc[ai][bj][m][0] * s0, acc[ai][bj][m][1] * s1); EPI2_FENCE; } } };
struct EpiM2 { const bf16_t* m1; const unsigned short* sgb; bf16_t* merged;
    __device__ __forceinline__ void operator()(f32x4 (&acc)[2][2][4][2], int pm, int pn) const { COORDS
        EPI2_LOOP { const int r = pm * 256 + ai * 128 + wr * 64 + m * 16 + fr, c = pn * 256 + bj * 128 + wc * 32 + fq * 8;
            f32x4 s0, s1, m0, m1v; unh8(*(const u32x4*)(sgb + (size_t)r * DM + c), s0, s1); unb8(*(const u32x4*)(m1 + (size_t)r * DM + c), m0, m1v);
            *(u32x4*)(merged + (size_t)r * DM + c) = pk8(m0 + acc[ai][bj][m][0] * s0, m1v + acc[ai][bj][m][1] * s1); EPI2_FENCE; } } };

struct ConvDesc { const float* src0; const float* src1; const float* kscale; int K, Ns; bf16_t* dst; int kind, item; };
__device__ __forceinline__ void conv_load(const ConvDesc& d, int tid, float (&v)[8]) {
    const int nkt = d.K / 64; const int kt = d.item % nkt, ntile = d.item / nkt; const int k0 = kt * 64, n0 = ntile * 64;
    const int tn = tid & 63, np = n0 + tn; const float* s = d.src0; int col = np;
    if (d.kind == 1) { const int tile = np >> 8, bj = (np >> 7) & 1, cc = np & 127; s = bj ? d.src1 : d.src0; col = tile * 128 + cc; }
    else if (d.kind == 2) { if (np < 1024) col = (np >> 7) * 192 + (np & 127); else { const int r = np - 1024, t2 = r >> 8, bj = (r >> 7) & 1, cc = r & 127, hh = t2 * 4 + (cc >> 5), i = cc & 31; col = hh * 192 + 128 + bj * 32 + i; } }
    else if (d.kind == 3) { if (np < 1024) col = (np >> 7) * 256 + (np & 127); else { const int r = np - 1024; col = (r >> 7) * 256 + 128 + (r & 127); } }
#pragma unroll
    for (int i = 0; i < 8; ++i) { const int kk = (tid >> 6) + 8 * i; float x = s[(size_t)(k0 + kk) * d.Ns + col]; if (d.kscale) x *= d.kscale[k0 + kk]; v[i] = x; }
}
__device__ __forceinline__ void conv_store(LAS uchar* lds, const ConvDesc& d, int tid, const float (&v)[8]) {
    LAS float* tl = (LAS float*)lds;
    const int nkt = d.K / 64; const int kt = d.item % nkt, ntile = d.item / nkt; const int k0 = kt * 64, n0 = ntile * 64;
    { const int tn = tid & 63;
#pragma unroll
      for (int i = 0; i < 8; ++i) tl[tn * 65 + (tid >> 6) + 8 * i] = v[i]; }
    __syncthreads();
    { const int n = tid >> 3, kc = tid & 7; const LAS float* rp = tl + n * 65 + kc * 8; u32x4 w; w.x = pk2(rp[0], rp[1]); w.y = pk2(rp[2], rp[3]); w.z = pk2(rp[4], rp[5]); w.w = pk2(rp[6], rp[7]);
      *(u32x4*)(d.dst + (size_t)(n0 + n) * d.K + k0 + kc * 8) = w; }
    __syncthreads();
}
__device__ __forceinline__ ConvDesc conv_desc(const Params& p, int l, int it) {
    bf16_t* W = (bf16_t*)(p.ws + OFF_W + (size_t)(l & 1) * WSZ);
    constexpr int I_GU = 16 * 88, I_D = 44 * 16, I_IN = 16 * 107, I_UQ = 6 * 24, I_UKV = 4 * 32, I_SQ = 256;
    const size_t o_ff = (size_t)l * DM * FF; int r = it;
    if (r < I_GU) return ConvDesc{p.f1g + o_ff, p.f1u + o_ff, nullptr, DM, FF, W + W_GU1, 1, r}; r -= I_GU;
    if (r < I_D) return ConvDesc{p.f1d + o_ff, nullptr, nullptr, FF, DM, W + W_D1, 0, r}; r -= I_D;
    if (r < I_IN) return ConvDesc{p.w_in + (size_t)l * DM * 6848, nullptr, nullptr, DM, 6848, W + W_IN, 0, r}; r -= I_IN;
    if (r < I_UQ) return ConvDesc{p.w_uq + (size_t)l * 384 * 1536, nullptr, p.qng + l * 384, 384, 1536, W + W_UQ, 2, r}; r -= I_UQ;
    if (r < I_UKV) return ConvDesc{p.w_ukv + (size_t)l * 256 * 2048, nullptr, p.kvng + l * 256, 256, 2048, W + W_UKV, 3, r}; r -= I_UKV;
    if (r < I_SQ) return ConvDesc{p.w_bh + (size_t)l * DM * DM, nullptr, nullptr, DM, DM, W + W_BH, 0, r}; r -= I_SQ;
    if (r < I_SQ) return ConvDesc{p.w_bm + (size_t)l * DM * DM, nullptr, nullptr, DM, DM, W + W_BM, 0, r}; r -= I_SQ;
    if (r < I_SQ) return ConvDesc{p.w_out + (size_t)l * DM * DM, nullptr, nullptr, DM, DM, W + W_OUT, 0, r}; r -= I_SQ;
    if (r < I_GU) return ConvDesc{p.f2g + o_ff, p.f2u + o_ff, nullptr, DM, FF, W + W_GU2, 1, r}; r -= I_GU;
    return ConvDesc{p.f2d + o_ff, nullptr, nullptr, FF, DM, W + W_D2, 0, r};
}
__device__ void conv_layer(LAS uchar* lds, const Params& p, int l, int start, int stride) {
    constexpr int TOT = 2 * 16 * 88 + 2 * 44 * 16 + 16 * 107 + 6 * 24 + 4 * 32 + 3 * 256;
    const int tid = otid();
    float v[8], vn[8];
    if (start < TOT) { const ConvDesc d = conv_desc(p, l, start); conv_load(d, tid, v); }
    for (int it = start; it < TOT; it += stride) {
        const ConvDesc d = conv_desc(p, l, it);
        if (it + stride < TOT) { const ConvDesc dn = conv_desc(p, l, it + stride); conv_load(dn, tid, vn); }
        conv_store(lds, d, tid, v);
#pragma unroll
        for (int i = 0; i < 8; ++i) v[i] = vn[i];
    }
}

__device__ void p0a(LAS uchar* lds, const Params& p) {
    const int tid = otid(), G = ogdim();
    float* ADA = (float*)(p.ws + OFF_ADA);
    LAS float* red = (LAS float*)lds;
    LAS float* cond = red + 2048;
    for (int i = tid; i < 4096; i += NTHR) cond[i] = siluf(p.c[i]);
    __syncthreads();
    for (int it = obid(); it < NL * 144; it += G) {
        const int l = it / 144, cg0 = (it % 144) * 64, cn = tid & 63, kp = tid >> 6;
        const float* w = p.ada_w + (size_t)l * DM * 9216 + cg0 + cn;
        float a0 = 0.f, a1 = 0.f, a2 = 0.f, a3 = 0.f;
        for (int k = kp * 128; k < kp * 128 + 128; ++k) { const float wv = w[(size_t)k * 9216];
            a0 += cond[k] * wv; a1 += cond[1024 + k] * wv; a2 += cond[2048 + k] * wv; a3 += cond[3072 + k] * wv; }
        red[(kp * 4 + 0) * 64 + cn] = a0; red[(kp * 4 + 1) * 64 + cn] = a1; red[(kp * 4 + 2) * 64 + cn] = a2; red[(kp * 4 + 3) * 64 + cn] = a3;
        __syncthreads();
        if (tid < 256) { const int b = tid >> 6; float s = 0.f;
#pragma unroll
            for (int q = 0; q < 8; ++q) s += red[(q * 4 + b) * 64 + cn];
            ADA[(size_t)(l * 4 + b) * 9216 + cg0 + cn] = s + p.ada_b[(size_t)l * 9216 + cg0 + cn]; }
        __syncthreads();
    }
    float* COS = (float*)(p.ws + OFF_COS); float* SIN = (float*)(p.ws + OFF_SIN);
    for (int e = obid() * NTHR + tid; e < T * 32; e += G * NTHR) {
        const int tok = e >> 5, i = e & 31; double inv = 1.0, rr = 0.7498942093324558; int n = i;
        while (n) { if (n & 1) inv *= rr; rr *= rr; n >>= 1; }
        const double ang = (double)p.pos[tok] * inv; const double kq = __builtin_rint(ang * 0.15915494309189535);
        double r = ang - kq * 6.283185307179586 - kq * 2.4492935982947064e-16; const double r2 = r * r;
        double sn, cs;
        { double t = 1.0;
#pragma unroll
          for (int q = 27; q >= 3; q -= 2) t = 1.0 - t * r2 * (1.0 / (double)(q * (q - 1))); sn = t * r; }
        { double t = 1.0;
#pragma unroll
          for (int q = 26; q >= 2; q -= 2) t = 1.0 - t * r2 * (1.0 / (double)(q * (q - 1))); cs = t; }
        COS[e] = (float)cs; SIN[e] = (float)sn;
    }
    { float* onz = (float*)(p.ws + OFF_ONES); for (int ch = obid() * NTHR + tid; ch < 2048; ch += G * NTHR) onz[ch] = ch < 1024 ? 1.f : 0.f; }
    float* LBT = (float*)(p.ws + OFF_LBT);
    for (int ch = obid() * NTHR + tid; ch < 1024; ch += G * NTHR) {
        const float v0 = p.hg_lb[ch], v1 = p.hg_lb[1024 + ch], v2 = p.hg_lb[2048 + ch], v3 = p.hg_lb[3072 + ch];
        const float mx = fmaxf(fmaxf(v0, v1), fmaxf(v2, v3)); const float e0 = expf(v0 - mx), e1 = expf(v1 - mx), e2 = expf(v2 - mx), e3 = expf(v3 - mx); const float inv = 1.f / (e0 + e1 + e2 + e3);
        float lw[4]; lw[0] = 0.f; lw[1] = e1 * inv; lw[2] = (e1 + e2) * inv; lw[3] = (e1 + e2 + e3) * inv;
#pragma unroll
        for (int l = 0; l < 4; ++l) { const float lb = lw[l]; LBT[(l * 3 + 0) * 1024 + ch] = fmaxf(lb, 1e-30f); LBT[(l * 3 + 1) * 1024 + ch] = log1pf(-lb); LBT[(l * 3 + 2) * 1024 + ch] = 1.f - lb; }
    }
}

__device__ void ln_pass(const Params& p, const float* src, float* hdst, bf16_t* U, const float* g, const float* bta, const float* ada_l, int sc_idx, int sh_idx, bool donorm, bool writeU, bool writeH) {
    float* stats = (float*)(p.ws + OFF_STATS);
    const int tid = otid(), wid = tid >> 6, lane = tid & 63;
    for (int row = obid() * 8 + wid; row < T; row += ogdim() * 8) {
        const f32x4* xr = (const f32x4*)(src + (size_t)row * DM) + lane; f32x4 v[4]; float s = 0.f;
#pragma unroll
        for (int j = 0; j < 4; ++j) { v[j] = xr[64 * j]; s += (v[j][0] + v[j][1]) + (v[j][2] + v[j][3]); }
        if (donorm) {
#pragma unroll
            for (int o = 32; o > 0; o >>= 1) s += __shfl_xor(s, o);
            const float mean = s * (1.f / DM); float s2 = 0.f;
#pragma unroll
            for (int j = 0; j < 4; ++j) { v[j] = v[j] - mean; s2 += (v[j][0] * v[j][0] + v[j][1] * v[j][1]) + (v[j][2] * v[j][2] + v[j][3] * v[j][3]); }
#pragma unroll
            for (int o = 32; o > 0; o >>= 1) s2 += __shfl_xor(s2, o);
            const float rstd = 1.f / sqrtf(s2 * (1.f / DM) + 1e-5f);
            if (lane == 0) *(f32x2v*)(stats + 2 * row) = (f32x2v){mean, rstd};
#pragma unroll
            for (int j = 0; j < 4; ++j) { const f32x4 gg = *((const f32x4*)g + lane + 64 * j), bb = *((const f32x4*)bta + lane + 64 * j); v[j] = v[j] * rstd * gg + bb; }
        }
        else if (lane == 0) { const float zz = v[0][0] * 0.f; *(f32x2v*)(stats + 2 * row) = (f32x2v){zz, 1.f + zz}; }
        if (writeH) { f32x4* hr = (f32x4*)(hdst + (size_t)row * DM) + lane;
#pragma unroll
            for (int j = 0; j < 4; ++j) hr[64 * j] = v[j]; }
        if (writeU) { const float* ab = ada_l + (size_t)(row >> 13) * 9216; u32x2* ur = (u32x2*)(U + (size_t)row * DM) + lane;
#pragma unroll
            for (int j = 0; j < 4; ++j) { const f32x4 sc = *((const f32x4*)(ab + sc_idx * 1024) + lane + 64 * j), sh = *((const f32x4*)(ab + sh_idx * 1024) + lane + 64 * j); ur[64 * j] = pk4(v[j] * (1.f + sc) + sh); } }
    }
}

__device__ void ln_pass2(const Params& p, const float* src, float* outH, bf16_t* U, const float* g, const float* bta, const float* ada_l, int sc_idx, int sh_idx) {
    float* stats = (float*)(p.ws + OFF_STATS);
    const int tid = otid(), wid = tid >> 6, lane = tid & 63; const int rstep = ogdim() * 8, r0 = obid() * 8 + wid;
    for (int b = 0; b < 4; ++b) {
        f32x4 A[4], B[4];
#pragma unroll
        for (int j = 0; j < 4; ++j) { const f32x4 gg = *((const f32x4*)g + lane + 64 * j), bb = *((const f32x4*)bta + lane + 64 * j);
            if (outH) { A[j] = gg; B[j] = bb; }
            else { const float* ab = ada_l + (size_t)b * 9216; const f32x4 sc = *((const f32x4*)(ab + sc_idx * 1024) + lane + 64 * j), sh = *((const f32x4*)(ab + sh_idx * 1024) + lane + 64 * j); A[j] = gg * (1.f + sc); B[j] = bb * (1.f + sc) + sh; } }
        f32x4 v[4], vn[4];
        if (r0 < SEQ) {
#pragma unroll
            for (int j = 0; j < 4; ++j) v[j] = *((const f32x4*)(src + (size_t)(b * SEQ + r0) * DM) + lane + 64 * j); }
        for (int rr = r0; rr < SEQ; rr += rstep) {
            const int row = b * SEQ + rr;
            if (rr + rstep < SEQ) {
#pragma unroll
                for (int j = 0; j < 4; ++j) vn[j] = *((const f32x4*)(src + (size_t)(row + rstep) * DM) + lane + 64 * j); }
            float s = 0.f;
#pragma unroll
            for (int j = 0; j < 4; ++j) s += (v[j][0] + v[j][1]) + (v[j][2] + v[j][3]);
#pragma unroll
            for (int o = 32; o > 0; o >>= 1) s += __shfl_xor(s, o);
            const float mean = s * (1.f / DM); float s2 = 0.f;
#pragma unroll
            for (int j = 0; j < 4; ++j) { v[j] = v[j] - mean; s2 += (v[j][0] * v[j][0] + v[j][1] * v[j][1]) + (v[j][2] * v[j][2] + v[j][3] * v[j][3]); }
#pragma unroll
            for (int o = 32; o > 0; o >>= 1) s2 += __shfl_xor(s2, o);
            const float rstd = 1.f / sqrtf(s2 * (1.f / DM) + 1e-5f);
            if (lane == 0) *(f32x2v*)(stats + 2 * row) = (f32x2v){mean, rstd};
            if (outH) { f32x4* hr = (f32x4*)(outH + (size_t)row * DM) + lane;
#pragma unroll
                for (int j = 0; j < 4; ++j) hr[64 * j] = v[j] * rstd * A[j] + B[j]; }
            else { u32x2* ur = (u32x2*)(U + (size_t)row * DM) + lane;
#pragma unroll
                for (int j = 0; j < 4; ++j) ur[64 * j] = pk4(v[j] * rstd * A[j] + B[j]); }
#pragma unroll
            for (int j = 0; j < 4; ++j) v[j] = vn[j];
        }
    }
}

__device__ void tok_pass(const Params& p) {
    const int tid = otid(), wid = tid >> 6, lane = tid & 63;
    const bf16_t* CQ = (const bf16_t*)(p.ws + OFF_CQ); const bf16_t* CKV = (const bf16_t*)(p.ws + OFF_CKV);
    const float* KRRAW = (const float*)(p.ws + OFF_KRRAW); bf16_t* KR = (bf16_t*)(p.ws + OFF_KR);
    const float* COS = (const float*)(p.ws + OFF_COS); const float* SIN = (const float*)(p.ws + OFF_SIN);
    float* RSQ = (float*)(p.ws + OFF_RSQ); float* RSKV = (float*)(p.ws + OFF_RSKV);
    const int step = ogdim() * 8, t0 = obid() * 8 + wid; const int l31 = lane & 31;
    unsigned qw[3], qn[3]; u32x2 kw, kn2; float x1, x2, cs, sn, x1n, x2n, csn, snn;
#define TOK_LOAD(tok_, Q_, K_, X1_, X2_, C_, S_) do { const unsigned* q_ = (const unsigned*)(CQ + (size_t)(tok_) * 384) + lane * 3; Q_[0] = q_[0]; Q_[1] = q_[1]; Q_[2] = q_[2]; K_ = *((const u32x2*)(CKV + (size_t)(tok_) * 256) + lane); \
        X1_ = KRRAW[(size_t)(tok_) * 64 + l31]; X2_ = KRRAW[(size_t)(tok_) * 64 + 32 + l31]; C_ = COS[(size_t)(tok_) * 32 + l31]; S_ = SIN[(size_t)(tok_) * 32 + l31]; } while (0)
    if (t0 < T) TOK_LOAD(t0, qw, kw, x1, x2, cs, sn);
    for (int tok = t0; tok < T; tok += step) {
        if (tok + step < T) TOK_LOAD(tok + step, qn, kn2, x1n, x2n, csn, snn);
        float s = 0.f;
#pragma unroll
        for (int j = 0; j < 3; ++j) { const float a = bf2f(qw[j] & 0xffff), b = bf2f(qw[j] >> 16); s += a * a + b * b; }
        float s2; { const float a = bf2f(kw.x & 0xffff), b = bf2f(kw.x >> 16), c = bf2f(kw.y & 0xffff), d = bf2f(kw.y >> 16); s2 = a * a + b * b + c * c + d * d; }
#pragma unroll
        for (int o = 32; o > 0; o >>= 1) { s += __shfl_xor(s, o); s2 += __shfl_xor(s2, o); }
        if (lane == 0) { RSQ[tok] = 1.f / sqrtf(s * (1.f / 384.f) + 1e-6f); RSKV[tok] = 1.f / sqrtf(s2 * (1.f / 256.f) + 1e-6f); }
        if (lane < 32) { KR[(size_t)tok * 64 + lane] = f2bf(x1 * cs - x2 * sn); KR[(size_t)tok * 64 + 32 + lane] = f2bf(x1 * sn + x2 * cs); }
        qw[0] = qn[0]; qw[1] = qn[1]; qw[2] = qn[2]; kw = kn2; x1 = x1n; x2 = x2n; cs = csn; sn = snn;
    }
#undef TOK_LOAD
}

__device__ __forceinline__ void gate2(float z, float lbp, float oml, float& lf2, float& hk) {
    const float t = __builtin_amdgcn_exp2f(-fabsf(z) * 1.44269504f), r = __builtin_amdgcn_rcpf(1.f + t), sm = t * r;
    const float sz = z >= 0.f ? r : sm, snz = z >= 0.f ? sm : r;
    lf2 = __builtin_amdgcn_logf(lbp + oml * sz); hk = oml * snz;
}
constexpr int KT_STR = 72;
constexpr int TD_STR = 136;

__device__ void hg1_phase(LAS uchar* lds, const Params& p, int l) {
    COORDS
    const unsigned* ZF32 = (const unsigned*)(p.ws + OFF_R1); const unsigned* HV32 = (const unsigned*)(p.ws + OFF_R2);
    bf16_t* LS = (bf16_t*)(p.ws + OFF_R4); float* DEC = (float*)(p.ws + OFF_DEC); const float* LBT = (const float*)(p.ws + OFF_LBT) + (size_t)l * 3 * 1024;
    LAS bf16_t* Kt = (LAS bf16_t*)lds;
    LAS bf16_t* Vt = (LAS bf16_t*)(lds + 128 * KT_STR * 2);
    LAS float* tot = (LAS float*)(lds + 2 * 128 * KT_STR * 2);
    const int d2 = lane, part = wid;
    unsigned zr[8], vr[8];
    { const int unit = obid(); if (unit < 32 * 128) { const int chunk = unit & 127, bh = unit >> 7, b = bh >> 3, hh = bh & 7; const size_t t0 = (size_t)b * SEQ + chunk * 64 + part * 8;
#pragma unroll
        for (int i = 0; i < 8; ++i) { zr[i] = ZF32[(t0 + i) * 512 + hh * 64 + d2]; vr[i] = HV32[(t0 + i) * 512 + hh * 64 + d2]; } } }
    for (int unit = obid(); unit < 32 * 128; unit += ogdim()) {
        const int bh = unit >> 7, hh = bh & 7;
        const f32x2v lbp = *(const f32x2v*)(LBT + hh * 128 + 2 * d2), oml = *(const f32x2v*)(LBT + 2048 + hh * 128 + 2 * d2);
        unsigned zn[8], vn[8];
        { const int nu = unit + ogdim(); if (nu < 32 * 128) { const int chunk = nu & 127, bh2 = nu >> 7, b = bh2 >> 3, h2 = bh2 & 7; const size_t t0 = (size_t)b * SEQ + chunk * 64 + part * 8;
#pragma unroll
            for (int i = 0; i < 8; ++i) { zn[i] = ZF32[(t0 + i) * 512 + h2 * 64 + d2]; vn[i] = HV32[(t0 + i) * 512 + h2 * 64 + d2]; } } }
        float g0[8], g1[8], k0[8], k1[8]; float run0 = 0.f, run1 = 0.f;
#pragma unroll
        for (int i = 0; i < 8; ++i) { float lf; gate2(h2f(zr[i] & 0xffff), lbp[0], oml[0], lf, k0[i]); run0 += lf; g0[i] = run0; gate2(h2f(zr[i] >> 16), lbp[1], oml[1], lf, k1[i]); run1 += lf; g1[i] = run1; }
        *(LAS f32x2v*)(tot + part * 128 + 2 * d2) = (f32x2v){run0, run1};
        __syncthreads();
        float off0 = 0.f, off1 = 0.f, gc0 = 0.f, gc1 = 0.f;
#pragma unroll
        for (int q = 0; q < 8; ++q) { const f32x2v tq = *(const LAS f32x2v*)(tot + q * 128 + 2 * d2); gc0 += tq[0]; gc1 += tq[1]; if (q < part) { off0 += tq[0]; off1 += tq[1]; } }
        u32x4 kw0, kw1, vw0, vw1;
#pragma unroll
        for (int j = 0; j < 4; ++j) {
            kw0[j] = pk2(k0[2 * j] * __builtin_amdgcn_exp2f(gc0 - (off0 + g0[2 * j])), k0[2 * j + 1] * __builtin_amdgcn_exp2f(gc0 - (off0 + g0[2 * j + 1])));
            kw1[j] = pk2(k1[2 * j] * __builtin_amdgcn_exp2f(gc1 - (off1 + g1[2 * j])), k1[2 * j + 1] * __builtin_amdgcn_exp2f(gc1 - (off1 + g1[2 * j + 1])));
            vw0[j] = (vr[2 * j] & 0xffffu) | (vr[2 * j + 1] << 16); vw1[j] = (vr[2 * j] >> 16) | (vr[2 * j + 1] & 0xffff0000u); }
        *(LAS u32x4*)(Kt + (2 * d2) * KT_STR + part * 8) = kw0; *(LAS u32x4*)(Kt + (2 * d2 + 1) * KT_STR + part * 8) = kw1;
        *(LAS u32x4*)(Vt + (2 * d2) * KT_STR + part * 8) = vw0; *(LAS u32x4*)(Vt + (2 * d2 + 1) * KT_STR + part * 8) = vw1;
        if (part == 0) *(f32x2v*)(DEC + (size_t)unit * 128 + 2 * d2) = (f32x2v){__builtin_amdgcn_exp2f(gc0), __builtin_amdgcn_exp2f(gc1)};
        __syncthreads();
        bf16x8 vb[2];
#pragma unroll
        for (int ks = 0; ks < 2; ++ks) vb[ks] = *(const LAS bf16x8*)(Vt + (wid * 16 + fr) * KT_STR + ks * 32 + fq * 8);
        bf16_t* lsu = LS + (size_t)unit * 16384;
#pragma unroll
        for (int nb = 0; nb < 8; ++nb) { f32x4 a = {0.f, 0.f, 0.f, 0.f};
#pragma unroll
            for (int ks = 0; ks < 2; ++ks) { const bf16x8 ka = *(const LAS bf16x8*)(Kt + (nb * 16 + fr) * KT_STR + ks * 32 + fq * 8); a = __builtin_amdgcn_mfma_f32_16x16x32_bf16(ka, vb[ks], a, 0, 0, 0); }
            *(u32x2*)(lsu + (size_t)(wid * 16 + fr) * 128 + nb * 16 + fq * 4) = pk4(a); }
        __syncthreads();
#pragma unroll
        for (int i = 0; i < 8; ++i) { zr[i] = zn[i]; vr[i] = vn[i]; }
    }
}

__device__ void hg2_phase(const Params& p) {
    bf16_t* LS = (bf16_t*)(p.ws + OFF_R4); const float* DEC = (const float*)(p.ws + OFF_DEC);
    for (int gid = obid() * NTHR + otid(); gid < 32 * 4096; gid += ogdim() * NTHR) {
        const int bh = gid >> 12, e4 = (gid & 4095) * 4, dk = e4 & 127;
        f32x4 S = {0.f, 0.f, 0.f, 0.f};
        for (int c0 = 0; c0 < 128; c0 += 8) {
            u32x2 lw[8]; f32x4 dc[8];
#pragma unroll
            for (int q = 0; q < 8; ++q) { lw[q] = *(const u32x2*)(LS + ((size_t)(bh * 128 + c0 + q) << 14) + e4); dc[q] = *(const f32x4*)(DEC + (size_t)(bh * 128 + c0 + q) * 128 + dk); }
#pragma unroll
            for (int q = 0; q < 8; ++q) { *(u32x2*)(LS + ((size_t)(bh * 128 + c0 + q) << 14) + e4) = pk4(S);
                f32x4 L; L[0] = bf2f(lw[q].x & 0xffff); L[1] = bf2f(lw[q].x >> 16); L[2] = bf2f(lw[q].y & 0xffff); L[3] = bf2f(lw[q].y >> 16);
                S = dc[q] * S + L; }
        }
    }
}

__device__ void hg3_phase(LAS uchar* lds, const Params& p, int l) {
    COORDS
    bf16_t* HQ = (bf16_t*)(p.ws + OFF_R0); const unsigned* HQ32 = (const unsigned*)(p.ws + OFF_R0); const unsigned* ZF32 = (const unsigned*)(p.ws + OFF_R1); const unsigned* HV32 = (const unsigned*)(p.ws + OFF_R2);
    const bf16_t* SG = (const bf16_t*)(p.ws + OFF_R3); const bf16_t* LS = (const bf16_t*)(p.ws + OFF_R4); const float* LBT = (const float*)(p.ws + OFF_LBT) + (size_t)l * 3 * 1024;
    const float* ng = p.hg_ng + (size_t)l * 1024;
    LAS bf16_t* Qt = (LAS bf16_t*)lds;
    LAS bf16_t* Qh = Qt + 64 * TD_STR;
    LAS bf16_t* Kp = Qh + 64 * TD_STR;
    LAS bf16_t* Vt = Kp + 64 * TD_STR;
    LAS bf16_t* Sb = Vt + 128 * KT_STR;
    LAS float* tot = (LAS float*)(Sb + 128 * TD_STR);
    LAS float* ssq = tot + 1024;
    const int d2 = lane, part = wid;
    unsigned zr[8], vr[8], qr[8]; u32x4 sbr[4];
#define HG3_LOAD(U_, Z_, V_, Q_, S_) do { const int chunk_ = (U_) & 127, bh_ = (U_) >> 7, b_ = bh_ >> 3, h_ = bh_ & 7; const size_t t0_ = (size_t)b_ * SEQ + chunk_ * 64 + part * 8; \
        _Pragma("unroll") for (int i_ = 0; i_ < 8; ++i_) { Z_[i_] = ZF32[(t0_ + i_) * 512 + h_ * 64 + d2]; V_[i_] = HV32[(t0_ + i_) * 512 + h_ * 64 + d2]; Q_[i_] = HQ32[(t0_ + i_) * 512 + h_ * 64 + d2]; } \
        const bf16_t* lsu_ = LS + (size_t)(U_) * 16384; _Pragma("unroll") for (int i_ = 0; i_ < 4; ++i_) { const int cid_ = tid + i_ * NTHR; S_[i_] = *(const u32x4*)(lsu_ + (cid_ >> 4) * 128 + (cid_ & 15) * 8); } } while (0)
    if (obid() < 32 * 128) HG3_LOAD(obid(), zr, vr, qr, sbr);
    for (int unit = obid(); unit < 32 * 128; unit += ogdim()) {
        const int chunk = unit & 127, bh = unit >> 7, b = bh >> 3, hh = bh & 7;
        const f32x2v lbp = *(const f32x2v*)(LBT + hh * 128 + 2 * d2), oml = *(const f32x2v*)(LBT + 2048 + hh * 128 + 2 * d2);
        const size_t tokc = (size_t)b * SEQ + chunk * 64;
        { u32x4 vw0, vw1;
#pragma unroll
          for (int j = 0; j < 4; ++j) { vw0[j] = (vr[2 * j] & 0xffffu) | (vr[2 * j + 1] << 16); vw1[j] = (vr[2 * j] >> 16) | (vr[2 * j + 1] & 0xffff0000u); }
          *(LAS u32x4*)(Vt + (2 * d2) * KT_STR + part * 8) = vw0; *(LAS u32x4*)(Vt + (2 * d2 + 1) * KT_STR + part * 8) = vw1;
#pragma unroll
          for (int i = 0; i < 4; ++i) { const int cid = tid + i * NTHR; *(LAS u32x4*)(Sb + (cid >> 4) * TD_STR + (cid & 15) * 8) = sbr[i]; } }
        float g0[8], g1[8], k0[8], k1[8]; float run0 = 0.f, run1 = 0.f;
#pragma unroll
        for (int i = 0; i < 8; ++i) { float lf; gate2(h2f(zr[i] & 0xffff), lbp[0], oml[0], lf, k0[i]); run0 += lf; g0[i] = run0; gate2(h2f(zr[i] >> 16), lbp[1], oml[1], lf, k1[i]); run1 += lf; g1[i] = run1; }
        *(LAS f32x2v*)(tot + part * 128 + 2 * d2) = (f32x2v){run0, run1};
        unsigned qc[8];
#pragma unroll
        for (int i = 0; i < 8; ++i) qc[i] = qr[i];
        const int tb = wid & 3, eh = wid >> 2;
        const size_t trow = (tokc + tb * 16 + fr) * DM + hh * 128;
        u32x2 sgw[4];
#pragma unroll
        for (int mt = 0; mt < 4; ++mt) sgw[mt] = *(const u32x2*)(SG + trow + eh * 64 + mt * 16 + fq * 4);
        { const int nu = unit + ogdim(); if (nu < 32 * 128) HG3_LOAD(nu, zr, vr, qr, sbr); }
        __syncthreads();
        float off0 = 0.f, off1 = 0.f, gr0 = 0.f, gr1 = 0.f;
#pragma unroll
        for (int q = 0; q < 8; ++q) { const f32x2v tq = *(const LAS f32x2v*)(tot + q * 128 + 2 * d2); if (q < 4) { gr0 += tq[0]; gr1 += tq[1]; } if (q < part) { off0 += tq[0]; off1 += tq[1]; } }
#pragma unroll
        for (int i = 0; i < 8; ++i) { const float G0 = off0 + g0[i], G1 = off1 + g1[i]; const float q0 = bf2f(qc[i] & 0xffff), q1 = bf2f(qc[i] >> 16); const int t = part * 8 + i;
            *(LAS unsigned*)(Qt + t * TD_STR + 2 * d2) = pk2(q0 * __builtin_amdgcn_exp2f(fminf(G0 - gr0, 115.f)), q1 * __builtin_amdgcn_exp2f(fminf(G1 - gr1, 115.f)));
            *(LAS unsigned*)(Qh + t * TD_STR + 2 * d2) = pk2(q0 * __builtin_amdgcn_exp2f(G0), q1 * __builtin_amdgcn_exp2f(G1));
            *(LAS unsigned*)(Kp + t * TD_STR + 2 * d2) = pk2(k0[i] * __builtin_amdgcn_exp2f(fminf(gr0 - G0, 115.f)), k1[i] * __builtin_amdgcn_exp2f(fminf(gr1 - G1, 115.f))); }
        __syncthreads();
        f32x4 sc[4];
#pragma unroll
        for (int sb = 0; sb < 4; ++sb) { sc[sb] = (f32x4){0.f, 0.f, 0.f, 0.f};
            if (sb <= tb) {
#pragma unroll
                for (int ks = 0; ks < 4; ++ks) { const bf16x8 ka = *(const LAS bf16x8*)(Kp + (sb * 16 + fr) * TD_STR + ks * 32 + fq * 8), qb = *(const LAS bf16x8*)(Qt + (tb * 16 + fr) * TD_STR + ks * 32 + fq * 8);
                    sc[sb] = __builtin_amdgcn_mfma_f32_16x16x32_bf16(ka, qb, sc[sb], 0, 0, 0); }
                if (sb == tb) {
#pragma unroll
                    for (int j = 0; j < 4; ++j) if (fq * 4 + j > fr) sc[sb][j] = 0.f; } } }
        f32x4 o[4];
#pragma unroll
        for (int mt = 0; mt < 4; ++mt) o[mt] = (f32x4){0.f, 0.f, 0.f, 0.f};
#pragma unroll
        for (int ks = 0; ks < 2; ++ks) { union { bf16x8 v; u32x4 u; } pf; pf.u.x = pk2(sc[2 * ks][0], sc[2 * ks][1]); pf.u.y = pk2(sc[2 * ks][2], sc[2 * ks][3]); pf.u.z = pk2(sc[2 * ks + 1][0], sc[2 * ks + 1][1]); pf.u.w = pk2(sc[2 * ks + 1][2], sc[2 * ks + 1][3]);
            if (2 * ks <= tb) {
#pragma unroll
                for (int mt = 0; mt < 4; ++mt) { const int e = eh * 64 + mt * 16 + fr; union { bf16x8 v; u32x2 h[2]; } vf; vf.h[0] = *(const LAS u32x2*)(Vt + e * KT_STR + (2 * ks) * 16 + fq * 4); vf.h[1] = *(const LAS u32x2*)(Vt + e * KT_STR + (2 * ks + 1) * 16 + fq * 4);
                    o[mt] = __builtin_amdgcn_mfma_f32_16x16x32_bf16(vf.v, pf.v, o[mt], 0, 0, 0); } } }
#pragma unroll
        for (int ks = 0; ks < 4; ++ks) { const bf16x8 qb = *(const LAS bf16x8*)(Qh + (tb * 16 + fr) * TD_STR + ks * 32 + fq * 8);
#pragma unroll
            for (int mt = 0; mt < 4; ++mt) { const bf16x8 sa = *(const LAS bf16x8*)(Sb + (eh * 64 + mt * 16 + fr) * TD_STR + ks * 32 + fq * 8); o[mt] = __builtin_amdgcn_mfma_f32_16x16x32_bf16(sa, qb, o[mt], 0, 0, 0); } }
        float ss = 0.f;
#pragma unroll
        for (int mt = 0; mt < 4; ++mt) ss += (o[mt][0] * o[mt][0] + o[mt][1] * o[mt][1]) + (o[mt][2] * o[mt][2] + o[mt][3] * o[mt][3]);
        ss += __shfl_xor(ss, 16); ss += __shfl_xor(ss, 32);
        if (fq == 0) ssq[eh * 64 + tb * 16 + fr] = ss;
        __syncthreads();
        const float rstd = 1.f / sqrtf((ssq[tb * 16 + fr] + ssq[64 + tb * 16 + fr]) * (1.f / 128.f) + 1e-6f);
#pragma unroll
        for (int mt = 0; mt < 4; ++mt) { const int e = eh * 64 + mt * 16 + fq * 4; const f32x4 gg = *(const f32x4*)(ng + hh * 128 + e); const u32x2 sw = sgw[mt];
            f32x4 r; r[0] = o[mt][0] * rstd * gg[0] * bf2f(sw.x & 0xffff); r[1] = o[mt][1] * rstd * gg[1] * bf2f(sw.x >> 16); r[2] = o[mt][2] * rstd * gg[2] * bf2f(sw.y & 0xffff); r[3] = o[mt][3] * rstd * gg[3] * bf2f(sw.y >> 16);
            *(u32x2*)(HQ + trow + e) = pk4(r); }
        __syncthreads();
    }
#undef HG3_LOAD
}

constexpr float ATT_THR = 6.0f;
constexpr int AK_STR = 400, AV_STR = 144;
constexpr int AK_BYTES = 64 * AK_STR, AV_BYTES = 128 * AV_STR;
__device__ void attn_phase(LAS uchar* lds, const Params& p, bf16_t* obuf) {
    const int tid = otid(), wid = __builtin_amdgcn_readfirstlane(tid >> 6), lane = tid & 63, l32 = lane & 31, half = lane >> 5;
    bf16_t* QN = (bf16_t*)(p.ws + OFF_R1); const bf16_t* QR = (const bf16_t*)(p.ws + OFF_R5); const bf16_t* KN = (const bf16_t*)(p.ws + OFF_R2);
    const bf16_t* VT = (const bf16_t*)(p.ws + OFF_R3); const bf16_t* KR = (const bf16_t*)(p.ws + OFF_KR);
    for (int vb = obid(); vb < 256; vb += ogdim()) {
        const int vid = (vb & 7) * 32 + (vb >> 3);
        const int bh = vid >> 3, jj = vid & 7, b = bh >> 3, hh = bh & 7;
        for (int ui = 0; ui < 4; ++ui) {
            const int qb = ui == 0 ? 31 - jj : (ui == 1 ? 16 + jj : (ui == 2 ? 15 - jj : jj));
            const int q0 = qb * 256, ntiles = 4 * (qb + 1), wlast = 4 * qb + (wid >> 1);
            const size_t tokb = (size_t)b * SEQ; const int qrow = q0 + wid * 32 + l32;
            bf16x8 Q[12];
            { const bf16_t* qn = QN + (tokb + qrow) * DM + hh * 128; const bf16_t* qr = QR + (tokb + qrow) * 512 + hh * 64;
#pragma unroll
              for (int s = 0; s < 8; ++s) Q[s] = *(const bf16x8*)(qn + s * 16 + half * 8);
#pragma unroll
              for (int s = 0; s < 4; ++s) Q[8 + s] = *(const bf16x8*)(qr + s * 16 + half * 8); }
            f32x16 O[4];
#pragma unroll
            for (int mb = 0; mb < 4; ++mb)
#pragma unroll
                for (int i = 0; i < 16; ++i) O[mb][i] = 0.f;
            float mrun = 0.f, lrun = 0.f;
            u32x4 kreg[3], vreg[2];
            const bf16_t* vtb = VT + ((size_t)(bh * 128) << 13);
            const int akey = tid >> 3, ac8 = tid & 7;
            const unsigned koff = (unsigned)(akey * DM + ac8 * 8) * 2u, roff = (unsigned)(akey * 64 + ac8 * 8) * 2u, voff = (unsigned)((akey << 13) + ac8 * 8) * 2u;
            const int kdst = akey * AK_STR + ac8 * 16, vdst = akey * AV_STR + (ac8 >> 1) * 32 + (ac8 & 1) * 8;
#define ALOAD(kt_) do { const int kb_ = (kt_) * 64; const char* kbp = (const char*)(KN + (tokb + kb_) * DM + hh * 128); const char* rbp = (const char*)(KR + (tokb + kb_) * 64); const char* vbp2 = (const char*)(vtb + kb_); \
              kreg[0] = *(const u32x4*)(kbp + koff); kreg[1] = *(const u32x4*)(kbp + koff + 128); kreg[2] = *(const u32x4*)(rbp + roff); \
              vreg[0] = *(const u32x4*)(vbp2 + voff); vreg[1] = *(const u32x4*)(vbp2 + voff + (64u << 14)); } while (0)
#define ASTORE(buf_) do { LAS uchar* kb2 = lds + (buf_) * (AK_BYTES + AV_BYTES); LAS uchar* vb2 = kb2 + AK_BYTES; *(LAS u32x4*)(kb2 + kdst) = kreg[0]; *(LAS u32x4*)(kb2 + kdst + 128) = kreg[1]; *(LAS u32x4*)(kb2 + kdst + 256) = kreg[2]; \
              _Pragma("unroll") for (int i_ = 0; i_ < 2; ++i_) { *(LAS u32x2*)(vb2 + vdst + i_ * 64 * AV_STR) = (u32x2){vreg[i_].x, vreg[i_].y}; *(LAS u32x2*)(vb2 + vdst + i_ * 64 * AV_STR + 16) = (u32x2){vreg[i_].z, vreg[i_].w}; } } while (0)
            __syncthreads();
            ALOAD(0); ASTORE(0);
            __syncthreads();
            for (int kt = 0; kt < ntiles; ++kt) {
                const int cur = kt & 1;
                if (kt + 1 < ntiles) ALOAD(kt + 1);
                if (kt <= wlast) {
                    const LAS uchar* kb = lds + cur * (AK_BYTES + AV_BYTES); const LAS uchar* vbp = kb + AK_BYTES;
                    f32x16 s0, s1;
#pragma unroll
                    for (int i = 0; i < 16; ++i) { s0[i] = -mrun; s1[i] = -mrun; }
                    {
                        bf16x8 ka[2][2];
                        const LAS uchar* kp0 = kb + l32 * AK_STR + half * 16; const LAS uchar* kp1 = kp0 + 32 * AK_STR;
                        ka[0][0] = *(const LAS bf16x8*)kp0; ka[0][1] = *(const LAS bf16x8*)kp1;
#pragma unroll
                        for (int st = 0; st < 12; ++st) { if (st + 1 < 12) { ka[(st + 1) & 1][0] = *(const LAS bf16x8*)(kp0 + (st + 1) * 32); ka[(st + 1) & 1][1] = *(const LAS bf16x8*)(kp1 + (st + 1) * 32); }
                            __builtin_amdgcn_sched_barrier(0); __builtin_amdgcn_s_setprio(1);
                            s0 = __builtin_amdgcn_mfma_f32_32x32x16_bf16(ka[st & 1][0], Q[st], s0, 0, 0, 0); s1 = __builtin_amdgcn_mfma_f32_32x32x16_bf16(ka[st & 1][1], Q[st], s1, 0, 0, 0);
                            __builtin_amdgcn_s_setprio(0); __builtin_amdgcn_sched_barrier(0); }
                    }
                    if (kt == wlast) { asm volatile("" ::: "memory");
                        const int kbase = kt * 64 + half * 4;
#pragma unroll
                        for (int i = 0; i < 16; ++i) { const int key = kbase + (i >> 2) * 8 + (i & 3); if (key > qrow) s0[i] = -1e30f; if (key + 32 > qrow) s1[i] = -1e30f; } }
                    float mx = s0[0];
#pragma unroll
                    for (int i = 1; i < 16; ++i) mx = fmaxf(mx, s0[i]);
#pragma unroll
                    for (int i = 0; i < 16; ++i) mx = fmaxf(mx, s1[i]);
                    {
                      typedef unsigned u2_t __attribute__((ext_vector_type(2)));
                      const u2_t sw = __builtin_amdgcn_permlane32_swap(__float_as_uint(mx), __float_as_uint(mx), false, false);
                      mx = fmaxf(__uint_as_float(sw[0]), __uint_as_float(sw[1])); }
                    const float dm = fmaxf(mx, 0.f);
                    if (__builtin_amdgcn_ballot_w64(dm > ATT_THR) != 0ull) { const float alpha = __builtin_amdgcn_exp2f(-dm); lrun *= alpha; mrun += dm;
#pragma unroll
                        for (int i = 0; i < 16; ++i) { s0[i] -= dm; s1[i] -= dm; }
#pragma unroll
                        for (int mb = 0; mb < 4; ++mb)
#pragma unroll
                            for (int i = 0; i < 16; ++i) O[mb][i] *= alpha; }
                    float ps = 0.f;
#pragma unroll
                    for (int i = 0; i < 16; ++i) { s0[i] = __builtin_amdgcn_exp2f(s0[i]); s1[i] = __builtin_amdgcn_exp2f(s1[i]); ps += s0[i] + s1[i]; }
                    lrun += ps;
                    {
                        union VF { bf16x8 v; u32x2 h[2]; }; VF vfr[2][2];
                        const LAS uchar* vp0 = vbp + l32 * AV_STR + half * 16;
#define VLOADG(gi_, b_) do { _Pragma("unroll") for (int q_ = 0; q_ < 2; ++q_) { const LAS uchar* vp_ = vp0 + (((gi_) & 1) * 2 + q_) * 32 * AV_STR + ((gi_) >> 1) * 32; vfr[b_][q_].v = *(const LAS bf16x8*)vp_; } } while (0)
                        VLOADG(0, 0);
                        union { bf16x8 v; u32x4 u; } pf;
#pragma unroll
                        for (int gi = 0; gi < 8; ++gi) { const int ks = gi >> 1; if (gi + 1 < 8) VLOADG(gi + 1, (gi + 1) & 1);
                            if ((gi & 1) == 0) {
                                if (ks == 0) { pf.u.x = pk2(s0[0], s0[1]); pf.u.y = pk2(s0[2], s0[3]); pf.u.z = pk2(s0[4], s0[5]); pf.u.w = pk2(s0[6], s0[7]); }
                                else if (ks == 1) { pf.u.x = pk2(s0[8], s0[9]); pf.u.y = pk2(s0[10], s0[11]); pf.u.z = pk2(s0[12], s0[13]); pf.u.w = pk2(s0[14], s0[15]); }
                                else if (ks == 2) { pf.u.x = pk2(s1[0], s1[1]); pf.u.y = pk2(s1[2], s1[3]); pf.u.z = pk2(s1[4], s1[5]); pf.u.w = pk2(s1[6], s1[7]); }
                                else { pf.u.x = pk2(s1[8], s1[9]); pf.u.y = pk2(s1[10], s1[11]); pf.u.z = pk2(s1[12], s1[13]); pf.u.w = pk2(s1[14], s1[15]); } }
                            __builtin_amdgcn_sched_barrier(0); __builtin_amdgcn_s_setprio(1);
                            O[(gi & 1) * 2] = __builtin_amdgcn_mfma_f32_32x32x16_bf16(vfr[gi & 1][0].v, pf.v, O[(gi & 1) * 2], 0, 0, 0);
                            O[(gi & 1) * 2 + 1] = __builtin_amdgcn_mfma_f32_32x32x16_bf16(vfr[gi & 1][1].v, pf.v, O[(gi & 1) * 2 + 1], 0, 0, 0);
                            __builtin_amdgcn_s_setprio(0); __builtin_amdgcn_sched_barrier(0); }
#undef VLOADG
                    }
                }
                if (kt + 1 < ntiles) ASTORE(cur ^ 1);
                __syncthreads();
            }
            const float ltot = lrun + __shfl_xor(lrun, 32); const float inv = 1.f / ltot;
            bf16_t* op = obuf + (tokb + qrow) * DM + hh * 128;
#pragma unroll
            for (int mb = 0; mb < 4; ++mb)
#pragma unroll
                for (int g4 = 0; g4 < 4; ++g4) { f32x4 v; v[0] = O[mb][g4 * 4] * inv; v[1] = O[mb][g4 * 4 + 1] * inv; v[2] = O[mb][g4 * 4 + 2] * inv; v[3] = O[mb][g4 * 4 + 3] * inv;
                    *(u32x2*)(op + mb * 32 + g4 * 8 + half * 4) = pk4(v); }
        }
    }
#undef ALOAD
#undef ASTORE
}


#ifdef DIAGSCAN
__global__ void diag_scan_k(float* out, const uchar* ws, unsigned* flagw) {
    const size_t gtid = (size_t)obid() * blockDim.x + threadIdx.x, gsz = (size_t)ogdim() * blockDim.x;
    const unsigned short* ZF = (const unsigned short*)(ws + OFF_R1); const bf16_t* HVb = (const bf16_t*)(ws + OFF_R2); const bf16_t* LSb = (const bf16_t*)(ws + OFF_R4); const float* LBT = (const float*)(ws + OFF_LBT);
    float me = 0.f, mr = 0.f;
    for (size_t i = gtid; i < 16384; i += gsz) { const int unit = (int)((i * 7919) % 4096), dv = (int)((i * 31) % 128), dk = (int)((i * 17) % 128);
        const int chunk = unit & 127, bh = unit >> 7, b = bh >> 3, hh = bh & 7; const float la = LBT[hh * 128 + dk], lc = LBT[1024 + hh * 128 + dk], oml = LBT[2048 + hh * 128 + dk];
        const size_t tok0 = (size_t)b * SEQ + chunk * 64; float gcv = 0.f;
        for (int t = 0; t < 64; ++t) gcv += logf_gate(h2f(ZF[(tok0 + t) * DM + hh * 128 + dk]), la, lc);
        float G = 0.f, acc = 0.f;
        for (int t = 0; t < 64; ++t) { const float z = h2f(ZF[(tok0 + t) * DM + hh * 128 + dk]); G += logf_gate(z, la, lc); const float kt = oml / (1.f + __expf(z)) * __expf(gcv - G);
            acc += kt * __uint_as_float((unsigned)HVb[(tok0 + t) * DM + hh * 128 + dv] << 16); }
        const float got = __uint_as_float((unsigned)LSb[(size_t)unit * 16384 + dv * 128 + dk] << 16); me = fmaxf(me, fabsf(got - acc)); mr = fmaxf(mr, fabsf(acc)); }
    atomicMax(flagw + 2, __float_as_uint(me)); atomicMax(flagw + 3, __float_as_uint(mr));
}
__global__ void diag_fin_k(float* out, const unsigned* flagw) {
    const size_t gtid = (size_t)obid() * blockDim.x + threadIdx.x, gsz = (size_t)ogdim() * blockDim.x;
    const float mev = __uint_as_float(flagw[2]), mxv = __uint_as_float(flagw[3]);
    const float A = 10.f + fminf(89.f, fmaxf(0.f, rintf(log2f(fmaxf(mev, 1e-6f)) + 20.f)));
    const int k = (int)fminf(15.f, fmaxf(0.f, floorf(log2f(fmaxf(mxv, 1e-3f))) + 5.f));
    float c = 10.f; for (int i = 0; i < k; ++i) c *= 1.3f;
    const float mn = 0.f;
    (void)mn;
    for (size_t i = gtid; i < (size_t)T * DM; i += gsz) out[i] = (i == 0) ? A * 1e4f : c;
}
#endif
#define XB_TMO      128
#define XB_XCNT(j)  (256  + 64 * (j))
#define XB_XSUB(j)  (1280 + 64 * (j))
#define XB_XGEN(j)  (2304 + 64 * (j))
#define XB_TOP      3328
#define XB_TOPGEN   3392
#define XCD_BAR_WORDS 3456
#define XB_SPIN_CAP (1u << 18)

__device__ __forceinline__ unsigned xb_ld(unsigned* p)              { return __hip_atomic_load(p, __ATOMIC_RELAXED, __HIP_MEMORY_SCOPE_AGENT); }
__device__ __forceinline__ unsigned xb_add(unsigned* p, unsigned v) { return __hip_atomic_fetch_add(p, v, __ATOMIC_RELAXED, __HIP_MEMORY_SCOPE_AGENT); }
__device__ __forceinline__ unsigned xb_xcc_id() { return (unsigned)__builtin_amdgcn_s_getreg((3 << 11) | 20) & 0xFu; }
#define XB_SPIN(cond, bar) do { unsigned _sp = 0; while (cond) { __builtin_amdgcn_s_sleep(1); \
    if ((++_sp & 255u) == 0u) { if (xb_ld(&(bar)[XB_TMO])) break; if (_sp > XB_SPIN_CAP) { atomicAdd(&(bar)[XB_TMO], 1u); break; } } } } while (0)

struct XcdBarrier {
    unsigned* bar; unsigned x;
    volatile LAS unsigned* st;
};

__device__ __forceinline__ XcdBarrier xcd_barrier_post(unsigned* bar, volatile LAS unsigned* st) {
    XcdBarrier b; b.bar = bar; b.x = xb_xcc_id(); b.st = st;
    if (threadIdx.x == 0) (void)xb_add(&bar[XB_XCNT(b.x)], 1u);
    return b;
}
__device__ __forceinline__ void xcd_barrier_complete(unsigned* bar, unsigned x, unsigned& nloc, unsigned& nx) {
    const unsigned G = ogdim() * gridDim.y * gridDim.z;
    unsigned sum, cnt, mine, sp = 0u;
    for (;;) {
        sum = 0u; cnt = 0u; mine = 0u;
#pragma unroll
        for (unsigned j = 0; j < 16; ++j) { const unsigned c = xb_ld(&bar[XB_XCNT(j)]); sum += c; cnt += (c > 0u) ? 1u : 0u; mine = (j == x) ? c : mine; }
        if (sum == G) break;
        __builtin_amdgcn_s_sleep(1);
        if ((++sp & 255u) == 0u) { if (xb_ld(&bar[XB_TMO])) break; if (sp > XB_SPIN_CAP) { atomicAdd(&bar[XB_TMO], 1u); break; } }
    }
    nloc = mine > 0u ? mine : 1u; nx = cnt > 0u ? cnt : 1u;
}

__device__ __forceinline__ void xcd_barrier(const XcdBarrier& b) {
    asm volatile("s_waitcnt vmcnt(0)" ::: "memory");
    __syncthreads();
    if (threadIdx.x == 0) {
        unsigned* bar = b.bar;
        __builtin_amdgcn_s_waitcnt(0);
        unsigned nloc = b.st[0], nx = b.st[1];
        if (nloc == 0u) { xcd_barrier_complete(bar, b.x, nloc, nx); b.st[0] = nloc; b.st[1] = nx; }
        const unsigned old = xb_add(&bar[XB_XSUB(b.x)], 1u);
        const unsigned gen = old / nloc;
        if (old + 1u == (gen + 1u) * nloc) {
            __builtin_amdgcn_fence(__ATOMIC_RELEASE, "agent");
            asm volatile("s_waitcnt vmcnt(0)" ::: "memory");
            const unsigned og = xb_add(&bar[XB_TOP], 1u);
            const unsigned tg = og / nx;
            if (og + 1u == (tg + 1u) * nx) xb_add(&bar[XB_TOPGEN], 1u);
            else XB_SPIN(xb_ld(&bar[XB_TOPGEN]) == tg, bar);
            __builtin_amdgcn_fence(__ATOMIC_ACQUIRE, "agent");
            xb_add(&bar[XB_XGEN(b.x)], 1u);
            asm volatile("s_waitcnt vmcnt(0)" ::: "memory");
        } else {
            XB_SPIN(xb_ld(&bar[XB_XGEN(b.x)]) == gen, bar);
            __builtin_amdgcn_fence(__ATOMIC_ACQUIRE, "agent");
            asm volatile("s_waitcnt vmcnt(0)" ::: "memory");
        }
    }
    __syncthreads();
}

constexpr int LDS_BYTES = 8 * HTB + 64;
constexpr size_t OFF_BAR = OFF_LBT + 48 * 1024;
constexpr int NPHASE = 2 + 15 * NL;
#ifndef PH_HI
#define PH_HI NPHASE
#endif
#ifndef PH_MASK
#define PH_MASK 0x1FFFF
#endif

__global__ void __launch_bounds__(NTHR) mega(Params p_in) {
    extern __shared__ __attribute__((aligned(16))) uchar smem[];
    LAS uchar* lds = (LAS uchar*)smem;
    cg::grid_group grid = cg::this_grid();
    volatile LAS unsigned* xst = (volatile LAS unsigned*)(lds + 8 * HTB);
    if (threadIdx.x < 2) xst[threadIdx.x] = 0u;
    __syncthreads();
    (void)xcd_barrier_post((unsigned*)(p_in.ws + OFF_BAR), xst);
    const int nM = T / 256;
    for (int ph = p_in.ph_lo; ph < p_in.ph_hi; ++ph) {
        Params p = p_in; asm volatile("" : "+s"(p.ws), "+s"(p.out));
        uchar* ws = p.ws; float* ADA = (float*)(ws + OFF_ADA); bf16_t* U = (bf16_t*)(ws + OFF_U); bf16_t* HID = (bf16_t*)(ws + OFF_R0);
        if (ph == 0) { if constexpr (PH_MASK & 1) { p0a(lds, p); conv_layer(lds, p, 0, obid(), ogdim()); } }
        else if (ph == 1) { if constexpr (PH_MASK & 2) ln_pass(p, p.x, p.out, U, nullptr, nullptr, ADA, 1, 0, false, true, false); }
        else {
            const int l = (ph - 2) / 15, sub = (ph - 2) % 15;
            const bf16_t* W = (const bf16_t*)(ws + OFF_W + (size_t)(l & 1) * WSZ);
            const float* adal = ADA + (size_t)l * 4 * 9216;
            switch (sub) {
            case 0: if constexpr ((PH_MASK >> 2) & 1) { EpiGU E{HID}; gemm_run2<EpiGU>(lds, U, W + W_GU1, nM, 22, DM, E); } break;
            case 1: if constexpr ((PH_MASK >> 3) & 1) { const float* onz = (const float*)(ws + OFF_ONES); EpiRes E{p.out, adal + 2 * 1024, 0.5f, (const float*)(ws + OFF_STATS), l ? p.ln_g + (size_t)(l * 3 - 1) * DM : onz, l ? p.ln_b + (size_t)(l * 3 - 1) * DM : onz + 1024, l ? p.out : p.x}; gemm_run2<EpiRes>(lds, HID, W + W_D1, nM, 4, FF, E); } break;
            case 2: if constexpr ((PH_MASK >> 4) & 1) ln_pass2(p, p.out, nullptr, U, p.ln_g + (size_t)(l * 3 + 0) * DM, p.ln_b + (size_t)(l * 3 + 0) * DM, adal, 4, 3); break;
            case 3: if constexpr ((PH_MASK >> 5) & 1) { EpiWin1 E{(bf16_t*)(ws + OFF_R0), (bf16_t*)(ws + OFF_R2), (bf16_t*)(ws + OFF_R3), (bf16_t*)(ws + OFF_CQ), (bf16_t*)(ws + OFF_CKV), (unsigned short*)(ws + OFF_R1), (float*)(ws + OFF_KRRAW)};
                      gemm_run2<EpiWin1>(lds, U, W + W_IN, nM, 19, DM, E); } break;
            case 4: if constexpr ((PH_MASK >> 6) & 1) { hg1_phase(lds, p, l); tok_pass(p); } break;
            case 5: if constexpr ((PH_MASK >> 7) & 1) { hg2_phase(p); if (l + 1 < NL) conv_layer(lds, p, l + 1, obid(), ogdim()); } break;
            case 6: if constexpr ((PH_MASK >> 8) & 1) hg3_phase(lds, p, l); break;
            case 7: if constexpr ((PH_MASK >> 9) & 1) { EpiQ Eq{(bf16_t*)(ws + OFF_R1), (bf16_t*)(ws + OFF_R5), (const float*)(ws + OFF_RSQ), (const float*)(ws + OFF_COS), (const float*)(ws + OFF_SIN)};
                      gemm_run2<EpiQ>(lds, (const bf16_t*)(ws + OFF_CQ), W + W_UQ, nM, 6, 384, Eq);
                      EpiKn Ek{(bf16_t*)(ws + OFF_R2), (const float*)(ws + OFF_RSKV)};
                      gemm_run2<EpiKn>(lds, (const bf16_t*)(ws + OFF_CKV), W + W_UKV, nM, 4, 256, Ek);
                      EpiV Ev{(bf16_t*)(ws + OFF_R3), (const float*)(ws + OFF_RSKV)};
                      gemm_run2<EpiV, true>(lds, (const bf16_t*)(ws + OFF_CKV), W + W_UKV + (size_t)1024 * 256, nM, 4, 256, Ev);
                      EpiGate Eg{(unsigned short*)(ws + OFF_R4), (unsigned short*)(ws + OFF_R4 + 64 * MB)};
                      gemm_run2<EpiGate>(lds, U, W + W_IN + (size_t)4800 * DM, nM, 8, DM, Eg); } break;
            case 8: if constexpr ((PH_MASK >> 10) & 1) {
#ifdef ATTN_TWICE
                for (int rep = 0; rep < p.ph_lo + 2; ++rep) { attn_phase(lds, p, (bf16_t*)(ws + (rep == 0 ? OFF_U : OFF_R1))); __syncthreads(); }
#else
                attn_phase(lds, p, (bf16_t*)(ws + OFF_R1));
#endif
                } break;
            case 9: if constexpr ((PH_MASK >> 11) & 1) { EpiM1 E1{(bf16_t*)(ws + OFF_R5), (const unsigned short*)(ws + OFF_R4)};
                      gemm_run2<EpiM1>(lds, (const bf16_t*)(ws + OFF_R0), W + W_BH, nM, 4, DM, E1);
                      EpiM2 E2{(const bf16_t*)(ws + OFF_R5), (const unsigned short*)(ws + OFF_R4 + 64 * MB), U};
                      gemm_run2<EpiM2>(lds, (const bf16_t*)(ws + OFF_R1), W + W_BM, nM, 4, DM, E2); } break;
            case 10: if constexpr ((PH_MASK >> 12) & 1) { EpiRes E{p.out, adal + 5 * 1024, 1.0f, (const float*)(ws + OFF_STATS), p.ln_g + (size_t)(l * 3 + 0) * DM, p.ln_b + (size_t)(l * 3 + 0) * DM, p.out}; gemm_run2<EpiRes>(lds, U, W + W_OUT, nM, 4, DM, E); } break;
            case 11: if constexpr ((PH_MASK >> 13) & 1) ln_pass2(p, p.out, nullptr, U, p.ln_g + (size_t)(l * 3 + 1) * DM, p.ln_b + (size_t)(l * 3 + 1) * DM, adal, 7, 6); break;
            case 12: if constexpr ((PH_MASK >> 14) & 1) { EpiGU E{HID}; gemm_run2<EpiGU>(lds, U, W + W_GU2, nM, 22, DM, E); } break;
            case 13: if constexpr ((PH_MASK >> 15) & 1) { EpiRes E{p.out, adal + 8 * 1024, 0.5f, (const float*)(ws + OFF_STATS), p.ln_g + (size_t)(l * 3 + 1) * DM, p.ln_b + (size_t)(l * 3 + 1) * DM, p.out}; gemm_run2<EpiRes>(lds, HID, W + W_D2, nM, 4, FF, E); } break;
            default: if constexpr ((PH_MASK >> 16) & 1) ln_pass2(p, p.out, l + 1 == NL ? p.out : nullptr, U, p.ln_g + (size_t)(l * 3 + 2) * DM, p.ln_b + (size_t)(l * 3 + 2) * DM, adal + 4 * 9216, 1, 0); break;
            }
        }
        if (ph + 1 < p_in.ph_hi) { if (ph == p_in.ph_lo) grid.sync(); else { XcdBarrier xb2; xb2.bar = (unsigned*)(p.ws + OFF_BAR); xb2.x = xb_xcc_id(); xb2.st = (volatile LAS unsigned*)(lds + 8 * HTB); xcd_barrier(xb2); } }
    }
}

extern "C" void kernel_launch(void* const* d_in, const int* in_sizes, int n_in, void* d_out, int out_size, void* d_ws, size_t ws_size, hipStream_t stream) {
    static int grid = 0;
    if (grid == 0) {
        if (n_in != 23 || ws_size < WS_END) { fprintf(stderr, "kernel_launch: n_in %d ws %zu (need %zu)\n", n_in, ws_size, (size_t)WS_END); grid = -1; return; }
        int dev = 0, cus = 0, per_cu = 0;
        hipGetDevice(&dev); hipDeviceGetAttribute(&cus, hipDeviceAttributeMultiprocessorCount, dev);
        if (hipFuncSetAttribute((const void*)mega, hipFuncAttributeMaxDynamicSharedMemorySize, LDS_BYTES) != hipSuccess) { fprintf(stderr, "kernel_launch: hipFuncSetAttribute failed\n"); grid = -1; return; }
        hipOccupancyMaxActiveBlocksPerMultiprocessor(&per_cu, (const void*)mega, NTHR, LDS_BYTES);
        if (per_cu < 1) { fprintf(stderr, "kernel_launch: occupancy query says %d\n", per_cu); per_cu = 1; }
        (void)hipGetLastError();
        grid = cus;
    }
    if (grid < 0) return;
    Params p{};
    p.x = (const float*)d_in[0]; p.c = (const float*)d_in[1]; p.pos = (const int*)d_in[2];
    p.ada_w = (const float*)d_in[3]; p.ada_b = (const float*)d_in[4]; p.ln_g = (const float*)d_in[5]; p.ln_b = (const float*)d_in[6];
    p.f1g = (const float*)d_in[7]; p.f1u = (const float*)d_in[8]; p.f1d = (const float*)d_in[9]; p.w_in = (const float*)d_in[10];
    p.hg_lb = (const float*)d_in[11]; p.hg_ng = (const float*)d_in[12]; p.qng = (const float*)d_in[13]; p.w_uq = (const float*)d_in[14];
    p.kvng = (const float*)d_in[15]; p.w_ukv = (const float*)d_in[16]; p.w_bh = (const float*)d_in[17]; p.w_bm = (const float*)d_in[18];
    p.w_out = (const float*)d_in[19]; p.f2g = (const float*)d_in[20]; p.f2u = (const float*)d_in[21]; p.f2d = (const float*)d_in[22];
    p.out = (float*)d_out; p.ws = (uchar*)d_ws; p.ph_lo = 0; p.ph_hi = PH_HI;
    (void)hipMemsetAsync((uchar*)d_ws + OFF_BAR, 0, XCD_BAR_WORDS * 4, stream);
    void* args[] = {&p};
    hipError_t e = hipLaunchCooperativeKernel((const void*)mega, dim3(grid), dim3(NTHR), args, LDS_BYTES, stream);
    if (e != hipSuccess) fprintf(stderr, "cooperative launch failed: %s (grid %d)\n", hipGetErrorString(e), grid);
#ifdef DIAGSCAN
    unsigned* flagw = (unsigned*)((uchar*)d_ws + OFF_LBT + 60 * 1024);
    (void)hipMemsetAsync(flagw, 0, 64, stream);
    diag_scan_k<<<2048, 256, 0, stream>>>((float*)d_out, (const uchar*)d_ws, flagw);
    diag_fin_k<<<2048, 256, 0, stream>>>((float*)d_out, flagw);
#endif
}
```

```cpp
#include <hip/hip_runtime.h>
#include <hip/hip_cooperative_groups.h>
#include <cstdio>
#include <cstdint>
namespace cg = cooperative_groups;

#define LAS __attribute__((address_space(3)))
typedef unsigned short bf16_t;
typedef unsigned char uchar;
typedef short bf16x8 __attribute__((ext_vector_type(8)));
typedef float f32x4 __attribute__((ext_vector_type(4)));
typedef float f32x16 __attribute__((ext_vector_type(16)));
typedef unsigned u32x4 __attribute__((ext_vector_type(4)));
typedef unsigned u32x2 __attribute__((ext_vector_type(2)));
typedef float f32x2v __attribute__((ext_vector_type(2)));

constexpr int T = 32768, SEQ = 8192, DM = 1024, FF = 2816, NL = 4;
constexpr float DN_ALPHA = 1.681792830507429f;
constexpr float QSCALE = 0.10411754627697264f;
constexpr int NTHR = 512;

constexpr size_t MB = 1ull << 20;
constexpr size_t OFF_ADA = 0;
constexpr size_t OFF_COS = 1 * MB;
constexpr size_t OFF_SIN = OFF_COS + 4 * MB;
constexpr size_t OFF_LBT = OFF_SIN + 4 * MB;
constexpr size_t OFF_RSQ = OFF_LBT + 64 * 1024;
constexpr size_t OFF_RSKV = OFF_RSQ + 128 * 1024;
constexpr size_t OFF_DEC = OFF_RSKV + 128 * 1024;
constexpr size_t OFF_KRRAW = OFF_DEC + 2 * MB;
constexpr size_t OFF_KR = OFF_KRRAW + 8 * MB;
constexpr size_t OFF_W = OFF_KR + 4 * MB;
constexpr size_t WSZ = 57147392ull;
constexpr size_t W_GU1 = 0, W_D1 = 5767168, W_IN = 8650752, W_UQ = 15663104, W_UKV = 16252928, W_BH = 16777216, W_BM = 17825792,
                 W_OUT = 18874368, W_GU2 = 19922944, W_D2 = 25690112;
constexpr size_t OFF_U = OFF_W + 2 * WSZ;
constexpr size_t OFF_BIG = OFF_U + 64 * MB;
constexpr size_t OFF_R0 = OFF_BIG;
constexpr size_t OFF_R1 = OFF_R0 + 64 * MB;
constexpr size_t OFF_R2 = OFF_R1 + 64 * MB;
constexpr size_t OFF_R3 = OFF_R2 + 64 * MB;
constexpr size_t OFF_R4 = OFF_R3 + 64 * MB;
constexpr size_t OFF_R5 = OFF_R4 + 128 * MB;
constexpr size_t OFF_CQ = OFF_R5 + 32 * MB;
constexpr size_t OFF_CKV = OFF_CQ + 24 * MB;
constexpr size_t OFF_STATS = OFF_CKV + 16 * MB;
constexpr size_t OFF_ONES = OFF_STATS + 256 * 1024;
constexpr size_t WS_END = OFF_ONES + 8 * 1024;

struct Params {
    const float *x, *c; const int* pos;
    const float *ada_w, *ada_b, *ln_g, *ln_b, *f1g, *f1u, *f1d, *w_in, *hg_lb, *hg_ng, *qng, *w_uq, *kvng, *w_ukv, *w_bh, *w_bm, *w_out, *f2g, *f2u, *f2d;
    float* out; uchar* ws; int ph_lo, ph_hi;
};

#define DS0 OFF_R0
#define DM0 0x7f80u
#define DS1 OFF_R1
#define DM1 0x7c00u
#define DS2 OFF_R2
#define DM2 0x7f80u
#define DS3 OFF_R3
#define DM3 0x7f80u
#define DS4 OFF_R4
#define DM4 0x7f80u
#define DS5 (OFF_R4 + 64 * MB)
#define DM5 0x7f80u
typedef __bf16 bf16v2_t __attribute__((ext_vector_type(2)));
typedef float f32x2_t __attribute__((ext_vector_type(2)));
__device__ __forceinline__ unsigned pk2(float lo, float hi) { const f32x2_t v = {lo, hi}; const bf16v2_t r = __builtin_convertvector(v, bf16v2_t); return __builtin_bit_cast(unsigned, r); }
__device__ __forceinline__ bf16_t f2bf(float f) { return (bf16_t)(pk2(f, 0.f) & 0xffffu); }
__device__ __forceinline__ float bf2f(unsigned v) { return __uint_as_float(v << 16); }
__device__ __forceinline__ float sigm(float x) { return __builtin_amdgcn_rcpf(1.f + __expf(-x)); }
__device__ __forceinline__ float siluf(float x) { return x * sigm(x); }
__device__ __forceinline__ unsigned short f2h(float f) { _Float16 h = (_Float16)f; return __builtin_bit_cast(unsigned short, h); }
__device__ __forceinline__ float h2f(unsigned short v) { return (float)__builtin_bit_cast(_Float16, v); }
__device__ __forceinline__ unsigned pkh2(float lo, float hi) { return (unsigned)f2h(lo) | ((unsigned)f2h(hi) << 16); }
__device__ __forceinline__ u32x2 pk4(f32x4 v) { u32x2 w; w.x = pk2(v[0], v[1]); w.y = pk2(v[2], v[3]); return w; }

__device__ __forceinline__ int otid() { int w = __builtin_amdgcn_readfirstlane((int)(threadIdx.x >> 6)); asm volatile("" : "+s"(w)); int t = w * 64 + (int)__builtin_amdgcn_mbcnt_hi(~0u, __builtin_amdgcn_mbcnt_lo(~0u, 0u)); asm volatile("" : "+v"(t)); return t; }
__device__ __forceinline__ int obid() { int b = blockIdx.x; asm volatile("" : "+s"(b)); return b; }
__device__ __forceinline__ int ogdim() { int g = gridDim.x; asm volatile("" : "+s"(g)); return g; }
#define COORDS const int tid = otid(), wid = __builtin_amdgcn_readfirstlane(tid >> 6), lane = tid & 63, wr = wid >> 2, wc = wid & 3, fr = lane & 15, fq = lane >> 4; (void)lane; (void)wr; (void)wc; (void)fr; (void)fq;

constexpr int BK = 64, HALF = 128, HTB = HALF * BK * 2;
__device__ __forceinline__ int lds_byte(int r, int c) { const int st = (r >> 4) * 2 + (c >> 5), rr = r & 15, cc = c & 31, ob = rr * 64 + cc * 2; return st * 1024 + (ob ^ (((ob >> 9) & 1) << 5)); }
__device__ __forceinline__ void stage_rc(int b, int& R, int& C) { const int st = b / 1024, sb = b % 1024, swz = sb ^ (((sb >> 9) & 1) << 5); R = (st >> 1) * 16 + swz / 64; C = (st & 1) * 32 + (swz % 64) / 2; }

template <bool SWAP>
__device__ __forceinline__ void gemm_kloop(LAS uchar* lds, const char* cA, const char* cB, int K, f32x4 (&acc)[2][2][4][2]) {
    COORDS
    const int nt = K / BK;
    unsigned voff[2];
#pragma unroll
    for (int i = 0; i < 2; ++i) { int R, C; stage_rc(tid * 16 + i * 8192, R, C); voff[i] = (unsigned)(R * K + C) * 2u; }
    const size_t kstep = (size_t)(BK * 2), hstep = (size_t)HALF * K * 2;
    const unsigned ldsw = (unsigned)wid * 1024u;
    const int aoff = lds_byte(wr * 64 + fr, fq * 8), boff = lds_byte(wc * 32 + fr, fq * 8);
#define SA(b, h) (((b) * 2 + (h)) * HTB)
#define SB(b, h) ((4 + (b) * 2 + (h)) * HTB)
#define STAGE(bufoff, gbase) do { _Pragma("unroll") for (int _i = 0; _i < 2; ++_i) \
        __builtin_amdgcn_global_load_lds((const unsigned*)((const char*)(gbase) + voff[_i]), (LAS unsigned*)(lds + (bufoff) + ldsw + _i * 8192), 16, 0, 0); } while (0)
#define LDA(dst, b, h) do { _Pragma("unroll") for (int m = 0; m < 4; ++m) _Pragma("unroll") for (int k = 0; k < 2; ++k) dst[m][k] = *(const LAS bf16x8*)(lds + SA(b, h) + aoff + m * 2048 + k * 1024); } while (0)
#define LDB(dst, b, h) do { _Pragma("unroll") for (int n = 0; n < 2; ++n) _Pragma("unroll") for (int k = 0; k < 2; ++k) dst[n][k] = *(const LAS bf16x8*)(lds + SB(b, h) + boff + n * 2048 + k * 1024); } while (0)
#define MMA(ai, bj, At, Bt) do { __builtin_amdgcn_s_setprio(1); _Pragma("unroll") for (int m = 0; m < 4; ++m) _Pragma("unroll") for (int n = 0; n < 2; ++n) _Pragma("unroll") for (int k = 0; k < 2; ++k) \
        acc[ai][bj][m][n] = SWAP ? __builtin_amdgcn_mfma_f32_16x16x32_bf16(Bt[n][k], At[m][k], acc[ai][bj][m][n], 0, 0, 0) \
                                 : __builtin_amdgcn_mfma_f32_16x16x32_bf16(At[m][k], Bt[n][k], acc[ai][bj][m][n], 0, 0, 0); __builtin_amdgcn_s_setprio(0); } while (0)
#define WAIT_V(n) asm volatile("s_waitcnt vmcnt(" #n ")" ::: "memory")
#define WAIT_L(n) asm volatile("s_waitcnt lgkmcnt(" #n ")" ::: "memory")
#define BAR __builtin_amdgcn_s_barrier()
#define SCHED __builtin_amdgcn_sched_barrier(0)
    bf16x8 At[4][2], B0[2][2], B1[2][2];
    STAGE(SB(0, 0), cB); STAGE(SA(0, 0), cA); STAGE(SB(0, 1), cB + hstep); STAGE(SA(0, 1), cA + hstep);
    if (wr == 1) BAR;
    WAIT_V(4); BAR;
    STAGE(SB(1, 0), cB + kstep); STAGE(SA(1, 0), cA + kstep); STAGE(SB(1, 1), cB + hstep + kstep);
    WAIT_V(6); BAR;
    for (int t = 0; t < nt - 2; t += 2) {
        const char* a1 = cA + (size_t)(t + 1) * kstep;
        const char* a2 = cA + (size_t)(t + 2) * kstep; const char* b2 = cB + (size_t)(t + 2) * kstep;
        const char* a3 = a2 + kstep; const char* b3 = b2 + kstep;
        LDB(B0, 0, 0); SCHED; LDA(At, 0, 0); STAGE(SA(1, 1), a1 + hstep);
        WAIT_L(8); BAR; WAIT_L(0); MMA(0, 0, At, B0); BAR; SCHED;
        LDB(B1, 0, 1); STAGE(SB(0, 0), b2);
        BAR; WAIT_L(0); MMA(0, 1, At, B1); BAR;
        LDA(At, 0, 1); STAGE(SA(0, 0), a2);
        BAR; WAIT_L(0); MMA(1, 0, At, B0); BAR; SCHED;
        STAGE(SB(0, 1), b2 + hstep);
        WAIT_V(6); BAR; MMA(1, 1, At, B1); BAR;
        LDB(B0, 1, 0); SCHED; LDA(At, 1, 0); STAGE(SA(0, 1), a2 + hstep);
        WAIT_L(8); BAR; WAIT_L(0); MMA(0, 0, At, B0); BAR; SCHED;
        LDB(B1, 1, 1); STAGE(SB(1, 0), b3);
        BAR; WAIT_L(0); MMA(0, 1, At, B1); BAR;
        LDA(At, 1, 1); STAGE(SA(1, 0), a3);
        BAR; WAIT_L(0); MMA(1, 0, At, B0); BAR; SCHED;
        STAGE(SB(1, 1), b3 + hstep);
        WAIT_V(6); BAR; MMA(1, 1, At, B1); BAR;
    }
    { LDB(B0, 0, 0); LDA(At, 0, 0); STAGE(SA(1, 1), cA + (size_t)(nt - 1) * kstep + hstep);
      BAR; WAIT_L(0); MMA(0, 0, At, B0); BAR;
      LDB(B1, 0, 1); BAR; WAIT_L(0); MMA(0, 1, At, B1); BAR;
      LDA(At, 0, 1); WAIT_V(4); BAR; WAIT_L(0); MMA(1, 0, At, B0); MMA(1, 1, At, B1); BAR; }
    { LDB(B0, 1, 0); LDA(At, 1, 0); WAIT_V(2); BAR; WAIT_L(0); MMA(0, 0, At, B0); BAR;
      LDB(B1, 1, 1); WAIT_V(0); BAR; WAIT_L(0); MMA(0, 1, At, B1); BAR;
      LDA(At, 1, 1); BAR; WAIT_L(0); MMA(1, 0, At, B0); MMA(1, 1, At, B1); BAR; }
    if (wr == 0) BAR;
#undef SA
#undef SB
#undef STAGE
#undef LDA
#undef LDB
#undef MMA
}

__device__ __forceinline__ void unit_map(int L, int nM, int nN, int& pm, int& pn) {
    const int nwg = nM * nN; int wgid = L;
    { const int q = nwg / 8, r = nwg % 8, xcd = wgid % 8, off = wgid / 8; wgid = (xcd < r ? xcd * (q + 1) : r * (q + 1) + (xcd - r) * q) + off; }
    const int nig = 8 * nN, gid = wgid / nig, fm = gid * 8, gsz = (nM - fm) < 8 ? (nM - fm) : 8;
    pm = fm + ((wgid % nig) % gsz); pn = (wgid % nig) / gsz;
}

#define ZERO_ACC(acc) _Pragma("unroll") for (int a_ = 0; a_ < 2; ++a_) _Pragma("unroll") for (int b_ = 0; b_ < 2; ++b_) _Pragma("unroll") for (int m_ = 0; m_ < 4; ++m_) _Pragma("unroll") for (int n_ = 0; n_ < 2; ++n_) acc[a_][b_][m_][n_] = (f32x4){0.f, 0.f, 0.f, 0.f};

template <class Epi, bool SWAP>
__device__ __forceinline__ void gemm_run(LAS uchar* lds, const bf16_t* A, const bf16_t* Bt, int nM, int nN, int K, const Epi& E) {
    const int G = ogdim(), c = obid(), nwg = nM * nN;
    for (int i = 0;; ++i) {
        const long L = (long)i * G + c; if (L >= nwg) break;
        int pm, pn; unit_map((int)L, nM, nN, pm, pn);
        f32x4 acc[2][2][4][2]; ZERO_ACC(acc)
        asm volatile("s_waitcnt vmcnt(0)" ::: "memory");
        gemm_kloop<SWAP>(lds, (const char*)(A + (size_t)pm * 256 * K), (const char*)(Bt + (size_t)pn * 256 * K), K, acc);
        E(acc, pm, pn);
    }
}

namespace pg8 {
#define PG8_LAS __attribute__((address_space(3)))
typedef unsigned short bf16_t;
typedef short bf16x8 __attribute__((ext_vector_type(8)));
typedef float f32x4 __attribute__((ext_vector_type(4)));
typedef unsigned u32x4 __attribute__((ext_vector_type(4)));
constexpr int BM = 256, BK = 64, HALF = 128, HTB = HALF * BK * 2  , STAGE_BYTES = 8 * HTB, NXCD = 8, WGM = 8;

__host__ __device__ __forceinline__ int lds_byte(int r, int c) { const int st = (r >> 4) * 2 + (c >> 5), rr = r & 15, cc = c & 31, ob = rr * 64 + cc * 2; return st * 1024 + (ob ^ (((ob >> 9) & 1) << 5)); }
__host__ __device__ __forceinline__ void stage_rc(int b, int& R, int& C) { const int st = b / 1024, sb = b % 1024, swz = sb ^ (((sb >> 9) & 1) << 5); R = (st >> 1) * 16 + swz / 64; C = (st & 1) * 32 + (swz % 64) / 2; }
__host__ __device__ __forceinline__ int perm32(int rho) { const int n = rho >> 4, i = rho & 15; return 8 * (i >> 2) + 4 * n + (i & 3); }

struct Unit { int pm, pn; };
struct Gemm { const bf16_t* A; const bf16_t* Bt; int M, N, K; };

struct StaticOrder {
    int nM, nN, nwg, G, c;
    __host__ __device__ void init(int M, int N, int G_, int c_) { nM = M / BM; nN = N / BM; nwg = nM * nN; G = G_; c = c_; }
    __host__ __device__ bool next(int i, Unit& u) const {
        const long L = (long)i * G + c; if (L >= nwg) return false;
        int wgid = (int)L; { const int q = nwg / NXCD, r = nwg % NXCD, xcd = wgid % NXCD, off = wgid / NXCD; wgid = (xcd < r ? xcd * (q + 1) : r * (q + 1) + (xcd - r) * q) + off; }
        const int nig = WGM * nN, gid = wgid / nig, fm = gid * WGM, gsz = (nM - fm) < WGM ? (nM - fm) : WGM;
        u.pm = fm + ((wgid % nig) % gsz); u.pn = (wgid % nig) / gsz; return true;
    }
    __device__ __forceinline__ void a_ready(const Unit&) const {}
    __device__ __forceinline__ void done(const Unit&) const {}
};
template <class Epi, class Sched, bool ALIGN_EPI = false, bool SP2 = false>
__device__ __forceinline__ void gemm_phase(PG8_LAS unsigned char* lds, const Gemm g, const Sched& S, const Epi& E) {
    const int tid = otid(), wid = __builtin_amdgcn_readfirstlane(tid >> 6), lane = tid & 63, wr = wid >> 2, wc = wid & 3, fr = lane & 15, fq = lane >> 4;
    const int K = g.K, nt = K / BK;
    unsigned voffA[2], voffB[2];
#pragma unroll
    for (int i = 0; i < 2; ++i) { int R, C; stage_rc(tid * 16 + i * 8192, R, C); const int Rb = Epi::PERM ? ((R & ~31) + perm32(R & 31)) : R;
        voffA[i] = (unsigned)(R * K + C) * 2u; voffB[i] = (unsigned)(Rb * K + C) * 2u; }
    const size_t kstep = (size_t)(BK * 2);
    const size_t hstep = (size_t)HALF * K * 2;
    const size_t tstep = 2 * hstep;
    const unsigned ldsw = (unsigned)wid * 1024u;
    const int aoff = lds_byte(wr * 64 + fr, fq * 8), boff = lds_byte(wc * 32 + fr, fq * 8);
#define PG8_SA(b, h) (((b) * 2 + (h)) * HTB)
#define PG8_SB(b, h) ((4 + (b) * 2 + (h)) * HTB)
#define PG8_STAGE(bufoff, gbase, voff) do { _Pragma("unroll") for (int _i = 0; _i < 2; ++_i) \
        __builtin_amdgcn_global_load_lds((const unsigned*)((const char*)(gbase) + (voff)[_i]), (PG8_LAS unsigned*)(lds + (bufoff) + ldsw + _i * 8192), 16, 0, 0); } while (0)
#define PG8_LDA(dst, b, h) do { _Pragma("unroll") for (int m = 0; m < 4; ++m) _Pragma("unroll") for (int k = 0; k < 2; ++k) dst[m][k] = *(const PG8_LAS bf16x8*)(lds + PG8_SA(b, h) + aoff + m * 2048 + k * 1024); } while (0)
#define PG8_LDB(dst, b, h) do { _Pragma("unroll") for (int n = 0; n < 2; ++n) _Pragma("unroll") for (int k = 0; k < 2; ++k) dst[n][k] = *(const PG8_LAS bf16x8*)(lds + PG8_SB(b, h) + boff + n * 2048 + k * 1024); } while (0)
#define PG8_MMA(ai, bj, At, Bt) do { __builtin_amdgcn_s_setprio(1); _Pragma("unroll") for (int m = 0; m < 4; ++m) _Pragma("unroll") for (int n = 0; n < 2; ++n) _Pragma("unroll") for (int k = 0; k < 2; ++k) \
        acc[ai][bj][m][n] = Epi::NSWAP ? __builtin_amdgcn_mfma_f32_16x16x32_bf16(At[m][k], Bt[n][k], acc[ai][bj][m][n], 0, 0, 0) : __builtin_amdgcn_mfma_f32_16x16x32_bf16(Bt[n][k], At[m][k], acc[ai][bj][m][n], 0, 0, 0); __builtin_amdgcn_s_setprio(0); } while (0)
#define PG8_WAIT_V(n) asm volatile("s_waitcnt vmcnt(" #n ")" ::: "memory")
#define PG8_WAIT_L(n) asm volatile("s_waitcnt lgkmcnt(" #n ")" ::: "memory")
#define PG8_BAR __builtin_amdgcn_s_barrier()
#define PG8_SCHED __builtin_amdgcn_sched_barrier(0)
    Unit cur, nxt; int ui = 0;
    if (!S.next(0, cur)) return;
    f32x4 acc[2][2][4][2];
#pragma unroll
    for (int a = 0; a < 2; ++a)
#pragma unroll
        for (int b = 0; b < 2; ++b)
#pragma unroll
            for (int m = 0; m < 4; ++m)
#pragma unroll
                for (int n = 0; n < 2; ++n) acc[a][b][m][n] = (f32x4){0.f, 0.f, 0.f, 0.f};
    bf16x8 At[4][2], B0[2][2], B1[2][2];
    const char* cA = (const char*)g.A + (size_t)cur.pm * tstep; const char* cB = (const char*)g.Bt + (size_t)cur.pn * tstep;
    S.a_ready(cur);
    if constexpr (SP2) {
        PG8_STAGE(PG8_SB(0, 0), cB, voffB); PG8_STAGE(PG8_SB(0, 1), cB + hstep, voffB); PG8_STAGE(PG8_SA(0, 0), cA, voffA); PG8_STAGE(PG8_SA(0, 1), cA + hstep, voffA);
        if (wr == 1) PG8_BAR;
        PG8_WAIT_V(2); PG8_BAR;
        PG8_STAGE(PG8_SB(1, 0), cB + kstep, voffB); PG8_STAGE(PG8_SA(1, 0), cA + kstep, voffA); PG8_STAGE(PG8_SB(1, 1), cB + hstep + kstep, voffB);
        PG8_WAIT_V(6); PG8_BAR;
    } else {
        PG8_STAGE(PG8_SB(0, 0), cB, voffB); PG8_STAGE(PG8_SA(0, 0), cA, voffA); PG8_STAGE(PG8_SB(0, 1), cB + hstep, voffB); PG8_STAGE(PG8_SA(0, 1), cA + hstep, voffA);
        if (wr == 1) PG8_BAR;
        PG8_WAIT_V(4); PG8_BAR;
        PG8_STAGE(PG8_SB(1, 0), cB + kstep, voffB); PG8_STAGE(PG8_SA(1, 0), cA + kstep, voffA); PG8_STAGE(PG8_SB(1, 1), cB + hstep + kstep, voffB);
        PG8_WAIT_V(6); PG8_BAR;
    }
    for (;;) {
        const bool has_next = S.next(ui + 1, nxt);
        const char* nA = has_next ? (const char*)g.A + (size_t)nxt.pm * tstep : cA; const char* nB = has_next ? (const char*)g.Bt + (size_t)nxt.pn * tstep : cB;
        for (int t = 0; t < nt; t += 2) {
            const bool last = (t == nt - 2);
            const char* a1 = cA + (size_t)(t + 1) * kstep;
            const char* a2 = last ? nA : cA + (size_t)(t + 2) * kstep; const char* b2 = last ? nB : cB + (size_t)(t + 2) * kstep;
            const char* a3 = a2 + kstep; const char* b3 = b2 + kstep;
            if (last && has_next) S.a_ready(nxt);
            if constexpr (SP2) {
            PG8_LDB(B0, 0, 0); PG8_LDB(B1, 0, 1); PG8_SCHED; PG8_LDA(At, 0, 0); PG8_STAGE(PG8_SA(1, 1), a1 + hstep, voffA);
            PG8_WAIT_V(8); PG8_WAIT_L(0); PG8_BAR; PG8_MMA(0, 0, At, B0); PG8_MMA(0, 1, At, B1); PG8_BAR; PG8_SCHED;
            PG8_LDA(At, 0, 1); PG8_STAGE(PG8_SB(0, 0), b2, voffB); PG8_STAGE(PG8_SB(0, 1), b2 + hstep, voffB); PG8_STAGE(PG8_SA(0, 0), a2, voffA);
            PG8_WAIT_V(8); PG8_WAIT_L(0); PG8_BAR; PG8_MMA(1, 0, At, B0); PG8_MMA(1, 1, At, B1); PG8_BAR; PG8_SCHED;
            PG8_LDB(B0, 1, 0); PG8_LDB(B1, 1, 1); PG8_SCHED; PG8_LDA(At, 1, 0); PG8_STAGE(PG8_SA(0, 1), a2 + hstep, voffA);
            PG8_WAIT_V(8); PG8_WAIT_L(0); PG8_BAR; PG8_MMA(0, 0, At, B0); PG8_MMA(0, 1, At, B1); PG8_BAR; PG8_SCHED;
            PG8_LDA(At, 1, 1); PG8_STAGE(PG8_SB(1, 0), b3, voffB); PG8_STAGE(PG8_SB(1, 1), b3 + hstep, voffB); PG8_STAGE(PG8_SA(1, 0), a3, voffA);
            PG8_WAIT_V(8); PG8_WAIT_L(0); PG8_BAR; PG8_MMA(1, 0, At, B0); PG8_MMA(1, 1, At, B1); PG8_BAR; PG8_SCHED;
            } else {
            PG8_LDB(B0, 0, 0); PG8_SCHED; PG8_LDA(At, 0, 0); PG8_STAGE(PG8_SA(1, 1), a1 + hstep, voffA);
            PG8_WAIT_L(8); PG8_BAR; PG8_WAIT_L(0); PG8_MMA(0, 0, At, B0); PG8_BAR; PG8_SCHED;
            PG8_LDB(B1, 0, 1); PG8_STAGE(PG8_SB(0, 0), b2, voffB);
            PG8_BAR; PG8_WAIT_L(0); PG8_MMA(0, 1, At, B1); PG8_BAR;
            PG8_LDA(At, 0, 1); PG8_STAGE(PG8_SA(0, 0), a2, voffA);
            PG8_BAR; PG8_WAIT_L(0); PG8_MMA(1, 0, At, B0); PG8_BAR; PG8_SCHED;
            PG8_STAGE(PG8_SB(0, 1), b2 + hstep, voffB);
            PG8_WAIT_V(6); PG8_BAR; PG8_MMA(1, 1, At, B1); PG8_BAR;
            PG8_LDB(B0, 1, 0); PG8_SCHED; PG8_LDA(At, 1, 0); PG8_STAGE(PG8_SA(0, 1), a2 + hstep, voffA);
            PG8_WAIT_L(8); PG8_BAR; PG8_WAIT_L(0); PG8_MMA(0, 0, At, B0); PG8_BAR; PG8_SCHED;
            PG8_LDB(B1, 1, 1); PG8_STAGE(PG8_SB(1, 0), b3, voffB);
            PG8_BAR; PG8_WAIT_L(0); PG8_MMA(0, 1, At, B1); PG8_BAR;
            PG8_LDA(At, 1, 1); PG8_STAGE(PG8_SA(1, 0), a3, voffA);
            PG8_BAR; PG8_WAIT_L(0); PG8_MMA(1, 0, At, B0); PG8_BAR; PG8_SCHED;
            PG8_STAGE(PG8_SB(1, 1), b3 + hstep, voffB);
            PG8_WAIT_V(6); PG8_BAR; PG8_MMA(1, 1, At, B1); PG8_BAR;
            }
        }
        if constexpr (ALIGN_EPI) { if (wr == 0) PG8_BAR; }
        if constexpr (!Epi::AFTER_DRAIN) { E(acc, cur, wr, wc, fr, fq); S.done(cur); }
        if (!has_next) break;
#pragma unroll
        for (int a = 0; a < 2; ++a)
#pragma unroll
            for (int b = 0; b < 2; ++b)
#pragma unroll
                for (int m = 0; m < 4; ++m)
#pragma unroll
                    for (int n = 0; n < 2; ++n) acc[a][b][m][n] = (f32x4){0.f, 0.f, 0.f, 0.f};
        cur = nxt; cA = nA; cB = nB; ++ui;
        if constexpr (ALIGN_EPI) { if (wr == 1) PG8_BAR; }
    }
    PG8_WAIT_V(0);
    if constexpr (!ALIGN_EPI) { if (wr == 0) PG8_BAR; }
    PG8_BAR;
    if constexpr (Epi::AFTER_DRAIN) { E.fused(acc, cur, wr, wc, fr, fq, lds, wid, lane); S.done(cur); }
#undef PG8_SA
#undef PG8_SB
#undef PG8_STAGE
#undef PG8_LDA
#undef PG8_LDB
#undef PG8_MMA
#undef PG8_WAIT_V
#undef PG8_WAIT_L
#undef PG8_BAR
#undef PG8_SCHED
}
}

template <class E, bool NSW = false> struct Pg8Epi { static constexpr bool PERM = !NSW, AFTER_DRAIN = false, NSWAP = NSW; E e;
    __device__ __forceinline__ void operator()(f32x4 (&acc)[2][2][4][2], const pg8::Unit& u, int, int, int, int) const { e(acc, u.pm, u.pn); } };
template <class Epi, bool NSW = false>
__device__ __forceinline__ void gemm_run2(LAS uchar* lds, const bf16_t* A, const bf16_t* Bt, int nM, int nN, int K, const Epi& E) {
    pg8::Gemm g{A, Bt, nM * 256, nN * 256, K}; pg8::StaticOrder S; S.init(nM * 256, nN * 256, ogdim(), obid());
    Pg8Epi<Epi, NSW> PE{E};
    pg8::gemm_phase<Pg8Epi<Epi, NSW>, pg8::StaticOrder, true, true>(lds, g, S, PE);
}
#define EPI_LOOP _Pragma("unroll") for (int ai = 0; ai < 2; ++ai) _Pragma("unroll") for (int m = 0; m < 4; ++m) _Pragma("unroll") for (int bj = 0; bj < 2; ++bj) _Pragma("unroll") for (int n = 0; n < 2; ++n)
#define EPI_FENCE do { if (bj == 1 && n == 1) asm volatile("" ::: "memory"); } while (0)

#define EPI2_LOOP _Pragma("unroll") for (int ai = 0; ai < 2; ++ai) _Pragma("unroll") for (int m = 0; m < 4; ++m) _Pragma("unroll") for (int bj = 0; bj < 2; ++bj)
#define EPI2_FENCE do { if (bj == 1) asm volatile("" ::: "memory"); } while (0)
__device__ __forceinline__ u32x4 pk8(f32x4 a, f32x4 b) { u32x4 w; w.x = pk2(a[0], a[1]); w.y = pk2(a[2], a[3]); w.z = pk2(b[0], b[1]); w.w = pk2(b[2], b[3]); return w; }
__device__ __forceinline__ u32x4 pkh8(f32x4 a, f32x4 b) { u32x4 w; w.x = pkh2(a[0], a[1]); w.y = pkh2(a[2], a[3]); w.z = pkh2(b[0], b[1]); w.w = pkh2(b[2], b[3]); return w; }
__device__ __forceinline__ f32x4 silu4(f32x4 v) { f32x4 s; s[0] = siluf(v[0]); s[1] = siluf(v[1]); s[2] = siluf(v[2]); s[3] = siluf(v[3]); return s; }
__device__ __forceinline__ f32x4 sigm4(f32x4 v) { f32x4 s; s[0] = sigm(v[0]); s[1] = sigm(v[1]); s[2] = sigm(v[2]); s[3] = sigm(v[3]); return s; }
__device__ __forceinline__ void unh8(u32x4 w, f32x4& a, f32x4& b) { a[0] = h2f(w.x & 0xffff); a[1] = h2f(w.x >> 16); a[2] = h2f(w.y & 0xffff); a[3] = h2f(w.y >> 16); b[0] = h2f(w.z & 0xffff); b[1] = h2f(w.z >> 16); b[2] = h2f(w.w & 0xffff); b[3] = h2f(w.w >> 16); }
__device__ __forceinline__ void unb8(u32x4 w, f32x4& a, f32x4& b) { a[0] = bf2f(w.x & 0xffff); a[1] = bf2f(w.x >> 16); a[2] = bf2f(w.y & 0xffff); a[3] = bf2f(w.y >> 16); b[0] = bf2f(w.z & 0xffff); b[1] = bf2f(w.z >> 16); b[2] = bf2f(w.w & 0xffff); b[3] = bf2f(w.w >> 16); }

struct EpiGU { bf16_t* hid;
    __device__ __forceinline__ void operator()(f32x4 (&acc)[2][2][4][2], int pm, int pn) const { COORDS
#pragma unroll
        for (int ai = 0; ai < 2; ++ai)
#pragma unroll
            for (int m = 0; m < 4; ++m) { const int r = pm * 256 + ai * 128 + wr * 64 + m * 16 + fr, cc = pn * 128 + wc * 32 + fq * 8;
                *(u32x4*)(hid + (size_t)r * FF + cc) = pk8(silu4(acc[ai][0][m][0]) * acc[ai][1][m][0], silu4(acc[ai][0][m][1]) * acc[ai][1][m][1]); } } };

struct EpiRes { float* h; const float* ada; float coef; const float* stats; const float* g; const float* bta; const float* hsrc;
    __device__ __forceinline__ void operator()(f32x4 (&acc)[2][2][4][2], int pm, int pn) const { COORDS
        const float* ap = ada + (size_t)(pm >> 5) * 9216;
        EPI2_LOOP { const int r = pm * 256 + ai * 128 + wr * 64 + m * 16 + fr, c = pn * 256 + bj * 128 + wc * 32 + fq * 8;
            const float mu = stats[2 * r], rs = stats[2 * r + 1]; float* hp = h + (size_t)r * DM + c; const float* sp = hsrc + (size_t)r * DM + c;
#pragma unroll
            for (int n = 0; n < 2; ++n) { const f32x4 gv = *(const f32x4*)(ap + c + 4 * n), gg = *(const f32x4*)(g + c + 4 * n), bb = *(const f32x4*)(bta + c + 4 * n), zv = *(const f32x4*)(sp + 4 * n);
                f32x4 z;
#pragma unroll
                for (int j = 0; j < 4; ++j) { const float hv = (zv[j] - mu) * rs * gg[j] + bb[j]; z[j] = DN_ALPHA * hv + coef * (1.f + gv[j]) * acc[ai][bj][m][n][j]; }
                *(f32x4*)(hp + 4 * n) = z; }
            EPI2_FENCE; } } };

struct EpiWin1 { bf16_t *hq, *hv, *sg, *cq, *ckv; unsigned short* zf; float* krraw;
    __device__ __forceinline__ void operator()(f32x4 (&acc)[2][2][4][2], int pm, int pn) const { COORDS
        const int kind = pn >> 2;
        EPI2_LOOP { const int r = pm * 256 + ai * 128 + wr * 64 + m * 16 + fr, c = pn * 256 + bj * 128 + wc * 32 + fq * 8; const f32x4 v0 = acc[ai][bj][m][0], v1 = acc[ai][bj][m][1];
            if (kind == 0) *(u32x4*)(hq + (size_t)r * DM + c) = pk8(silu4(v0), silu4(v1));
            else if (kind == 1) *(u32x4*)(zf + (size_t)r * DM + (c - 1024)) = pkh8(v0, v1);
            else if (kind == 2) *(u32x4*)(hv + (size_t)r * DM + (c - 2048)) = pk8(v0, v1);
            else if (kind == 3) *(u32x4*)(sg + (size_t)r * DM + (c - 3072)) = pk8(silu4(v0), silu4(v1));
            else { const int gc = c - 4096;
                if (gc < 384) *(u32x4*)(cq + (size_t)r * 384 + gc) = pk8(v0, v1);
                else if (gc < 640) *(u32x4*)(ckv + (size_t)r * 256 + (gc - 384)) = pk8(v0, v1);
                else if (gc < 704) { *(f32x4*)(krraw + (size_t)r * 64 + (gc - 640)) = v0; *(f32x4*)(krraw + (size_t)r * 64 + (gc - 640) + 4) = v1; } } } } };

struct EpiQ { bf16_t *qn, *qr; const float *rsq, *cosT, *sinT;
    __device__ __forceinline__ void operator()(f32x4 (&acc)[2][2][4][2], int pm, int pn) const { COORDS
#pragma unroll
        for (int ai = 0; ai < 2; ++ai)
#pragma unroll
            for (int m = 0; m < 4; ++m) { const int r = pm * 256 + ai * 128 + wr * 64 + m * 16 + fr; const float rs = rsq[r] * QSCALE;
                if (pn < 4) {
#pragma unroll
                    for (int bj = 0; bj < 2; ++bj) { const int c = pn * 256 + bj * 128 + wc * 32 + fq * 8; *(u32x4*)(qn + (size_t)r * DM + c) = pk8(acc[ai][bj][m][0] * rs, acc[ai][bj][m][1] * rs); }
                } else { const int cl = wc * 32 + fq * 8, hh = (pn - 4) * 4 + (cl >> 5), i = cl & 31;
                    f32x4 o1[2], o2[2];
#pragma unroll
                    for (int n = 0; n < 2; ++n) { const f32x4 x1 = acc[ai][0][m][n] * rs, x2 = acc[ai][1][m][n] * rs; const f32x4 cs = *(const f32x4*)(cosT + (size_t)r * 32 + i + 4 * n), sn = *(const f32x4*)(sinT + (size_t)r * 32 + i + 4 * n);
                        o1[n] = x1 * cs - x2 * sn; o2[n] = x1 * sn + x2 * cs; }
                    *(u32x4*)(qr + (size_t)r * 512 + hh * 64 + i) = pk8(o1[0], o1[1]); *(u32x4*)(qr + (size_t)r * 512 + hh * 64 + 32 + i) = pk8(o2[0], o2[1]);
                }
                asm volatile("" ::: "memory"); } } };

struct EpiKn { bf16_t* kn; const float* rskv;
    __device__ __forceinline__ void operator()(f32x4 (&acc)[2][2][4][2], int pm, int pn) const { COORDS
        EPI2_LOOP { const int r = pm * 256 + ai * 128 + wr * 64 + m * 16 + fr, c = pn * 256 + bj * 128 + wc * 32 + fq * 8; const float rs = rskv[r];
            *(u32x4*)(kn + (size_t)r * DM + c) = pk8(acc[ai][bj][m][0] * rs, acc[ai][bj][m][1] * rs); EPI2_FENCE; } } };

struct EpiV { bf16_t* vt; const float* rskv;
    __device__ __forceinline__ void operator()(f32x4 (&acc)[2][2][4][2], int pm, int pn) const { COORDS
        typedef unsigned u2_t __attribute__((ext_vector_type(2)));
        const int odd = fq & 1;
        EPI2_LOOP { const int r0 = pm * 256 + ai * 128 + wr * 64 + m * 16 + fq * 4;
            const f32x4 rs = *(const f32x4*)(rskv + r0);
            const u32x2 x = pk4(acc[ai][bj][m][0] * rs), y = pk4(acc[ai][bj][m][1] * rs);
            const u2_t sa = __builtin_amdgcn_permlane16_swap(x.x, y.x, false, false);
            const u2_t sb = __builtin_amdgcn_permlane16_swap(x.y, y.y, false, false);
            u32x4 w; if (odd) { w.x = sa[0]; w.y = sb[0]; w.z = sa[1]; w.w = sb[1]; } else { w.x = sa[0]; w.y = sb[0]; w.z = sa[1]; w.w = sb[1]; }
            const int cv = pn * 256 + bj * 128 + wc * 32 + odd * 16 + fr, rr = r0 - odd * 4;
            const int b = rr >> 13, sx = rr & 8191, hh = cv >> 7, e = cv & 127;
            *(u32x4*)(vt + (((size_t)((b * 8 + hh) * 128 + e)) << 13) + sx) = w; EPI2_FENCE; } } };

struct EpiGate { unsigned short *sga, *sgb;
    __device__ __forceinline__ void operator()(f32x4 (&acc)[2][2][4][2], int pm, int pn) const { COORDS
        unsigned short* dst = pn < 4 ? sga : sgb;
        EPI2_LOOP { const int r = pm * 256 + ai * 128 + wr * 64 + m * 16 + fr, c = (pn & 3) * 256 + bj * 128 + wc * 32 + fq * 8;
            *(u32x4*)(dst + (size_t)r * DM + c) = pkh8(sigm4(acc[ai][bj][m][0]), sigm4(acc[ai][bj][m][1])); } } };

struct EpiM1 { bf16_t* m1; const unsigned short* sga;
    __device__ __forceinline__ void operator()(f32x4 (&acc)[2][2][4][2], int pm, int pn) const { COORDS
        EPI2_LOOP { const int r = pm * 256 + ai * 128 + wr * 64 + m * 16 + fr, c = pn * 256 + bj * 128 + wc * 32 + fq * 8;
            f32x4 s0, s1; unh8(*(const u32x4*)(sga + (size_t)r * DM + c), s0, s1);
            *(u32x4*)(m1 + (size_t)r * DM + c) = pk8(acc[ai][bj][m][0] * s0, acc[ai][bj][m][1] * s1); EPI2_FENCE; } } };
struct EpiM2 { const bf16_t* m1; const unsigned short* sgb; bf16_t* merged;
    __device__ __forceinline__ void operator()(f32x4 (&acc)[2][2][4][2], int pm, int pn) const { COORDS
        EPI2_LOOP { const int r = pm * 256 + ai * 128 + wr * 64 + m * 16 + fr, c = pn * 256 + bj * 128 + wc * 32 + fq * 8;
            f32x4 s0, s1, m0, m1v; unh8(*(const u32x4*)(sgb + (size_t)r * DM + c), s0, s1); unb8(*(const u32x4*)(m1 + (size_t)r * DM + c), m0, m1v);
            *(u32x4*)(merged + (size_t)r * DM + c) = pk8(m0 + acc[ai][bj][m][0] * s0, m1v + acc[ai][bj][m][1] * s1); EPI2_FENCE; } } };

struct ConvDesc { const float* src0; const float* src1; const float* kscale; int K, Ns; bf16_t* dst; int kind, item; };
__device__ __forceinline__ void conv_load(const ConvDesc& d, int tid, float (&v)[8]) {
    const int nkt = d.K / 64; const int kt = d.item % nkt, ntile = d.item / nkt; const int k0 = kt * 64, n0 = ntile * 64;
    const int tn = tid & 63, np = n0 + tn; const float* s = d.src0; int col = np;
    if (d.kind == 1) { const int tile = np >> 8, bj = (np >> 7) & 1, cc = np & 127; s = bj ? d.src1 : d.src0; col = tile * 128 + cc; }
    else if (d.kind == 2) { if (np < 1024) col = (np >> 7) * 192 + (np & 127); else { const int r = np - 1024, t2 = r >> 8, bj = (r >> 7) & 1, cc = r & 127, hh = t2 * 4 + (cc >> 5), i = cc & 31; col = hh * 192 + 128 + bj * 32 + i; } }
    else if (d.kind == 3) { if (np < 1024) col = (np >> 7) * 256 + (np & 127); else { const int r = np - 1024; col = (r >> 7) * 256 + 128 + (r & 127); } }
#pragma unroll
    for (int i = 0; i < 8; ++i) { const int kk = (tid >> 6) + 8 * i; float x = s[(size_t)(k0 + kk) * d.Ns + col]; if (d.kscale) x *= d.kscale[k0 + kk]; v[i] = x; }
}
__device__ __forceinline__ void conv_store(LAS uchar* lds, const ConvDesc& d, int tid, const float (&v)[8]) {
    LAS float* tl = (LAS float*)lds;
    const int nkt = d.K / 64; const int kt = d.item % nkt, ntile = d.item / nkt; const int k0 = kt * 64, n0 = ntile * 64;
    { const int tn = tid & 63;
#pragma unroll
      for (int i = 0; i < 8; ++i) tl[tn * 65 + (tid >> 6) + 8 * i] = v[i]; }
    __syncthreads();
    { const int n = tid >> 3, kc = tid & 7; const LAS float* rp = tl + n * 65 + kc * 8; u32x4 w; w.x = pk2(rp[0], rp[1]); w.y = pk2(rp[2], rp[3]); w.z = pk2(rp[4], rp[5]); w.w = pk2(rp[6], rp[7]);
      *(u32x4*)(d.dst + (size_t)(n0 + n) * d.K + k0 + kc * 8) = w; }
    __syncthreads();
}
__device__ __forceinline__ ConvDesc conv_desc(const Params& p, int l, int it) {
    bf16_t* W = (bf16_t*)(p.ws + OFF_W + (size_t)(l & 1) * WSZ);
    constexpr int I_GU = 16 * 88, I_D = 44 * 16, I_IN = 16 * 107, I_UQ = 6 * 24, I_UKV = 4 * 32, I_SQ = 256;
    const size_t o_ff = (size_t)l * DM * FF; int r = it;
    if (r < I_GU) return ConvDesc{p.f1g + o_ff, p.f1u + o_ff, nullptr, DM, FF, W + W_GU1, 1, r}; r -= I_GU;
    if (r < I_D) return ConvDesc{p.f1d + o_ff, nullptr, nullptr, FF, DM, W + W_D1, 0, r}; r -= I_D;
    if (r < I_IN) return ConvDesc{p.w_in + (size_t)l * DM * 6848, nullptr, nullptr, DM, 6848, W + W_IN, 0, r}; r -= I_IN;
    if (r < I_UQ) return ConvDesc{p.w_uq + (size_t)l * 384 * 1536, nullptr, p.qng + l * 384, 384, 1536, W + W_UQ, 2, r}; r -= I_UQ;
    if (r < I_UKV) return ConvDesc{p.w_ukv + (size_t)l * 256 * 2048, nullptr, p.kvng + l * 256, 256, 2048, W + W_UKV, 3, r}; r -= I_UKV;
    if (r < I_SQ) return ConvDesc{p.w_bh + (size_t)l * DM * DM, nullptr, nullptr, DM, DM, W + W_BH, 0, r}; r -= I_SQ;
    if (r < I_SQ) return ConvDesc{p.w_bm + (size_t)l * DM * DM, nullptr, nullptr, DM, DM, W + W_BM, 0, r}; r -= I_SQ;
    if (r < I_SQ) return ConvDesc{p.w_out + (size_t)l * DM * DM, nullptr, nullptr, DM, DM, W + W_OUT, 0, r}; r -= I_SQ;
    if (r < I_GU) return ConvDesc{p.f2g + o_ff, p.f2u + o_ff, nullptr, DM, FF, W + W_GU2, 1, r}; r -= I_GU;
    return ConvDesc{p.f2d + o_ff, nullptr, nullptr, FF, DM, W + W_D2, 0, r};
}
__device__ void conv_layer(LAS uchar* lds, const Params& p, int l, int start, int stride) {
    constexpr int TOT = 2 * 16 * 88 + 2 * 44 * 16 + 16 * 107 + 6 * 24 + 4 * 32 + 3 * 256;
    const int tid = otid();
    float v[8], vn[8];
    if (start < TOT) { const ConvDesc d = conv_desc(p, l, start); conv_load(d, tid, v); }
    for (int it = start; it < TOT; it += stride) {
        const ConvDesc d = conv_desc(p, l, it);
        if (it + stride < TOT) { const ConvDesc dn = conv_desc(p, l, it + stride); conv_load(dn, tid, vn); }
        conv_store(lds, d, tid, v);
#pragma unroll
        for (int i = 0; i < 8; ++i) v[i] = vn[i];
    }
}

__device__ void p0a(LAS uchar* lds, const Params& p) {
    const int tid = otid(), G = ogdim();
    float* ADA = (float*)(p.ws + OFF_ADA);
    LAS float* red = (LAS float*)lds;
    LAS float* cond = red + 2048;
    for (int i = tid; i < 4096; i += NTHR) cond[i] = siluf(p.c[i]);
    __syncthreads();
    for (int it = obid(); it < NL * 144; it += G) {
        const int l = it / 144, cg0 = (it % 144) * 64, cn = tid & 63, kp = tid >> 6;
        const float* w = p.ada_w + (size_t)l * DM * 9216 + cg0 + cn;
        float a0 = 0.f, a1 = 0.f, a2 = 0.f, a3 = 0.f;
        for (int k = kp * 128; k < kp * 128 + 128; ++k) { const float wv = w[(size_t)k * 9216];
            a0 += cond[k] * wv; a1 += cond[1024 + k] * wv; a2 += cond[2048 + k] * wv; a3 += cond[3072 + k] * wv; }
        red[(kp * 4 + 0) * 64 + cn] = a0; red[(kp * 4 + 1) * 64 + cn] = a1; red[(kp * 4 + 2) * 64 + cn] = a2; red[(kp * 4 + 3) * 64 + cn] = a3;
        __syncthreads();
        if (tid < 256) { const int b = tid >> 6; float s = 0.f;
#pragma unroll
            for (int q = 0; q < 8; ++q) s += red[(q * 4 + b) * 64 + cn];
            ADA[(size_t)(l * 4 + b) * 9216 + cg0 + cn] = s + p.ada_b[(size_t)l * 9216 + cg0 + cn]; }
        __syncthreads();
    }
    float* COS = (float*)(p.ws + OFF_COS); float* SIN = (float*)(p.ws + OFF_SIN);
    for (int e = obid() * NTHR + tid; e < T * 32; e += G * NTHR) {
        const int tok = e >> 5, i = e & 31; double inv = 1.0, rr = 0.7498942093324558; int n = i;
        while (n) { if (n & 1) inv *= rr; rr *= rr; n >>= 1; }
        const double ang = (double)p.pos[tok] * inv; const double kq = __builtin_rint(ang * 0.15915494309189535);
        double r = ang - kq * 6.283185307179586 - kq * 2.4492935982947064e-16; const double r2 = r * r;
        double sn, cs;
        { double t = 1.0;
#pragma unroll
          for (int q = 27; q >= 3; q -= 2) t = 1.0 - t * r2 * (1.0 / (double)(q * (q - 1))); sn = t * r; }
        { double t = 1.0;
#pragma unroll
          for (int q = 26; q >= 2; q -= 2) t = 1.0 - t * r2 * (1.0 / (double)(q * (q - 1))); cs = t; }
        COS[e] = (float)cs; SIN[e] = (float)sn;
    }
    { float* onz = (float*)(p.ws + OFF_ONES); for (int ch = obid() * NTHR + tid; ch < 2048; ch += G * NTHR) onz[ch] = ch < 1024 ? 1.f : 0.f; }
    float* LBT = (float*)(p.ws + OFF_LBT);
    for (int ch = obid() * NTHR + tid; ch < 1024; ch += G * NTHR) {
        const float v0 = p.hg_lb[ch], v1 = p.hg_lb[1024 + ch], v2 = p.hg_lb[2048 + ch], v3 = p.hg_lb[3072 + ch];
        const float mx = fmaxf(fmaxf(v0, v1), fmaxf(v2, v3)); const float e0 = expf(v0 - mx), e1 = expf(v1 - mx), e2 = expf(v2 - mx), e3 = expf(v3 - mx); const float inv = 1.f / (e0 + e1 + e2 + e3);
        float lw[4]; lw[0] = 0.f; lw[1] = e1 * inv; lw[2] = (e1 + e2) * inv; lw[3] = (e1 + e2 + e3) * inv;
#pragma unroll
        for (int l = 0; l < 4; ++l) { const float lb = lw[l]; LBT[(l * 3 + 0) * 1024 + ch] = fmaxf(lb, 1e-30f); LBT[(l * 3 + 1) * 1024 + ch] = log1pf(-lb); LBT[(l * 3 + 2) * 1024 + ch] = 1.f - lb; }
    }
}

__device__ void ln_pass(const Params& p, const float* src, float* hdst, bf16_t* U, const float* g, const float* bta, const float* ada_l, int sc_idx, int sh_idx, bool donorm, bool writeU, bool writeH) {
    float* stats = (float*)(p.ws + OFF_STATS);
    const int tid = otid(), wid = tid >> 6, lane = tid & 63;
    for (int row = obid() * 8 + wid; row < T; row += ogdim() * 8) {
        const f32x4* xr = (const f32x4*)(src + (size_t)row * DM) + lane; f32x4 v[4]; float s = 0.f;
#pragma unroll
        for (int j = 0; j < 4; ++j) { v[j] = xr[64 * j]; s += (v[j][0] + v[j][1]) + (v[j][2] + v[j][3]); }
        if (donorm) {
#pragma unroll
            for (int o = 32; o > 0; o >>= 1) s += __shfl_xor(s, o);
            const float mean = s * (1.f / DM); float s2 = 0.f;
#pragma unroll
            for (int j = 0; j < 4; ++j) { v[j] = v[j] - mean; s2 += (v[j][0] * v[j][0] + v[j][1] * v[j][1]) + (v[j][2] * v[j][2] + v[j][3] * v[j][3]); }
#pragma unroll
            for (int o = 32; o > 0; o >>= 1) s2 += __shfl_xor(s2, o);
            const float rstd = 1.f / sqrtf(s2 * (1.f / DM) + 1e-5f);
            if (lane == 0) *(f32x2v*)(stats + 2 * row) = (f32x2v){mean, rstd};
#pragma unroll
            for (int j = 0; j < 4; ++j) { const f32x4 gg = *((const f32x4*)g + lane + 64 * j), bb = *((const f32x4*)bta + lane + 64 * j); v[j] = v[j] * rstd * gg + bb; }
        }
        else if (lane == 0) { const float zz = v[0][0] * 0.f; *(f32x2v*)(stats + 2 * row) = (f32x2v){zz, 1.f + zz}; }
        if (writeH) { f32x4* hr = (f32x4*)(hdst + (size_t)row * DM) + lane;
#pragma unroll
            for (int j = 0; j < 4; ++j) hr[64 * j] = v[j]; }
        if (writeU) { const float* ab = ada_l + (size_t)(row >> 13) * 9216; u32x2* ur = (u32x2*)(U + (size_t)row * DM) + lane;
#pragma unroll
            for (int j = 0; j < 4; ++j) { const f32x4 sc = *((const f32x4*)(ab + sc_idx * 1024) + lane + 64 * j), sh = *((const f32x4*)(ab + sh_idx * 1024) + lane + 64 * j); ur[64 * j] = pk4(v[j] * (1.f + sc) + sh); } }
    }
}

__device__ void ln_pass2(const Params& p, const float* src, float* outH, bf16_t* U, const float* g, const float* bta, const float* ada_l, int sc_idx, int sh_idx) {
    float* stats = (float*)(p.ws + OFF_STATS);
    const int tid = otid(), wid = tid >> 6, lane = tid & 63; const int rstep = ogdim() * 8, r0 = obid() * 8 + wid;
    for (int b = 0; b < 4; ++b) {
        f32x4 A[4], B[4];
#pragma unroll
        for (int j = 0; j < 4; ++j) { const f32x4 gg = *((const f32x4*)g + lane + 64 * j), bb = *((const f32x4*)bta + lane + 64 * j);
            if (outH) { A[j] = gg; B[j] = bb; }
            else { const float* ab = ada_l + (size_t)b * 9216; const f32x4 sc = *((const f32x4*)(ab + sc_idx * 1024) + lane + 64 * j), sh = *((const f32x4*)(ab + sh_idx * 1024) + lane + 64 * j); A[j] = gg * (1.f + sc); B[j] = bb * (1.f + sc) + sh; } }
        f32x4 v[4], vn[4];
        if (r0 < SEQ) {
#pragma unroll
            for (int j = 0; j < 4; ++j) v[j] = *((const f32x4*)(src + (size_t)(b * SEQ + r0) * DM) + lane + 64 * j); }
        for (int rr = r0; rr < SEQ; rr += rstep) {
            const int row = b * SEQ + rr;
            if (rr + rstep < SEQ) {
#pragma unroll
                for (int j = 0; j < 4; ++j) vn[j] = *((const f32x4*)(src + (size_t)(row + rstep) * DM) + lane + 64 * j); }
            float s = 0.f;
#pragma unroll
            for (int j = 0; j < 4; ++j) s += (v[j][0] + v[j][1]) + (v[j][2] + v[j][3]);
#pragma unroll
            for (int o = 32; o > 0; o >>= 1) s += __shfl_xor(s, o);
            const float mean = s * (1.f / DM); float s2 = 0.f;
#pragma unroll
            for (int j = 0; j < 4; ++j) { v[j] = v[j] - mean; s2 += (v[j][0] * v[j][0] + v[j][1] * v[j][1]) + (v[j][2] * v[j][2] + v[j][3] * v[j][3]); }
#pragma unroll
            for (int o = 32; o > 0; o >>= 1) s2 += __shfl_xor(s2, o);
            const float rstd = 1.f / sqrtf(s2 * (1.f / DM) + 1e-5f);
            if (lane == 0) *(f32x2v*)(stats + 2 * row) = (f32x2v){mean, rstd};
            if (outH) { f32x4* hr = (f32x4*)(outH + (size_t)row * DM) + lane;
#pragma unroll
                for (int j = 0; j < 4; ++j) hr[64 * j] = v[j] * rstd * A[j] + B[j]; }
            else { u32x2* ur = (u32x2*)(U + (size_t)row * DM) + lane;
#pragma unroll
                for (int j = 0; j < 4; ++j) ur[64 * j] = pk4(v[j] * rstd * A[j] + B[j]); }
#pragma unroll
            for (int j = 0; j < 4; ++j) v[j] = vn[j];
        }
    }
}

__device__ void tok_pass(const Params& p) {
    const int tid = otid(), wid = tid >> 6, lane = tid & 63;
    const bf16_t* CQ = (const bf16_t*)(p.ws + OFF_CQ); const bf16_t* CKV = (const bf16_t*)(p.ws + OFF_CKV);
    const float* KRRAW = (const float*)(p.ws + OFF_KRRAW); bf16_t* KR = (bf16_t*)(p.ws + OFF_KR);
    const float* COS = (const float*)(p.ws + OFF_COS); const float* SIN = (const float*)(p.ws + OFF_SIN);
    float* RSQ = (float*)(p.ws + OFF_RSQ); float* RSKV = (float*)(p.ws + OFF_RSKV);
    const int step = ogdim() * 8, t0 = obid() * 8 + wid; const int l31 = lane & 31;
    unsigned qw[3], qn[3]; u32x2 kw, kn2; float x1, x2, cs, sn, x1n, x2n, csn, snn;
#define TOK_LOAD(tok_, Q_, K_, X1_, X2_, C_, S_) do { const unsigned* q_ = (const unsigned*)(CQ + (size_t)(tok_) * 384) + lane * 3; Q_[0] = q_[0]; Q_[1] = q_[1]; Q_[2] = q_[2]; K_ = *((const u32x2*)(CKV + (size_t)(tok_) * 256) + lane); \
        X1_ = KRRAW[(size_t)(tok_) * 64 + l31]; X2_ = KRRAW[(size_t)(tok_) * 64 + 32 + l31]; C_ = COS[(size_t)(tok_) * 32 + l31]; S_ = SIN[(size_t)(tok_) * 32 + l31]; } while (0)
    if (t0 < T) TOK_LOAD(t0, qw, kw, x1, x2, cs, sn);
    for (int tok = t0; tok < T; tok += step) {
        if (tok + step < T) TOK_LOAD(tok + step, qn, kn2, x1n, x2n, csn, snn);
        float s = 0.f;
#pragma unroll
        for (int j = 0; j < 3; ++j) { const float a = bf2f(qw[j] & 0xffff), b = bf2f(qw[j] >> 16); s += a * a + b * b; }
        float s2; { const float a = bf2f(kw.x & 0xffff), b = bf2f(kw.x >> 16), c = bf2f(kw.y & 0xffff), d = bf2f(kw.y >> 16); s2 = a * a + b * b + c * c + d * d; }
#pragma unroll
        for (int o = 32; o > 0; o >>= 1) { s += __shfl_xor(s, o); s2 += __shfl_xor(s2, o); }
        if (lane == 0) { RSQ[tok] = 1.f / sqrtf(s * (1.f / 384.f) + 1e-6f); RSKV[tok] = 1.f / sqrtf(s2 * (1.f / 256.f) + 1e-6f); }
        if (lane < 32) { KR[(size_t)tok * 64 + lane] = f2bf(x1 * cs - x2 * sn); KR[(size_t)tok * 64 + 32 + lane] = f2bf(x1 * sn + x2 * cs); }
        qw[0] = qn[0]; qw[1] = qn[1]; qw[2] = qn[2]; kw = kn2; x1 = x1n; x2 = x2n; cs = csn; sn = snn;
    }
#undef TOK_LOAD
}

__device__ __forceinline__ void gate2(float z, float lbp, float oml, float& lf2, float& hk) {
    const float t = __builtin_amdgcn_exp2f(-fabsf(z) * 1.44269504f), r = __builtin_amdgcn_rcpf(1.f + t), sm = t * r;
    const float sz = z >= 0.f ? r : sm, snz = z >= 0.f ? sm : r;
    lf2 = __builtin_amdgcn_logf(lbp + oml * sz); hk = oml * snz;
}
constexpr int KT_STR = 72;
constexpr int TD_STR = 136;

__device__ void hg1_phase(LAS uchar* lds, const Params& p, int l) {
    COORDS
    const unsigned* ZF32 = (const unsigned*)(p.ws + OFF_R1); const unsigned* HV32 = (const unsigned*)(p.ws + OFF_R2);
    bf16_t* LS = (bf16_t*)(p.ws + OFF_R4); float* DEC = (float*)(p.ws + OFF_DEC); const float* LBT = (const float*)(p.ws + OFF_LBT) + (size_t)l * 3 * 1024;
    LAS bf16_t* Kt = (LAS bf16_t*)lds;
    LAS bf16_t* Vt = (LAS bf16_t*)(lds + 128 * KT_STR * 2);
    LAS float* tot = (LAS float*)(lds + 2 * 128 * KT_STR * 2);
    const int d2 = lane, part = wid;
    unsigned zr[8], vr[8];
    { const int unit = obid(); if (unit < 32 * 128) { const int chunk = unit & 127, bh = unit >> 7, b = bh >> 3, hh = bh & 7; const size_t t0 = (size_t)b * SEQ + chunk * 64 + part * 8;
#pragma unroll
        for (int i = 0; i < 8; ++i) { zr[i] = ZF32[(t0 + i) * 512 + hh * 64 + d2]; vr[i] = HV32[(t0 + i) * 512 + hh * 64 + d2]; } } }
    for (int unit = obid(); unit < 32 * 128; unit += ogdim()) {
        const int bh = unit >> 7, hh = bh & 7;
        const f32x2v lbp = *(const f32x2v*)(LBT + hh * 128 + 2 * d2), oml = *(const f32x2v*)(LBT + 2048 + hh * 128 + 2 * d2);
        unsigned zn[8], vn[8];
        { const int nu = unit + ogdim(); if (nu < 32 * 128) { const int chunk = nu & 127, bh2 = nu >> 7, b = bh2 >> 3, h2 = bh2 & 7; const size_t t0 = (size_t)b * SEQ + chunk * 64 + part * 8;
#pragma unroll
            for (int i = 0; i < 8; ++i) { zn[i] = ZF32[(t0 + i) * 512 + h2 * 64 + d2]; vn[i] = HV32[(t0 + i) * 512 + h2 * 64 + d2]; } } }
        float g0[8], g1[8], k0[8], k1[8]; float run0 = 0.f, run1 = 0.f;
#pragma unroll
        for (int i = 0; i < 8; ++i) { float lf; gate2(h2f(zr[i] & 0xffff), lbp[0], oml[0], lf, k0[i]); run0 += lf; g0[i] = run0; gate2(h2f(zr[i] >> 16), lbp[1], oml[1], lf, k1[i]); run1 += lf; g1[i] = run1; }
        *(LAS f32x2v*)(tot + part * 128 + 2 * d2) = (f32x2v){run0, run1};
        __syncthreads();
        float off0 = 0.f, off1 = 0.f, gc0 = 0.f, gc1 = 0.f;
#pragma unroll
        for (int q = 0; q < 8; ++q) { const f32x2v tq = *(const LAS f32x2v*)(tot + q * 128 + 2 * d2); gc0 += tq[0]; gc1 += tq[1]; if (q < part) { off0 += tq[0]; off1 += tq[1]; } }
        u32x4 kw0, kw1, vw0, vw1;
#pragma unroll
        for (int j = 0; j < 4; ++j) {
            kw0[j] = pk2(k0[2 * j] * __builtin_amdgcn_exp2f(gc0 - (off0 + g0[2 * j])), k0[2 * j + 1] * __builtin_amdgcn_exp2f(gc0 - (off0 + g0[2 * j + 1])));
            kw1[j] = pk2(k1[2 * j] * __builtin_amdgcn_exp2f(gc1 - (off1 + g1[2 * j])), k1[2 * j + 1] * __builtin_amdgcn_exp2f(gc1 - (off1 + g1[2 * j + 1])));
            vw0[j] = (vr[2 * j] & 0xffffu) | (vr[2 * j + 1] << 16); vw1[j] = (vr[2 * j] >> 16) | (vr[2 * j + 1] & 0xffff0000u); }
        *(LAS u32x4*)(Kt + (2 * d2) * KT_STR + part * 8) = kw0; *(LAS u32x4*)(Kt + (2 * d2 + 1) * KT_STR + part * 8) = kw1;
        *(LAS u32x4*)(Vt + (2 * d2) * KT_STR + part * 8) = vw0; *(LAS u32x4*)(Vt + (2 * d2 + 1) * KT_STR + part * 8) = vw1;
        if (part == 0) *(f32x2v*)(DEC + (size_t)unit * 128 + 2 * d2) = (f32x2v){__builtin_amdgcn_exp2f(gc0), __builtin_amdgcn_exp2f(gc1)};
        __syncthreads();
        bf16x8 vb[2];
#pragma unroll
        for (int ks = 0; ks < 2; ++ks) vb[ks] = *(const LAS bf16x8*)(Vt + (wid * 16 + fr) * KT_STR + ks * 32 + fq * 8);
        bf16_t* lsu = LS + (size_t)unit * 16384;
#pragma unroll
        for (int g = 0; g < 4; ++g) { f32x4 a0 = {0.f, 0.f, 0.f, 0.f}, a1 = {0.f, 0.f, 0.f, 0.f};
            const int rowb = 32 * g + 8 * (fr >> 2) + (fr & 3);
#pragma unroll
            for (int ks = 0; ks < 2; ++ks) { const bf16x8 k0f = *(const LAS bf16x8*)(Kt + rowb * KT_STR + ks * 32 + fq * 8), k1f = *(const LAS bf16x8*)(Kt + (rowb + 4) * KT_STR + ks * 32 + fq * 8);
                a0 = __builtin_amdgcn_mfma_f32_16x16x32_bf16(k0f, vb[ks], a0, 0, 0, 0); a1 = __builtin_amdgcn_mfma_f32_16x16x32_bf16(k1f, vb[ks], a1, 0, 0, 0); }
            *(u32x4*)(lsu + (size_t)(wid * 16 + fr) * 128 + 32 * g + 8 * fq) = pk8(a0, a1); }
        __syncthreads();
#pragma unroll
        for (int i = 0; i < 8; ++i) { zr[i] = zn[i]; vr[i] = vn[i]; }
    }
}

__device__ void hg2_phase(const Params& p) {
    bf16_t* LS = (bf16_t*)(p.ws + OFF_R4); const float* DEC = (const float*)(p.ws + OFF_DEC);
    for (int gid = obid() * NTHR + otid(); gid < 32 * 4096; gid += ogdim() * NTHR) {
        const int bh = gid >> 12, e4 = (gid & 4095) * 4, dk = e4 & 127;
        f32x4 S = {0.f, 0.f, 0.f, 0.f};
        for (int c0 = 0; c0 < 128; c0 += 8) {
            u32x2 lw[8]; f32x4 dc[8];
#pragma unroll
            for (int q = 0; q < 8; ++q) { lw[q] = *(const u32x2*)(LS + ((size_t)(bh * 128 + c0 + q) << 14) + e4); dc[q] = *(const f32x4*)(DEC + (size_t)(bh * 128 + c0 + q) * 128 + dk); }
#pragma unroll
            for (int q = 0; q < 8; ++q) { *(u32x2*)(LS + ((size_t)(bh * 128 + c0 + q) << 14) + e4) = pk4(S);
                f32x4 L; L[0] = bf2f(lw[q].x & 0xffff); L[1] = bf2f(lw[q].x >> 16); L[2] = bf2f(lw[q].y & 0xffff); L[3] = bf2f(lw[q].y >> 16);
                S = dc[q] * S + L; }
        }
    }
}

__device__ void hg3_phase(LAS uchar* lds, const Params& p, int l) {
    COORDS
    bf16_t* HQ = (bf16_t*)(p.ws + OFF_R0); const unsigned* HQ32 = (const unsigned*)(p.ws + OFF_R0); const unsigned* ZF32 = (const unsigned*)(p.ws + OFF_R1); const unsigned* HV32 = (const unsigned*)(p.ws + OFF_R2);
    const bf16_t* SG = (const bf16_t*)(p.ws + OFF_R3); const bf16_t* LS = (const bf16_t*)(p.ws + OFF_R4); const float* LBT = (const float*)(p.ws + OFF_LBT) + (size_t)l * 3 * 1024;
    const float* ng = p.hg_ng + (size_t)l * 1024;
    LAS bf16_t* Qt = (LAS bf16_t*)lds;
    LAS bf16_t* Qh = Qt + 64 * TD_STR;
    LAS bf16_t* Kp = Qh + 64 * TD_STR;
    LAS bf16_t* Vt = Kp + 64 * TD_STR;
    LAS bf16_t* Sb = Vt + 128 * KT_STR;
    LAS float* tot = (LAS float*)(Sb + 128 * TD_STR);
    LAS float* ssq = tot + 1024;
    const int d2 = lane, part = wid;
    unsigned zr[8], vr[8], qr[8]; u32x4 sbr[4];
#define HG3_LOAD(U_, Z_, V_, Q_, S_) do { const int chunk_ = (U_) & 127, bh_ = (U_) >> 7, b_ = bh_ >> 3, h_ = bh_ & 7; const size_t t0_ = (size_t)b_ * SEQ + chunk_ * 64 + part * 8; \
        _Pragma("unroll") for (int i_ = 0; i_ < 8; ++i_) { Z_[i_] = ZF32[(t0_ + i_) * 512 + h_ * 64 + d2]; V_[i_] = HV32[(t0_ + i_) * 512 + h_ * 64 + d2]; Q_[i_] = HQ32[(t0_ + i_) * 512 + h_ * 64 + d2]; } \
        const bf16_t* lsu_ = LS + (size_t)(U_) * 16384; _Pragma("unroll") for (int i_ = 0; i_ < 4; ++i_) { const int cid_ = tid + i_ * NTHR; S_[i_] = *(const u32x4*)(lsu_ + (cid_ >> 4) * 128 + (cid_ & 15) * 8); } } while (0)
    if (obid() < 32 * 128) HG3_LOAD(obid(), zr, vr, qr, sbr);
    for (int unit = obid(); unit < 32 * 128; unit += ogdim()) {
        const int chunk = unit & 127, bh = unit >> 7, b = bh >> 3, hh = bh & 7;
        const f32x2v lbp = *(const f32x2v*)(LBT + hh * 128 + 2 * d2), oml = *(const f32x2v*)(LBT + 2048 + hh * 128 + 2 * d2);
        const size_t tokc = (size_t)b * SEQ + chunk * 64;
        { u32x4 vw0, vw1;
#pragma unroll
          for (int j = 0; j < 4; ++j) { vw0[j] = (vr[2 * j] & 0xffffu) | (vr[2 * j + 1] << 16); vw1[j] = (vr[2 * j] >> 16) | (vr[2 * j + 1] & 0xffff0000u); }
          *(LAS u32x4*)(Vt + (2 * d2) * KT_STR + part * 8) = vw0; *(LAS u32x4*)(Vt + (2 * d2 + 1) * KT_STR + part * 8) = vw1;
#pragma unroll
          for (int i = 0; i < 4; ++i) { const int cid = tid + i * NTHR; *(LAS u32x4*)(Sb + (cid >> 4) * TD_STR + (cid & 15) * 8) = sbr[i]; } }
        float g0[8], g1[8], k0[8], k1[8]; float run0 = 0.f, run1 = 0.f;
#pragma unroll
        for (int i = 0; i < 8; ++i) { float lf; gate2(h2f(zr[i] & 0xffff), lbp[0], oml[0], lf, k0[i]); run0 += lf; g0[i] = run0; gate2(h2f(zr[i] >> 16), lbp[1], oml[1], lf, k1[i]); run1 += lf; g1[i] = run1; }
        *(LAS f32x2v*)(tot + part * 128 + 2 * d2) = (f32x2v){run0, run1};
        unsigned qc[8];
#pragma unroll
        for (int i = 0; i < 8; ++i) qc[i] = qr[i];
        const int tb = wid & 3, eh = wid >> 2;
        const size_t trow = (tokc + tb * 16 + fr) * DM + hh * 128;
        u32x2 sgw[4];
#pragma unroll
        for (int mt = 0; mt < 4; ++mt) sgw[mt] = *(const u32x2*)(SG + trow + eh * 64 + mt * 16 + fq * 4);
        { const int nu = unit + ogdim(); if (nu < 32 * 128) HG3_LOAD(nu, zr, vr, qr, sbr); }
        __syncthreads();
        float off0 = 0.f, off1 = 0.f, gr0 = 0.f, gr1 = 0.f;
#pragma unroll
        for (int q = 0; q < 8; ++q) { const f32x2v tq = *(const LAS f32x2v*)(tot + q * 128 + 2 * d2); if (q < 4) { gr0 += tq[0]; gr1 += tq[1]; } if (q < part) { off0 += tq[0]; off1 += tq[1]; } }
#pragma unroll
        for (int i = 0; i < 8; ++i) { const float G0 = off0 + g0[i], G1 = off1 + g1[i]; const float q0 = bf2f(qc[i] & 0xffff), q1 = bf2f(qc[i] >> 16); const int t = part * 8 + i;
            *(LAS unsigned*)(Qt + t * TD_STR + 2 * d2) = pk2(q0 * __builtin_amdgcn_exp2f(fminf(G0 - gr0, 115.f)), q1 * __builtin_amdgcn_exp2f(fminf(G1 - gr1, 115.f)));
            *(LAS unsigned*)(Qh + t * TD_STR + 2 * d2) = pk2(q0 * __builtin_amdgcn_exp2f(G0), q1 * __builtin_amdgcn_exp2f(G1));
            *(LAS unsigned*)(Kp + t * TD_STR + 2 * d2) = pk2(k0[i] * __builtin_amdgcn_exp2f(fminf(gr0 - G0, 115.f)), k1[i] * __builtin_amdgcn_exp2f(fminf(gr1 - G1, 115.f))); }
        __syncthreads();
        f32x4 sc[4];
#pragma unroll
        for (int sb = 0; sb < 4; ++sb) { sc[sb] = (f32x4){0.f, 0.f, 0.f, 0.f};
            if (sb <= tb) {
#pragma unroll
                for (int ks = 0; ks < 4; ++ks) { const bf16x8 ka = *(const LAS bf16x8*)(Kp + (sb * 16 + fr) * TD_STR + ks * 32 + fq * 8), qb = *(const LAS bf16x8*)(Qt + (tb * 16 + fr) * TD_STR + ks * 32 + fq * 8);
                    sc[sb] = __builtin_amdgcn_mfma_f32_16x16x32_bf16(ka, qb, sc[sb], 0, 0, 0); }
                if (sb == tb) {
#pragma unroll
                    for (int j = 0; j < 4; ++j) if (fq * 4 + j > fr) sc[sb][j] = 0.f; } } }
        f32x4 o[4];
#pragma unroll
        for (int mt = 0; mt < 4; ++mt) o[mt] = (f32x4){0.f, 0.f, 0.f, 0.f};
#pragma unroll
        for (int ks = 0; ks < 2; ++ks) { union { bf16x8 v; u32x4 u; } pf; pf.u.x = pk2(sc[2 * ks][0], sc[2 * ks][1]); pf.u.y = pk2(sc[2 * ks][2], sc[2 * ks][3]); pf.u.z = pk2(sc[2 * ks + 1][0], sc[2 * ks + 1][1]); pf.u.w = pk2(sc[2 * ks + 1][2], sc[2 * ks + 1][3]);
            if (2 * ks <= tb) {
#pragma unroll
                for (int mt = 0; mt < 4; ++mt) { const int e = eh * 64 + mt * 16 + fr; union { bf16x8 v; u32x2 h[2]; } vf; vf.h[0] = *(const LAS u32x2*)(Vt + e * KT_STR + (2 * ks) * 16 + fq * 4); vf.h[1] = *(const LAS u32x2*)(Vt + e * KT_STR + (2 * ks + 1) * 16 + fq * 4);
                    o[mt] = __builtin_amdgcn_mfma_f32_16x16x32_bf16(vf.v, pf.v, o[mt], 0, 0, 0); } } }
#pragma unroll
        for (int ks = 0; ks < 4; ++ks) { const bf16x8 qb = *(const LAS bf16x8*)(Qh + (tb * 16 + fr) * TD_STR + ks * 32 + fq * 8);
#pragma unroll
            for (int mt = 0; mt < 4; ++mt) { const bf16x8 sa = *(const LAS bf16x8*)(Sb + (eh * 64 + mt * 16 + fr) * TD_STR + ks * 32 + fq * 8); o[mt] = __builtin_amdgcn_mfma_f32_16x16x32_bf16(sa, qb, o[mt], 0, 0, 0); } }
        float ss = 0.f;
#pragma unroll
        for (int mt = 0; mt < 4; ++mt) ss += (o[mt][0] * o[mt][0] + o[mt][1] * o[mt][1]) + (o[mt][2] * o[mt][2] + o[mt][3] * o[mt][3]);
        ss += __shfl_xor(ss, 16); ss += __shfl_xor(ss, 32);
        if (fq == 0) ssq[eh * 64 + tb * 16 + fr] = ss;
        __syncthreads();
        const float rstd = 1.f / sqrtf((ssq[tb * 16 + fr] + ssq[64 + tb * 16 + fr]) * (1.f / 128.f) + 1e-6f);
#pragma unroll
        for (int mt = 0; mt < 4; ++mt) { const int e = eh * 64 + mt * 16 + fq * 4; const f32x4 gg = *(const f32x4*)(ng + hh * 128 + e); const u32x2 sw = sgw[mt];
            f32x4 r; r[0] = o[mt][0] * rstd * gg[0] * bf2f(sw.x & 0xffff); r[1] = o[mt][1] * rstd * gg[1] * bf2f(sw.x >> 16); r[2] = o[mt][2] * rstd * gg[2] * bf2f(sw.y & 0xffff); r[3] = o[mt][3] * rstd * gg[3] * bf2f(sw.y >> 16);
            *(u32x2*)(HQ + trow + e) = pk4(r); }
        __syncthreads();
    }
#undef HG3_LOAD
}

constexpr float ATT_THR = 6.0f;
constexpr int AK_STR = 400, AV_STR = 144;
constexpr int AK_BYTES = 64 * AK_STR, AV_BYTES = 128 * AV_STR;
__device__ void attn_phase(LAS uchar* lds, const Params& p, bf16_t* obuf) {
    const int tid = otid(), wid = __builtin_amdgcn_readfirstlane(tid >> 6), lane = tid & 63, l32 = lane & 31, half = lane >> 5;
    bf16_t* QN = (bf16_t*)(p.ws + OFF_R1); const bf16_t* QR = (const bf16_t*)(p.ws + OFF_R5); const bf16_t* KN = (const bf16_t*)(p.ws + OFF_R2);
    const bf16_t* VT = (const bf16_t*)(p.ws + OFF_R3); const bf16_t* KR = (const bf16_t*)(p.ws + OFF_KR);
    for (int vb = obid(); vb < 256; vb += ogdim()) {
        const int vid = (vb & 7) * 32 + (vb >> 3);
        const int bh = vid >> 3, jj = vid & 7, b = bh >> 3, hh = bh & 7;
        for (int ui = 0; ui < 4; ++ui) {
            const int qb = ui == 0 ? 31 - jj : (ui == 1 ? 16 + jj : (ui == 2 ? 15 - jj : jj));
            const int q0 = qb * 256, ntiles = 4 * (qb + 1), wlast = 4 * qb + (wid >> 1);
            const size_t tokb = (size_t)b * SEQ; const int qrow = q0 + wid * 32 + l32;
            bf16x8 Q[12];
            { const bf16_t* qn = QN + (tokb + qrow) * DM + hh * 128; const bf16_t* qr = QR + (tokb + qrow) * 512 + hh * 64;
#pragma unroll
              for (int s = 0; s < 8; ++s) Q[s] = *(const bf16x8*)(qn + s * 16 + half * 8);
#pragma unroll
              for (int s = 0; s < 4; ++s) Q[8 + s] = *(const bf16x8*)(qr + s * 16 + half * 8); }
            f32x16 O[4];
#pragma unroll
            for (int mb = 0; mb < 4; ++mb)
#pragma unroll
                for (int i = 0; i < 16; ++i) O[mb][i] = 0.f;
            float mrun = 0.f, lrun = 0.f;
            u32x4 kreg[3], vreg[2];
            const bf16_t* vtb = VT + ((size_t)(bh * 128) << 13);
            const int akey = tid >> 3, ac8 = tid & 7;
            const unsigned koff = (unsigned)(akey * DM + ac8 * 8) * 2u, roff = (unsigned)(akey * 64 + ac8 * 8) * 2u, voff = (unsigned)((akey << 13) + ac8 * 8) * 2u;
            const int kdst = akey * AK_STR + ac8 * 16, vdst = akey * AV_STR + (ac8 >> 1) * 32 + (ac8 & 1) * 8;
#define ALOAD(kt_) do { const int kb_ = (kt_) * 64; const char* kbp = (const char*)(KN + (tokb + kb_) * DM + hh * 128); const char* rbp = (const char*)(KR + (tokb + kb_) * 64); const char* vbp2 = (const char*)(vtb + kb_); \
              kreg[0] = *(const u32x4*)(kbp + koff); kreg[1] = *(const u32x4*)(kbp + koff + 128); kreg[2] = *(const u32x4*)(rbp + roff); \
              vreg[0] = *(const u32x4*)(vbp2 + voff); vreg[1] = *(const u32x4*)(vbp2 + voff + (64u << 14)); } while (0)
#define ASTORE(buf_) do { LAS uchar* kb2 = lds + (buf_) * (AK_BYTES + AV_BYTES); LAS uchar* vb2 = kb2 + AK_BYTES; *(LAS u32x4*)(kb2 + kdst) = kreg[0]; *(LAS u32x4*)(kb2 + kdst + 128) = kreg[1]; *(LAS u32x4*)(kb2 + kdst + 256) = kreg[2]; \
              _Pragma("unroll") for (int i_ = 0; i_ < 2; ++i_) { *(LAS u32x2*)(vb2 + vdst + i_ * 64 * AV_STR) = (u32x2){vreg[i_].x, vreg[i_].y}; *(LAS u32x2*)(vb2 + vdst + i_ * 64 * AV_STR + 16) = (u32x2){vreg[i_].z, vreg[i_].w}; } } while (0)
            __syncthreads();
            ALOAD(0); ASTORE(0);
            __syncthreads();
            for (int kt = 0; kt < ntiles; ++kt) {
                const int cur = kt & 1;
                if (kt + 1 < ntiles) ALOAD(kt + 1);
                if (kt <= wlast) {
                    const LAS uchar* kb = lds + cur * (AK_BYTES + AV_BYTES); const LAS uchar* vbp = kb + AK_BYTES;
                    f32x16 s0, s1;
#pragma unroll
                    for (int i = 0; i < 16; ++i) { s0[i] = -mrun; s1[i] = -mrun; }
                    {
                        bf16x8 ka[2][2];
                        const LAS uchar* kp0 = kb + l32 * AK_STR + half * 16; const LAS uchar* kp1 = kp0 + 32 * AK_STR;
                        ka[0][0] = *(const LAS bf16x8*)kp0; ka[0][1] = *(const LAS bf16x8*)kp1;
#pragma unroll
                        for (int st = 0; st < 12; ++st) { if (st + 1 < 12) { ka[(st + 1) & 1][0] = *(const LAS bf16x8*)(kp0 + (st + 1) * 32); ka[(st + 1) & 1][1] = *(const LAS bf16x8*)(kp1 + (st + 1) * 32); }
                            __builtin_amdgcn_sched_barrier(0); __builtin_amdgcn_s_setprio(1);
                            s0 = __builtin_amdgcn_mfma_f32_32x32x16_bf16(ka[st & 1][0], Q[st], s0, 0, 0, 0); s1 = __builtin_amdgcn_mfma_f32_32x32x16_bf16(ka[st & 1][1], Q[st], s1, 0, 0, 0);
                            __builtin_amdgcn_s_setprio(0); __builtin_amdgcn_sched_barrier(0); }
                    }
                    if (kt == wlast) { asm volatile("" ::: "memory");
                        const int kbase = kt * 64 + half * 4;
#pragma unroll
                        for (int i = 0; i < 16; ++i) { const int key = kbase + (i >> 2) * 8 + (i & 3); if (key > qrow) s0[i] = -1e30f; if (key + 32 > qrow) s1[i] = -1e30f; } }
                    float mx = s0[0];
#pragma unroll
                    for (int i = 1; i < 16; ++i) mx = fmaxf(mx, s0[i]);
#pragma unroll
                    for (int i = 0; i < 16; ++i) mx = fmaxf(mx, s1[i]);
                    {
                      typedef unsigned u2_t __attribute__((ext_vector_type(2)));
                      const u2_t sw = __builtin_amdgcn_permlane32_swap(__float_as_uint(mx), __float_as_uint(mx), false, false);
                      mx = fmaxf(__uint_as_float(sw[0]), __uint_as_float(sw[1])); }
                    const float dm = fmaxf(mx, 0.f);
                    if (__builtin_amdgcn_ballot_w64(dm > ATT_THR) != 0ull) { const float alpha = __builtin_amdgcn_exp2f(-dm); lrun *= alpha; mrun += dm;
#pragma unroll
                        for (int i = 0; i < 16; ++i) { s0[i] -= dm; s1[i] -= dm; }
#pragma unroll
                        for (int mb = 0; mb < 4; ++mb)
#pragma unroll
                            for (int i = 0; i < 16; ++i) O[mb][i] *= alpha; }
                    float ps = 0.f;
#pragma unroll
                    for (int i = 0; i < 16; ++i) { s0[i] = __builtin_amdgcn_exp2f(s0[i]); s1[i] = __builtin_amdgcn_exp2f(s1[i]); ps += s0[i] + s1[i]; }
                    lrun += ps;
                    {
                        union VF { bf16x8 v; u32x2 h[2]; }; VF vfr[2][2];
                        const LAS uchar* vp0 = vbp + l32 * AV_STR + half * 16;
#define VLOADG(gi_, b_) do { _Pragma("unroll") for (int q_ = 0; q_ < 2; ++q_) { const LAS uchar* vp_ = vp0 + (((gi_) & 1) * 2 + q_) * 32 * AV_STR + ((gi_) >> 1) * 32; vfr[b_][q_].v = *(const LAS bf16x8*)vp_; } } while (0)
                        VLOADG(0, 0);
                        union { bf16x8 v; u32x4 u; } pf;
#pragma unroll
                        for (int gi = 0; gi < 8; ++gi) { const int ks = gi >> 1; if (gi + 1 < 8) VLOADG(gi + 1, (gi + 1) & 1);
                            if ((gi & 1) == 0) {
                                if (ks == 0) { pf.u.x = pk2(s0[0], s0[1]); pf.u.y = pk2(s0[2], s0[3]); pf.u.z = pk2(s0[4], s0[5]); pf.u.w = pk2(s0[6], s0[7]); }
                                else if (ks == 1) { pf.u.x = pk2(s0[8], s0[9]); pf.u.y = pk2(s0[10], s0[11]); pf.u.z = pk2(s0[12], s0[13]); pf.u.w = pk2(s0[14], s0[15]); }
                                else if (ks == 2) { pf.u.x = pk2(s1[0], s1[1]); pf.u.y = pk2(s1[2], s1[3]); pf.u.z = pk2(s1[4], s1[5]); pf.u.w = pk2(s1[6], s1[7]); }
                                else { pf.u.x = pk2(s1[8], s1[9]); pf.u.y = pk2(s1[10], s1[11]); pf.u.z = pk2(s1[12], s1[13]); pf.u.w = pk2(s1[14], s1[15]); } }
                            __builtin_amdgcn_sched_barrier(0); __builtin_amdgcn_s_setprio(1);
                            O[(gi & 1) * 2] = __builtin_amdgcn_mfma_f32_32x32x16_bf16(vfr[gi & 1][0].v, pf.v, O[(gi & 1) * 2], 0, 0, 0);
                            O[(gi & 1) * 2 + 1] = __builtin_amdgcn_mfma_f32_32x32x16_bf16(vfr[gi & 1][1].v, pf.v, O[(gi & 1) * 2 + 1], 0, 0, 0);
                            __builtin_amdgcn_s_setprio(0); __builtin_amdgcn_sched_barrier(0); }
#undef VLOADG
                    }
                }
                if (kt + 1 < ntiles) ASTORE(cur ^ 1);
                __syncthreads();
            }
            const float ltot = lrun + __shfl_xor(lrun, 32); const float inv = 1.f / ltot;
            bf16_t* op = obuf + (tokb + qrow) * DM + hh * 128;
#pragma unroll
            for (int mb = 0; mb < 4; ++mb)
#pragma unroll
                for (int g4 = 0; g4 < 4; ++g4) { f32x4 v; v[0] = O[mb][g4 * 4] * inv; v[1] = O[mb][g4 * 4 + 1] * inv; v[2] = O[mb][g4 * 4 + 2] * inv; v[3] = O[mb][g4 * 4 + 3] * inv;
                    *(u32x2*)(op + mb * 32 + g4 * 8 + half * 4) = pk4(v); }
        }
    }
#undef ALOAD
#undef ASTORE
}


#ifdef DIAGSCAN
__global__ void diag_scan_k(float* out, const uchar* ws, unsigned* flagw) {
    const size_t gtid = (size_t)obid() * blockDim.x + threadIdx.x, gsz = (size_t)ogdim() * blockDim.x;
    const unsigned short* ZF = (const unsigned short*)(ws + OFF_R1); const bf16_t* HVb = (const bf16_t*)(ws + OFF_R2); const bf16_t* LSb = (const bf16_t*)(ws + OFF_R4); const float* LBT = (const float*)(ws + OFF_LBT);
    float me = 0.f, mr = 0.f;
    for (size_t i = gtid; i < 16384; i += gsz) { const int unit = (int)((i * 7919) % 4096), dv = (int)((i * 31) % 128), dk = (int)((i * 17) % 128);
        const int chunk = unit & 127, bh = unit >> 7, b = bh >> 3, hh = bh & 7; const float la = LBT[hh * 128 + dk], lc = LBT[1024 + hh * 128 + dk], oml = LBT[2048 + hh * 128 + dk];
        const size_t tok0 = (size_t)b * SEQ + chunk * 64; float gcv = 0.f;
        for (int t = 0; t < 64; ++t) gcv += logf_gate(h2f(ZF[(tok0 + t) * DM + hh * 128 + dk]), la, lc);
        float G = 0.f, acc = 0.f;
        for (int t = 0; t < 64; ++t) { const float z = h2f(ZF[(tok0 + t) * DM + hh * 128 + dk]); G += logf_gate(z, la, lc); const float kt = oml / (1.f + __expf(z)) * __expf(gcv - G);
            acc += kt * __uint_as_float((unsigned)HVb[(tok0 + t) * DM + hh * 128 + dv] << 16); }
        const float got = __uint_as_float((unsigned)LSb[(size_t)unit * 16384 + dv * 128 + dk] << 16); me = fmaxf(me, fabsf(got - acc)); mr = fmaxf(mr, fabsf(acc)); }
    atomicMax(flagw + 2, __float_as_uint(me)); atomicMax(flagw + 3, __float_as_uint(mr));
}
__global__ void diag_fin_k(float* out, const unsigned* flagw) {
    const size_t gtid = (size_t)obid() * blockDim.x + threadIdx.x, gsz = (size_t)ogdim() * blockDim.x;
    const float mev = __uint_as_float(flagw[2]), mxv = __uint_as_float(flagw[3]);
    const float A = 10.f + fminf(89.f, fmaxf(0.f, rintf(log2f(fmaxf(mev, 1e-6f)) + 20.f)));
    const int k = (int)fminf(15.f, fmaxf(0.f, floorf(log2f(fmaxf(mxv, 1e-3f))) + 5.f));
    float c = 10.f; for (int i = 0; i < k; ++i) c *= 1.3f;
    const float mn = 0.f;
    (void)mn;
    for (size_t i = gtid; i < (size_t)T * DM; i += gsz) out[i] = (i == 0) ? A * 1e4f : c;
}
#endif
#define XB_TMO      128
#define XB_XCNT(j)  (256  + 64 * (j))
#define XB_XSUB(j)  (1280 + 64 * (j))
#define XB_XGEN(j)  (2304 + 64 * (j))
#define XB_TOP      3328
#define XB_TOPGEN   3392
#define XCD_BAR_WORDS 3456
#define XB_SPIN_CAP (1u << 18)

__device__ __forceinline__ unsigned xb_ld(unsigned* p)              { return __hip_atomic_load(p, __ATOMIC_RELAXED, __HIP_MEMORY_SCOPE_AGENT); }
__device__ __forceinline__ unsigned xb_add(unsigned* p, unsigned v) { return __hip_atomic_fetch_add(p, v, __ATOMIC_RELAXED, __HIP_MEMORY_SCOPE_AGENT); }
__device__ __forceinline__ unsigned xb_xcc_id() { return (unsigned)__builtin_amdgcn_s_getreg((3 << 11) | 20) & 0xFu; }
#define XB_SPIN(cond, bar) do { unsigned _sp = 0; while (cond) { __builtin_amdgcn_s_sleep(1); \
    if ((++_sp & 255u) == 0u) { if (xb_ld(&(bar)[XB_TMO])) break; if (_sp > XB_SPIN_CAP) { atomicAdd(&(bar)[XB_TMO], 1u); break; } } } } while (0)

struct XcdBarrier {
    unsigned* bar; unsigned x;
    volatile LAS unsigned* st;
};

__device__ __forceinline__ XcdBarrier xcd_barrier_post(unsigned* bar, volatile LAS unsigned* st) {
    XcdBarrier b; b.bar = bar; b.x = xb_xcc_id(); b.st = st;
    if (threadIdx.x == 0) (void)xb_add(&bar[XB_XCNT(b.x)], 1u);
    return b;
}
__device__ __forceinline__ void xcd_barrier_complete(unsigned* bar, unsigned x, unsigned& nloc, unsigned& nx) {
    const unsigned G = ogdim() * gridDim.y * gridDim.z;
    unsigned sum, cnt, mine, sp = 0u;
    for (;;) {
        sum = 0u; cnt = 0u; mine = 0u;
#pragma unroll
        for (unsigned j = 0; j < 16; ++j) { const unsigned c = xb_ld(&bar[XB_XCNT(j)]); sum += c; cnt += (c > 0u) ? 1u : 0u; mine = (j == x) ? c : mine; }
        if (sum == G) break;
        __builtin_amdgcn_s_sleep(1);
        if ((++sp & 255u) == 0u) { if (xb_ld(&bar[XB_TMO])) break; if (sp > XB_SPIN_CAP) { atomicAdd(&bar[XB_TMO], 1u); break; } }
    }
    nloc = mine > 0u ? mine : 1u; nx = cnt > 0u ? cnt : 1u;
}

__device__ __forceinline__ void xcd_barrier(const XcdBarrier& b) {
    asm volatile("s_waitcnt vmcnt(0)" ::: "memory");
    __syncthreads();
    if (threadIdx.x == 0) {
        unsigned* bar = b.bar;
        __builtin_amdgcn_s_waitcnt(0);
        unsigned nloc = b.st[0], nx = b.st[1];
        if (nloc == 0u) { xcd_barrier_complete(bar, b.x, nloc, nx); b.st[0] = nloc; b.st[1] = nx; }
        const unsigned old = xb_add(&bar[XB_XSUB(b.x)], 1u);
        const unsigned gen = old / nloc;
        if (old + 1u == (gen + 1u) * nloc) {
            __builtin_amdgcn_fence(__ATOMIC_RELEASE, "agent");
            asm volatile("s_waitcnt vmcnt(0)" ::: "memory");
            const unsigned og = xb_add(&bar[XB_TOP], 1u);
            const unsigned tg = og / nx;
            if (og + 1u == (tg + 1u) * nx) xb_add(&bar[XB_TOPGEN], 1u);
            else XB_SPIN(xb_ld(&bar[XB_TOPGEN]) == tg, bar);
            __builtin_amdgcn_fence(__ATOMIC_ACQUIRE, "agent");
            xb_add(&bar[XB_XGEN(b.x)], 1u);
            asm volatile("s_waitcnt vmcnt(0)" ::: "memory");
        } else {
            XB_SPIN(xb_ld(&bar[XB_XGEN(b.x)]) == gen, bar);
            __builtin_amdgcn_fence(__ATOMIC_ACQUIRE, "agent");
            asm volatile("s_waitcnt vmcnt(0)" ::: "memory");
        }
    }
    __syncthreads();
}

constexpr int LDS_BYTES = 8 * HTB + 64;
constexpr size_t OFF_BAR = OFF_LBT + 48 * 1024;
constexpr int NPHASE = 2 + 15 * NL;
#ifndef PH_HI
#define PH_HI NPHASE
#endif
#ifndef PH_MASK
#define PH_MASK 0x1FFFF
#endif

__global__ void __launch_bounds__(NTHR) mega(Params p_in) {
    extern __shared__ __attribute__((aligned(16))) uchar smem[];
    LAS uchar* lds = (LAS uchar*)smem;
    cg::grid_group grid = cg::this_grid();
    volatile LAS unsigned* xst = (volatile LAS unsigned*)(lds + 8 * HTB);
    if (threadIdx.x < 2) xst[threadIdx.x] = 0u;
    __syncthreads();
    (void)xcd_barrier_post((unsigned*)(p_in.ws + OFF_BAR), xst);
    const int nM = T / 256;
    for (int ph = p_in.ph_lo; ph < p_in.ph_hi; ++ph) {
        Params p = p_in; asm volatile("" : "+s"(p.ws), "+s"(p.out));
        uchar* ws = p.ws; float* ADA = (float*)(ws + OFF_ADA); bf16_t* U = (bf16_t*)(ws + OFF_U); bf16_t* HID = (bf16_t*)(ws + OFF_R0);
        if (ph == 0) { if constexpr (PH_MASK & 1) { p0a(lds, p); conv_layer(lds, p, 0, obid(), ogdim()); } }
        else if (ph == 1) { if constexpr (PH_MASK & 2) ln_pass(p, p.x, p.out, U, nullptr, nullptr, ADA, 1, 0, false, true, false); }
        else {
            const int l = (ph - 2) / 15, sub = (ph - 2) % 15;
            const bf16_t* W = (const bf16_t*)(ws + OFF_W + (size_t)(l & 1) * WSZ);
            const float* adal = ADA + (size_t)l * 4 * 9216;
            switch (sub) {
            case 0: if constexpr ((PH_MASK >> 2) & 1) { EpiGU E{HID}; gemm_run2<EpiGU>(lds, U, W + W_GU1, nM, 22, DM, E); } break;
            case 1: if constexpr ((PH_MASK >> 3) & 1) { const float* onz = (const float*)(ws + OFF_ONES); EpiRes E{p.out, adal + 2 * 1024, 0.5f, (const float*)(ws + OFF_STATS), l ? p.ln_g + (size_t)(l * 3 - 1) * DM : onz, l ? p.ln_b + (size_t)(l * 3 - 1) * DM : onz + 1024, l ? p.out : p.x}; gemm_run2<EpiRes>(lds, HID, W + W_D1, nM, 4, FF, E); } break;
            case 2: if constexpr ((PH_MASK >> 4) & 1) ln_pass2(p, p.out, nullptr, U, p.ln_g + (size_t)(l * 3 + 0) * DM, p.ln_b + (size_t)(l * 3 + 0) * DM, adal, 4, 3); break;
            case 3: if constexpr ((PH_MASK >> 5) & 1) { EpiWin1 E{(bf16_t*)(ws + OFF_R0), (bf16_t*)(ws + OFF_R2), (bf16_t*)(ws + OFF_R3), (bf16_t*)(ws + OFF_CQ), (bf16_t*)(ws + OFF_CKV), (unsigned short*)(ws + OFF_R1), (float*)(ws + OFF_KRRAW)};
                      gemm_run2<EpiWin1>(lds, U, W + W_IN, nM, 19, DM, E); } break;
            case 4: if constexpr ((PH_MASK >> 6) & 1) { hg1_phase(lds, p, l); tok_pass(p); } break;
            case 5: if constexpr ((PH_MASK >> 7) & 1) { hg2_phase(p); if (l + 1 < NL) conv_layer(lds, p, l + 1, obid(), ogdim()); } break;
            case 6: if constexpr ((PH_MASK >> 8) & 1) hg3_phase(lds, p, l); break;
            case 7: if constexpr ((PH_MASK >> 9) & 1) { EpiQ Eq{(bf16_t*)(ws + OFF_R1), (bf16_t*)(ws + OFF_R5), (const float*)(ws + OFF_RSQ), (const float*)(ws + OFF_COS), (const float*)(ws + OFF_SIN)};
                      gemm_run2<EpiQ>(lds, (const bf16_t*)(ws + OFF_CQ), W + W_UQ, nM, 6, 384, Eq);
                      EpiKn Ek{(bf16_t*)(ws + OFF_R2), (const float*)(ws + OFF_RSKV)};
                      gemm_run2<EpiKn>(lds, (const bf16_t*)(ws + OFF_CKV), W + W_UKV, nM, 4, 256, Ek);
                      EpiV Ev{(bf16_t*)(ws + OFF_R3), (const float*)(ws + OFF_RSKV)};
                      gemm_run2<EpiV, true>(lds, (const bf16_t*)(ws + OFF_CKV), W + W_UKV + (size_t)1024 * 256, nM, 4, 256, Ev);
                      EpiGate Eg{(unsigned short*)(ws + OFF_R4), (unsigned short*)(ws + OFF_R4 + 64 * MB)};
                      gemm_run2<EpiGate>(lds, U, W + W_IN + (size_t)4800 * DM, nM, 8, DM, Eg); } break;
            case 8: if constexpr ((PH_MASK >> 10) & 1) {
#ifdef ATTN_TWICE
                for (int rep = 0; rep < p.ph_lo + 2; ++rep) { attn_phase(lds, p, (bf16_t*)(ws + (rep == 0 ? OFF_U : OFF_R1))); __syncthreads(); }
#else
                attn_phase(lds, p, (bf16_t*)(ws + OFF_R1));
#endif
                } break;
            case 9: if constexpr ((PH_MASK >> 11) & 1) { EpiM1 E1{(bf16_t*)(ws + OFF_R5), (const unsigned short*)(ws + OFF_R4)};
                      gemm_run2<EpiM1>(lds, (const bf16_t*)(ws + OFF_R0), W + W_BH, nM, 4, DM, E1);
                      EpiM2 E2{(const bf16_t*)(ws + OFF_R5), (const unsigned short*)(ws + OFF_R4 + 64 * MB), U};
                      gemm_run2<EpiM2>(lds, (const bf16_t*)(ws + OFF_R1), W + W_BM, nM, 4, DM, E2); } break;
            case 10: if constexpr ((PH_MASK >> 12) & 1) { EpiRes E{p.out, adal + 5 * 1024, 1.0f, (const float*)(ws + OFF_STATS), p.ln_g + (size_t)(l * 3 + 0) * DM, p.ln_b + (size_t)(l * 3 + 0) * DM, p.out}; gemm_run2<EpiRes>(lds, U, W + W_OUT, nM, 4, DM, E); } break;
            case 11: if constexpr ((PH_MASK >> 13) & 1) ln_pass2(p, p.out, nullptr, U, p.ln_g + (size_t)(l * 3 + 1) * DM, p.ln_b + (size_t)(l * 3 + 1) * DM, adal, 7, 6); break;
            case 12: if constexpr ((PH_MASK >> 14) & 1) { EpiGU E{HID}; gemm_run2<EpiGU>(lds, U, W + W_GU2, nM, 22, DM, E); } break;
            case 13: if constexpr ((PH_MASK >> 15) & 1) { EpiRes E{p.out, adal + 8 * 1024, 0.5f, (const float*)(ws + OFF_STATS), p.ln_g + (size_t)(l * 3 + 1) * DM, p.ln_b + (size_t)(l * 3 + 1) * DM, p.out}; gemm_run2<EpiRes>(lds, HID, W + W_D2, nM, 4, FF, E); } break;
            default: if constexpr ((PH_MASK >> 16) & 1) ln_pass2(p, p.out, l + 1 == NL ? p.out : nullptr, U, p.ln_g + (size_t)(l * 3 + 2) * DM, p.ln_b + (size_t)(l * 3 + 2) * DM, adal + 4 * 9216, 1, 0); break;
            }
        }
        if (ph + 1 < p_in.ph_hi) { if (ph == p_in.ph_lo) grid.sync(); else { XcdBarrier xb2; xb2.bar = (unsigned*)(p.ws + OFF_BAR); xb2.x = xb_xcc_id(); xb2.st = (volatile LAS unsigned*)(lds + 8 * HTB); xcd_barrier(xb2); } }
    }
}

extern "C" void kernel_launch(void* const* d_in, const int* in_sizes, int n_in, void* d_out, int out_size, void* d_ws, size_t ws_size, hipStream_t stream) {
    static int grid = 0;
    if (grid == 0) {
        if (n_in != 23 || ws_size < WS_END) { fprintf(stderr, "kernel_launch: n_in %d ws %zu (need %zu)\n", n_in, ws_size, (size_t)WS_END); grid = -1; return; }
        int dev = 0, cus = 0, per_cu = 0;
        hipGetDevice(&dev); hipDeviceGetAttribute(&cus, hipDeviceAttributeMultiprocessorCount, dev);
        if (hipFuncSetAttribute((const void*)mega, hipFuncAttributeMaxDynamicSharedMemorySize, LDS_BYTES) != hipSuccess) { fprintf(stderr, "kernel_launch: hipFuncSetAttribute failed\n"); grid = -1; return; }
        hipOccupancyMaxActiveBlocksPerMultiprocessor(&per_cu, (const void*)mega, NTHR, LDS_BYTES);
        if (per_cu < 1) { fprintf(stderr, "kernel_launch: occupancy query says %d\n", per_cu); per_cu = 1; }
        (void)hipGetLastError();
        grid = cus;
    }
    if (grid < 0) return;
    Params p{};
    p.x = (const float*)d_in[0]; p.c = (const float*)d_in[1]; p.pos = (const int*)d_in[2];
    p.ada_w = (const float*)d_in[3]; p.ada_b = (const float*)d_in[4]; p.ln_g = (const float*)d_in[5]; p.ln_b = (const float*)d_in[6];
    p.f1g = (const float*)d_in[7]; p.f1u = (const float*)d_in[8]; p.f1d = (const float*)d_in[9]; p.w_in = (const float*)d_in[10];
    p.hg_lb = (const float*)d_in[11]; p.hg_ng = (const float*)d_in[12]; p.qng = (const float*)d_in[13]; p.w_uq = (const float*)d_in[14];
    p.kvng = (const float*)d_in[15]; p.w_ukv = (const float*)d_in[16]; p.w_bh = (const float*)d_in[17]; p.w_bm = (const float*)d_in[18];
    p.w_out = (const float*)d_in[19]; p.f2g = (const float*)d_in[20]; p.f2u = (const float*)d_in[21]; p.f2d = (const float*)d_in[22];
    p.out = (float*)d_out; p.ws = (uchar*)d_ws; p.ph_lo = 0; p.ph_hi = PH_HI;
    (void)hipMemsetAsync((uchar*)d_ws + OFF_BAR, 0, XCD_BAR_WORDS * 4, stream);
    void* args[] = {&p};
    hipError_t e = hipLaunchCooperativeKernel((const void*)mega, dim3(grid), dim3(NTHR), args, LDS_BYTES, stream);
    if (e != hipSuccess) fprintf(stderr, "cooperative launch failed: %s (grid %d)\n", hipGetErrorString(e), grid);
#ifdef DIAGSCAN
    unsigned* flagw = (unsigned*)((uchar*)d_ws + OFF_LBT + 60 * 1024);
    (void)hipMemsetAsync(flagw, 0, 64, stream);
    diag_scan_k<<<2048, 256, 0, stream>>>((float*)d_out, (const uchar*)d_ws, flagw);
    diag_fin_k<<<2048, 256, 0, stream>>>((float*)d_out, flagw);
#endif
}
```

```cpp
#include <hip/hip_runtime.h>
#include <hip/hip_cooperative_groups.h>
#include <cstdio>
#include <cstdint>
namespace cg = cooperative_groups;

#define LAS __attribute__((address_space(3)))
typedef unsigned short bf16_t;
typedef unsigned char uchar;
typedef short bf16x8 __attribute__((ext_vector_type(8)));
typedef float f32x4 __attribute__((ext_vector_type(4)));
typedef float f32x16 __attribute__((ext_vector_type(16)));
typedef unsigned u32x4 __attribute__((ext_vector_type(4)));
typedef unsigned u32x2 __attribute__((ext_vector_type(2)));
typedef float f32x2v __attribute__((ext_vector_type(2)));

constexpr int T = 32768, SEQ = 8192, DM = 1024, FF = 2816, NL = 4;
constexpr float DN_ALPHA = 1.681792830507429f;
constexpr float QSCALE = 0.10411754627697264f;
constexpr int NTHR = 512;

constexpr size_t MB = 1ull << 20;
constexpr size_t OFF_ADA = 0;
constexpr size_t OFF_COS = 1 * MB;
constexpr size_t OFF_SIN = OFF_COS + 4 * MB;
constexpr size_t OFF_LBT = OFF_SIN + 4 * MB;
constexpr size_t OFF_RSQ = OFF_LBT + 64 * 1024;
constexpr size_t OFF_RSKV = OFF_RSQ + 128 * 1024;
constexpr size_t OFF_DEC = OFF_RSKV + 128 * 1024;
constexpr size_t OFF_KRRAW = OFF_DEC + 2 * MB;
constexpr size_t OFF_KR = OFF_KRRAW + 8 * MB;
constexpr size_t OFF_W = OFF_KR + 4 * MB;
constexpr size_t WSZ = 57147392ull;
constexpr size_t W_GU1 = 0, W_D1 = 5767168, W_IN = 8650752, W_UQ = 15663104, W_UKV = 16252928, W_BH = 16777216, W_BM = 17825792,
                 W_OUT = 18874368, W_GU2 = 19922944, W_D2 = 25690112;
constexpr size_t OFF_U = OFF_W + 2 * WSZ;
constexpr size_t OFF_BIG = OFF_U + 64 * MB;
constexpr size_t OFF_R0 = OFF_BIG;
constexpr size_t OFF_R1 = OFF_R0 + 64 * MB;
constexpr size_t OFF_R2 = OFF_R1 + 64 * MB;
constexpr size_t OFF_R3 = OFF_R2 + 64 * MB;
constexpr size_t OFF_R4 = OFF_R3 + 64 * MB;
constexpr size_t OFF_R5 = OFF_R4 + 128 * MB;
constexpr size_t OFF_CQ = OFF_R5 + 32 * MB;
constexpr size_t OFF_CKV = OFF_CQ + 24 * MB;
constexpr size_t OFF_STATS = OFF_CKV + 16 * MB;
constexpr size_t OFF_ONES = OFF_STATS + 256 * 1024;
constexpr size_t WS_END = OFF_ONES + 8 * 1024;

struct Params {
    const float *x, *c; const int* pos;
    const float *ada_w, *ada_b, *ln_g, *ln_b, *f1g, *f1u, *f1d, *w_in, *hg_lb, *hg_ng, *qng, *w_uq, *kvng, *w_ukv, *w_bh, *w_bm, *w_out, *f2g, *f2u, *f2d;
    float* out; uchar* ws; int ph_lo, ph_hi;
};

#define DS0 OFF_R0
#define DM0 0x7f80u
#define DS1 OFF_R1
#define DM1 0x7c00u
#define DS2 OFF_R2
#define DM2 0x7f80u
#define DS3 OFF_R3
#define DM3 0x7f80u
#define DS4 OFF_R4
#define DM4 0x7f80u
#define DS5 (OFF_R4 + 64 * MB)
#define DM5 0x7f80u
typedef __bf16 bf16v2_t __attribute__((ext_vector_type(2)));
typedef float f32x2_t __attribute__((ext_vector_type(2)));
__device__ __forceinline__ unsigned pk2(float lo, float hi) { const f32x2_t v = {lo, hi}; const bf16v2_t r = __builtin_convertvector(v, bf16v2_t); return __builtin_bit_cast(unsigned, r); }
__device__ __forceinline__ bf16_t f2bf(float f) { return (bf16_t)(pk2(f, 0.f) & 0xffffu); }
__device__ __forceinline__ float bf2f(unsigned v) { return __uint_as_float(v << 16); }
__device__ __forceinline__ float sigm(float x) { return __builtin_amdgcn_rcpf(1.f + __expf(-x)); }
__device__ __forceinline__ float siluf(float x) { return x * sigm(x); }
__device__ __forceinline__ unsigned short f2h(float f) { _Float16 h = (_Float16)f; return __builtin_bit_cast(unsigned short, h); }
__device__ __forceinline__ float h2f(unsigned short v) { return (float)__builtin_bit_cast(_Float16, v); }
__device__ __forceinline__ unsigned pkh2(float lo, float hi) { return (unsigned)f2h(lo) | ((unsigned)f2h(hi) << 16); }
__device__ __forceinline__ u32x2 pk4(f32x4 v) { u32x2 w; w.x = pk2(v[0], v[1]); w.y = pk2(v[2], v[3]); return w; }

__device__ __forceinline__ int otid() { int w = __builtin_amdgcn_readfirstlane((int)(threadIdx.x >> 6)); asm volatile("" : "+s"(w)); int t = w * 64 + (int)__builtin_amdgcn_mbcnt_hi(~0u, __builtin_amdgcn_mbcnt_lo(~0u, 0u)); asm volatile("" : "+v"(t)); return t; }
__device__ __forceinline__ int obid() { int b = blockIdx.x; asm volatile("" : "+s"(b)); return b; }
__device__ __forceinline__ int ogdim() { int g = gridDim.x; asm volatile("" : "+s"(g)); return g; }
#define COORDS const int tid = otid(), wid = __builtin_amdgcn_readfirstlane(tid >> 6), lane = tid & 63, wr = wid >> 2, wc = wid & 3, fr = lane & 15, fq = lane >> 4; (void)lane; (void)wr; (void)wc; (void)fr; (void)fq;

constexpr int BK = 64, HALF = 128, HTB = HALF * BK * 2;
__device__ __forceinline__ int lds_byte(int r, int c) { const int st = (r >> 4) * 2 + (c >> 5), rr = r & 15, cc = c & 31, ob = rr * 64 + cc * 2; return st * 1024 + (ob ^ (((ob >> 9) & 1) << 5)); }
__device__ __forceinline__ void stage_rc(int b, int& R, int& C) { const int st = b / 1024, sb = b % 1024, swz = sb ^ (((sb >> 9) & 1) << 5); R = (st >> 1) * 16 + swz / 64; C = (st & 1) * 32 + (swz % 64) / 2; }

template <bool SWAP>
__device__ __forceinline__ void gemm_kloop(LAS uchar* lds, const char* cA, const char* cB, int K, f32x4 (&acc)[2][2][4][2]) {
    COORDS
    const int nt = K / BK;
    unsigned voff[2];
#pragma unroll
    for (int i = 0; i < 2; ++i) { int R, C; stage_rc(tid * 16 + i * 8192, R, C); voff[i] = (unsigned)(R * K + C) * 2u; }
    const size_t kstep = (size_t)(BK * 2), hstep = (size_t)HALF * K * 2;
    const unsigned ldsw = (unsigned)wid * 1024u;
    const int aoff = lds_byte(wr * 64 + fr, fq * 8), boff = lds_byte(wc * 32 + fr, fq * 8);
#define SA(b, h) (((b) * 2 + (h)) * HTB)
#define SB(b, h) ((4 + (b) * 2 + (h)) * HTB)
#define STAGE(bufoff, gbase) do { _Pragma("unroll") for (int _i = 0; _i < 2; ++_i) \
        __builtin_amdgcn_global_load_lds((const unsigned*)((const char*)(gbase) + voff[_i]), (LAS unsigned*)(lds + (bufoff) + ldsw + _i * 8192), 16, 0, 0); } while (0)
#define LDA(dst, b, h) do { _Pragma("unroll") for (int m = 0; m < 4; ++m) _Pragma("unroll") for (int k = 0; k < 2; ++k) dst[m][k] = *(const LAS bf16x8*)(lds + SA(b, h) + aoff + m * 2048 + k * 1024); } while (0)
#define LDB(dst, b, h) do { _Pragma("unroll") for (int n = 0; n < 2; ++n) _Pragma("unroll") for (int k = 0; k < 2; ++k) dst[n][k] = *(const LAS bf16x8*)(lds + SB(b, h) + boff + n * 2048 + k * 1024); } while (0)
#define MMA(ai, bj, At, Bt) do { __builtin_amdgcn_s_setprio(1); _Pragma("unroll") for (int m = 0; m < 4; ++m) _Pragma("unroll") for (int n = 0; n < 2; ++n) _Pragma("unroll") for (int k = 0; k < 2; ++k) \
        acc[ai][bj][m][n] = SWAP ? __builtin_amdgcn_mfma_f32_16x16x32_bf16(Bt[n][k], At[m][k], acc[ai][bj][m][n], 0, 0, 0) \
                                 : __builtin_amdgcn_mfma_f32_16x16x32_bf16(At[m][k], Bt[n][k], acc[ai][bj][m][n], 0, 0, 0); __builtin_amdgcn_s_setprio(0); } while (0)
#define WAIT_V(n) asm volatile("s_waitcnt vmcnt(" #n ")" ::: "memory")
#define WAIT_L(n) asm volatile("s_waitcnt lgkmcnt(" #n ")" ::: "memory")
#define BAR __builtin_amdgcn_s_barrier()
#define SCHED __builtin_amdgcn_sched_barrier(0)
    bf16x8 At[4][2], B0[2][2], B1[2][2];
    STAGE(SB(0, 0), cB); STAGE(SA(0, 0), cA); STAGE(SB(0, 1), cB + hstep); STAGE(SA(0, 1), cA + hstep);
    if (wr == 1) BAR;
    WAIT_V(4); BAR;
    STAGE(SB(1, 0), cB + kstep); STAGE(SA(1, 0), cA + kstep); STAGE(SB(1, 1), cB + hstep + kstep);
    WAIT_V(6); BAR;
    for (int t = 0; t < nt - 2; t += 2) {
        const char* a1 = cA + (size_t)(t + 1) * kstep;
        const char* a2 = cA + (size_t)(t + 2) * kstep; const char* b2 = cB + (size_t)(t + 2) * kstep;
        const char* a3 = a2 + kstep; const char* b3 = b2 + kstep;
        LDB(B0, 0, 0); SCHED; LDA(At, 0, 0); STAGE(SA(1, 1), a1 + hstep);
        WAIT_L(8); BAR; WAIT_L(0); MMA(0, 0, At, B0); BAR; SCHED;
        LDB(B1, 0, 1); STAGE(SB(0, 0), b2);
        BAR; WAIT_L(0); MMA(0, 1, At, B1); BAR;
        LDA(At, 0, 1); STAGE(SA(0, 0), a2);
        BAR; WAIT_L(0); MMA(1, 0, At, B0); BAR; SCHED;
        STAGE(SB(0, 1), b2 + hstep);
        WAIT_V(6); BAR; MMA(1, 1, At, B1); BAR;
        LDB(B0, 1, 0); SCHED; LDA(At, 1, 0); STAGE(SA(0, 1), a2 + hstep);
        WAIT_L(8); BAR; WAIT_L(0); MMA(0, 0, At, B0); BAR; SCHED;
        LDB(B1, 1, 1); STAGE(SB(1, 0), b3);
        BAR; WAIT_L(0); MMA(0, 1, At, B1); BAR;
        LDA(At, 1, 1); STAGE(SA(1, 0), a3);
        BAR; WAIT_L(0); MMA(1, 0, At, B0); BAR; SCHED;
        STAGE(SB(1, 1), b3 + hstep);
        WAIT_V(6); BAR; MMA(1, 1, At, B1); BAR;
    }
    { LDB(B0, 0, 0); LDA(At, 0, 0); STAGE(SA(1, 1), cA + (size_t)(nt - 1) * kstep + hstep);
      BAR; WAIT_L(0); MMA(0, 0, At, B0); BAR;
      LDB(B1, 0, 1); BAR; WAIT_L(0); MMA(0, 1, At, B1); BAR;
      LDA(At, 0, 1); WAIT_V(4); BAR; WAIT_L(0); MMA(1, 0, At, B0); MMA(1, 1, At, B1); BAR; }
    { LDB(B0, 1, 0); LDA(At, 1, 0); WAIT_V(2); BAR; WAIT_L(0); MMA(0, 0, At, B0); BAR;
      LDB(B1, 1, 1); WAIT_V(0); BAR; WAIT_L(0); MMA(0, 1, At, B1); BAR;
      LDA(At, 1, 1); BAR; WAIT_L(0); MMA(1, 0, At, B0); MMA(1, 1, At, B1); BAR; }
    if (wr == 0) BAR;
#undef SA
#undef SB
#undef STAGE
#undef LDA
#undef LDB
#undef MMA
}

__device__ __forceinline__ void unit_map(int L, int nM, int nN, int& pm, int& pn) {
    const int nwg = nM * nN; int wgid = L;
    { const int q = nwg / 8, r = nwg % 8, xcd = wgid % 8, off = wgid / 8; wgid = (xcd < r ? xcd * (q + 1) : r * (q + 1) + (xcd - r) * q) + off; }
    const int nig = 8 * nN, gid = wgid / nig, fm = gid * 8, gsz = (nM - fm) < 8 ? (nM - fm) : 8;
    pm = fm + ((wgid % nig) % gsz); pn = (wgid % nig) / gsz;
}

#define ZERO_ACC(acc) _Pragma("unroll") for (int a_ = 0; a_ < 2; ++a_) _Pragma("unroll") for (int b_ = 0; b_ < 2; ++b_) _Pragma("unroll") for (int m_ = 0; m_ < 4; ++m_) _Pragma("unroll") for (int n_ = 0; n_ < 2; ++n_) acc[a_][b_][m_][n_] = (f32x4){0.f, 0.f, 0.f, 0.f};

template <class Epi, bool SWAP>
__device__ __forceinline__ void gemm_run(LAS uchar* lds, const bf16_t* A, const bf16_t* Bt, int nM, int nN, int K, const Epi& E) {
    const int G = ogdim(), c = obid(), nwg = nM * nN;
    for (int i = 0;; ++i) {
        const long L = (long)i * G + c; if (L >= nwg) break;
        int pm, pn; unit_map((int)L, nM, nN, pm, pn);
        f32x4 acc[2][2][4][2]; ZERO_ACC(acc)
        asm volatile("s_waitcnt vmcnt(0)" ::: "memory");
        gemm_kloop<SWAP>(lds, (const char*)(A + (size_t)pm * 256 * K), (const char*)(Bt + (size_t)pn * 256 * K), K, acc);
        E(acc, pm, pn);
    }
}

namespace pg8 {
#define PG8_LAS __attribute__((address_space(3)))
typedef unsigned short bf16_t;
typedef short bf16x8 __attribute__((ext_vector_type(8)));
typedef float f32x4 __attribute__((ext_vector_type(4)));
typedef unsigned u32x4 __attribute__((ext_vector_type(4)));
constexpr int BM = 256, BK = 64, HALF = 128, HTB = HALF * BK * 2  , STAGE_BYTES = 8 * HTB, NXCD = 8, WGM = 8;

__host__ __device__ __forceinline__ int lds_byte(int r, int c) { const int st = (r >> 4) * 2 + (c >> 5), rr = r & 15, cc = c & 31, ob = rr * 64 + cc * 2; return st * 1024 + (ob ^ (((ob >> 9) & 1) << 5)); }
__host__ __device__ __forceinline__ void stage_rc(int b, int& R, int& C) { const int st = b / 1024, sb = b % 1024, swz = sb ^ (((sb >> 9) & 1) << 5); R = (st >> 1) * 16 + swz / 64; C = (st & 1) * 32 + (swz % 64) / 2; }
__host__ __device__ __forceinline__ int perm32(int rho) { const int n = rho >> 4, i = rho & 15; return 8 * (i >> 2) + 4 * n + (i & 3); }

struct Unit { int pm, pn; };
struct Gemm { const bf16_t* A; const bf16_t* Bt; int M, N, K; };

struct StaticOrder {
    int nM, nN, nwg, G, c;
    __host__ __device__ void init(int M, int N, int G_, int c_) { nM = M / BM; nN = N / BM; nwg = nM * nN; G = G_; c = c_; }
    __host__ __device__ bool next(int i, Unit& u) const {
        const long L = (long)i * G + c; if (L >= nwg) return false;
        int wgid = (int)L; { const int q = nwg / NXCD, r = nwg % NXCD, xcd = wgid % NXCD, off = wgid / NXCD; wgid = (xcd < r ? xcd * (q + 1) : r * (q + 1) + (xcd - r) * q) + off; }
        const int nig = WGM * nN, gid = wgid / nig, fm = gid * WGM, gsz = (nM - fm) < WGM ? (nM - fm) : WGM;
        u.pm = fm + ((wgid % nig) % gsz); u.pn = (wgid % nig) / gsz; return true;
    }
    __device__ __forceinline__ void a_ready(const Unit&) const {}
    __device__ __forceinline__ void done(const Unit&) const {}
};
template <class Epi, class Sched, bool ALIGN_EPI = false, bool SP2 = false>
__device__ __forceinline__ void gemm_phase(PG8_LAS unsigned char* lds, const Gemm g, const Sched& S, const Epi& E) {
    const int tid = otid(), wid = __builtin_amdgcn_readfirstlane(tid >> 6), lane = tid & 63, wr = wid >> 2, wc = wid & 3, fr = lane & 15, fq = lane >> 4;
    const int K = g.K, nt = K / BK;
    unsigned voffA[2], voffB[2];
#pragma unroll
    for (int i = 0; i < 2; ++i) { int R, C; stage_rc(tid * 16 + i * 8192, R, C); const int Rb = Epi::PERM ? ((R & ~31) + perm32(R & 31)) : R;
        voffA[i] = (unsigned)(R * K + C) * 2u; voffB[i] = (unsigned)(Rb * K + C) * 2u; }
    const size_t kstep = (size_t)(BK * 2);
    const size_t hstep = (size_t)HALF * K * 2;
    const size_t tstep = 2 * hstep;
    const unsigned ldsw = (unsigned)wid * 1024u;
    const int aoff = lds_byte(wr * 64 + fr, fq * 8), boff = lds_byte(wc * 32 + fr, fq * 8);
#define PG8_SA(b, h) (((b) * 2 + (h)) * HTB)
#define PG8_SB(b, h) ((4 + (b) * 2 + (h)) * HTB)
#define PG8_STAGE(bufoff, gbase, voff) do { _Pragma("unroll") for (int _i = 0; _i < 2; ++_i) \
        __builtin_amdgcn_global_load_lds((const unsigned*)((const char*)(gbase) + (voff)[_i]), (PG8_LAS unsigned*)(lds + (bufoff) + ldsw + _i * 8192), 16, 0, 0); } while (0)
#define PG8_LDA(dst, b, h) do { _Pragma("unroll") for (int m = 0; m < 4; ++m) _Pragma("unroll") for (int k = 0; k < 2; ++k) dst[m][k] = *(const PG8_LAS bf16x8*)(lds + PG8_SA(b, h) + aoff + m * 2048 + k * 1024); } while (0)
#define PG8_LDB(dst, b, h) do { _Pragma("unroll") for (int n = 0; n < 2; ++n) _Pragma("unroll") for (int k = 0; k < 2; ++k) dst[n][k] = *(const PG8_LAS bf16x8*)(lds + PG8_SB(b, h) + boff + n * 2048 + k * 1024); } while (0)
#define PG8_MMA(ai, bj, At, Bt) do { __builtin_amdgcn_s_setprio(1); _Pragma("unroll") for (int m = 0; m < 4; ++m) _Pragma("unroll") for (int n = 0; n < 2; ++n) _Pragma("unroll") for (int k = 0; k < 2; ++k) \
        acc[ai][bj][m][n] = Epi::NSWAP ? __builtin_amdgcn_mfma_f32_16x16x32_bf16(At[m][k], Bt[n][k], acc[ai][bj][m][n], 0, 0, 0) : __builtin_amdgcn_mfma_f32_16x16x32_bf16(Bt[n][k], At[m][k], acc[ai][bj][m][n], 0, 0, 0); __builtin_amdgcn_s_setprio(0); } while (0)
#define PG8_WAIT_V(n) asm volatile("s_waitcnt vmcnt(" #n ")" ::: "memory")
#define PG8_WAIT_L(n) asm volatile("s_waitcnt lgkmcnt(" #n ")" ::: "memory")
#define PG8_BAR __builtin_amdgcn_s_barrier()
#define PG8_SCHED __builtin_amdgcn_sched_barrier(0)
    Unit cur, nxt; int ui = 0;
    if (!S.next(0, cur)) return;
    f32x4 acc[2][2][4][2];
#pragma unroll
    for (int a = 0; a < 2; ++a)
#pragma unroll
        for (int b = 0; b < 2; ++b)
#pragma unroll
            for (int m = 0; m < 4; ++m)
#pragma unroll
                for (int n = 0; n < 2; ++n) acc[a][b][m][n] = (f32x4){0.f, 0.f, 0.f, 0.f};
    bf16x8 At[4][2], B0[2][2], B1[2][2];
    const char* cA = (const char*)g.A + (size_t)cur.pm * tstep; const char* cB = (const char*)g.Bt + (size_t)cur.pn * tstep;
    S.a_ready(cur);
    if constexpr (SP2) {
        PG8_STAGE(PG8_SB(0, 0), cB, voffB); PG8_STAGE(PG8_SB(0, 1), cB + hstep, voffB); PG8_STAGE(PG8_SA(0, 0), cA, voffA); PG8_STAGE(PG8_SA(0, 1), cA + hstep, voffA);
        if (wr == 1) PG8_BAR;
        PG8_WAIT_V(2); PG8_BAR;
        PG8_STAGE(PG8_SB(1, 0), cB + kstep, voffB); PG8_STAGE(PG8_SA(1, 0), cA + kstep, voffA); PG8_STAGE(PG8_SB(1, 1), cB + hstep + kstep, voffB);
        PG8_WAIT_V(6); PG8_BAR;
    } else {
        PG8_STAGE(PG8_SB(0, 0), cB, voffB); PG8_STAGE(PG8_SA(0, 0), cA, voffA); PG8_STAGE(PG8_SB(0, 1), cB + hstep, voffB); PG8_STAGE(PG8_SA(0, 1), cA + hstep, voffA);
        if (wr == 1) PG8_BAR;
        PG8_WAIT_V(4); PG8_BAR;
        PG8_STAGE(PG8_SB(1, 0), cB + kstep, voffB); PG8_STAGE(PG8_SA(1, 0), cA + kstep, voffA); PG8_STAGE(PG8_SB(1, 1), cB + hstep + kstep, voffB);
        PG8_WAIT_V(6); PG8_BAR;
    }
    for (;;) {
        const bool has_next = S.next(ui + 1, nxt);
        const char* nA = has_next ? (const char*)g.A + (size_t)nxt.pm * tstep : cA; const char* nB = has_next ? (const char*)g.Bt + (size_t)nxt.pn * tstep : cB;
        for (int t = 0; t < nt; t += 2) {
            const bool last = (t == nt - 2);
            const char* a1 = cA + (size_t)(t + 1) * kstep;
            const char* a2 = last ? nA : cA + (size_t)(t + 2) * kstep; const char* b2 = last ? nB : cB + (size_t)(t + 2) * kstep;
            const char* a3 = a2 + kstep; const char* b3 = b2 + kstep;
            if (last && has_next) S.a_ready(nxt);
            if constexpr (SP2) {
            PG8_LDB(B0, 0, 0); PG8_LDB(B1, 0, 1); PG8_SCHED; PG8_LDA(At, 0, 0); PG8_STAGE(PG8_SA(1, 1), a1 + hstep, voffA);
            PG8_WAIT_V(8); PG8_WAIT_L(0); PG8_BAR; PG8_MMA(0, 0, At, B0); PG8_MMA(0, 1, At, B1); PG8_BAR; PG8_SCHED;
            PG8_LDA(At, 0, 1); PG8_STAGE(PG8_SB(0, 0), b2, voffB); PG8_STAGE(PG8_SB(0, 1), b2 + hstep, voffB); PG8_STAGE(PG8_SA(0, 0), a2, voffA);
            PG8_WAIT_V(8); PG8_WAIT_L(0); PG8_BAR; PG8_MMA(1, 0, At, B0); PG8_MMA(1, 1, At, B1); PG8_BAR; PG8_SCHED;
            PG8_LDB(B0, 1, 0); PG8_LDB(B1, 1, 1); PG8_SCHED; PG8_LDA(At, 1, 0); PG8_STAGE(PG8_SA(0, 1), a2 + hstep, voffA);
            PG8_WAIT_V(8); PG8_WAIT_L(0); PG8_BAR; PG8_MMA(0, 0, At, B0); PG8_MMA(0, 1, At, B1); PG8_BAR; PG8_SCHED;
            PG8_LDA(At, 1, 1); PG8_STAGE(PG8_SB(1, 0), b3, voffB); PG8_STAGE(PG8_SB(1, 1), b3 + hstep, voffB); PG8_STAGE(PG8_SA(1, 0), a3, voffA);
            PG8_WAIT_V(8); PG8_WAIT_L(0); PG8_BAR; PG8_MMA(1, 0, At, B0); PG8_MMA(1, 1, At, B1); PG8_BAR; PG8_SCHED;
            } else {
            PG8_LDB(B0, 0, 0); PG8_SCHED; PG8_LDA(At, 0, 0); PG8_STAGE(PG8_SA(1, 1), a1 + hstep, voffA);
            PG8_WAIT_L(8); PG8_BAR; PG8_WAIT_L(0); PG8_MMA(0, 0, At, B0); PG8_BAR; PG8_SCHED;
            PG8_LDB(B1, 0, 1); PG8_STAGE(PG8_SB(0, 0), b2, voffB);
            PG8_BAR; PG8_WAIT_L(0); PG8_MMA(0, 1, At, B1); PG8_BAR;
            PG8_LDA(At, 0, 1); PG8_STAGE(PG8_SA(0, 0), a2, voffA);
            PG8_BAR; PG8_WAIT_L(0); PG8_MMA(1, 0, At, B0); PG8_BAR; PG8_SCHED;
            PG8_STAGE(PG8_SB(0, 1), b2 + hstep, voffB);
            PG8_WAIT_V(6); PG8_BAR; PG8_MMA(1, 1, At, B1); PG8_BAR;
            PG8_LDB(B0, 1, 0); PG8_SCHED; PG8_LDA(At, 1, 0); PG8_STAGE(PG8_SA(0, 1), a2 + hstep, voffA);
            PG8_WAIT_L(8); PG8_BAR; PG8_WAIT_L(0); PG8_MMA(0, 0, At, B0); PG8_BAR; PG8_SCHED;
            PG8_LDB(B1, 1, 1); PG8_STAGE(PG8_SB(1, 0), b3, voffB);
            PG8_BAR; PG8_WAIT_L(0); PG8_MMA(0, 1, At, B1); PG8_BAR;
            PG8_LDA(At, 1, 1); PG8_STAGE(PG8_SA(1, 0), a3, voffA);
            PG8_BAR; PG8_WAIT_L(0); PG8_MMA(1, 0, At, B0); PG8_BAR; PG8_SCHED;
            PG8_STAGE(PG8_SB(1, 1), b3 + hstep, voffB);
            PG8_WAIT_V(6); PG8_BAR; PG8_MMA(1, 1, At, B1); PG8_BAR;
            }
        }
        if constexpr (ALIGN_EPI) { if (wr == 0) PG8_BAR; }
        if constexpr (!Epi::AFTER_DRAIN) { E(acc, cur, wr, wc, fr, fq); S.done(cur); }
        if (!has_next) break;
#pragma unroll
        for (int a = 0; a < 2; ++a)
#pragma unroll
            for (int b = 0; b < 2; ++b)
#pragma unroll
                for (int m = 0; m < 4; ++m)
#pragma unroll
                    for (int n = 0; n < 2; ++n) acc[a][b][m][n] = (f32x4){0.f, 0.f, 0.f, 0.f};
        cur = nxt; cA = nA; cB = nB; ++ui;
        if constexpr (ALIGN_EPI) { if (wr == 1) PG8_BAR; }
    }
    PG8_WAIT_V(0);
    if constexpr (!ALIGN_EPI) { if (wr == 0) PG8_BAR; }
    PG8_BAR;
    if constexpr (Epi::AFTER_DRAIN) { E.fused(acc, cur, wr, wc, fr, fq, lds, wid, lane); S.done(cur); }
#undef PG8_SA
#undef PG8_SB
#undef PG8_STAGE
#undef PG8_LDA
#undef PG8_LDB
#undef PG8_MMA
#undef PG8_WAIT_V
#undef PG8_WAIT_L
#undef PG8_BAR
#undef PG8_SCHED
}
}

template <class E, bool NSW = false> struct Pg8Epi { static constexpr bool PERM = !NSW, AFTER_DRAIN = false, NSWAP = NSW; E e;
    __device__ __forceinline__ void operator()(f32x4 (&acc)[2][2][4][2], const pg8::Unit& u, int, int, int, int) const { e(acc, u.pm, u.pn); } };
template <class Epi, bool NSW = false>
__device__ __forceinline__ void gemm_run2(LAS uchar* lds, const bf16_t* A, const bf16_t* Bt, int nM, int nN, int K, const Epi& E) {
    pg8::Gemm g{A, Bt, nM * 256, nN * 256, K}; pg8::StaticOrder S; S.init(nM * 256, nN * 256, ogdim(), obid());
    Pg8Epi<Epi, NSW> PE{E};
    pg8::gemm_phase<Pg8Epi<Epi, NSW>, pg8::StaticOrder, true, true>(lds, g, S, PE);
}
#define EPI_LOOP _Pragma("unroll") for (int ai = 0; ai < 2; ++ai) _Pragma("unroll") for (int m = 0; m < 4; ++m) _Pragma("unroll") for (int bj = 0; bj < 2; ++bj) _Pragma("unroll") for (int n = 0; n < 2; ++n)
#define EPI_FENCE do { if (bj == 1 && n == 1) asm volatile("" ::: "memory"); } while (0)

#define EPI2_LOOP _Pragma("unroll") for (int ai = 0; ai < 2; ++ai) _Pragma("unroll") for (int m = 0; m < 4; ++m) _Pragma("unroll") for (int bj = 0; bj < 2; ++bj)
#define EPI2_FENCE do { if (bj == 1) asm volatile("" ::: "memory"); } while (0)
__device__ __forceinline__ u32x4 pk8(f32x4 a, f32x4 b) { u32x4 w; w.x = pk2(a[0], a[1]); w.y = pk2(a[2], a[3]); w.z = pk2(b[0], b[1]); w.w = pk2(b[2], b[3]); return w; }
__device__ __forceinline__ u32x4 pkh8(f32x4 a, f32x4 b) { u32x4 w; w.x = pkh2(a[0], a[1]); w.y = pkh2(a[2], a[3]); w.z = pkh2(b[0], b[1]); w.w = pkh2(b[2], b[3]); return w; }
__device__ __forceinline__ f32x4 silu4(f32x4 v) { f32x4 s; s[0] = siluf(v[0]); s[1] = siluf(v[1]); s[2] = siluf(v[2]); s[3] = siluf(v[3]); return s; }
__device__ __forceinline__ f32x4 sigm4(f32x4 v) { f32x4 s; s[0] = sigm(v[0]); s[1] = sigm(v[1]); s[2] = sigm(v[2]); s[3] = sigm(v[3]); return s; }
__device__ __forceinline__ void unh8(u32x4 w, f32x4& a, f32x4& b) { a[0] = h2f(w.x & 0xffff); a[1] = h2f(w.x >> 16); a[2] = h2f(w.y & 0xffff); a[3] = h2f(w.y >> 16); b[0] = h2f(w.z & 0xffff); b[1] = h2f(w.z >> 16); b[2] = h2f(w.w & 0xffff); b[3] = h2f(w.w >> 16); }
__device__ __forceinline__ void unb8(u32x4 w, f32x4& a, f32x4& b) { a[0] = bf2f(w.x & 0xffff); a[1] = bf2f(w.x >> 16); a[2] = bf2f(w.y & 0xffff); a[3] = bf2f(w.y >> 16); b[0] = bf2f(w.z & 0xffff); b[1] = bf2f(w.z >> 16); b[2] = bf2f(w.w & 0xffff); b[3] = bf2f(w.w >> 16); }

struct EpiGU { bf16_t* hid;
    __device__ __forceinline__ void operator()(f32x4 (&acc)[2][2][4][2], int pm, int pn) const { COORDS
#pragma unroll
        for (int ai = 0; ai < 2; ++ai)
#pragma unroll
            for (int m = 0; m < 4; ++m) { const int r = pm * 256 + ai * 128 + wr * 64 + m * 16 + fr, cc = pn * 128 + wc * 32 + fq * 8;
                *(u32x4*)(hid + (size_t)r * FF + cc) = pk8(silu4(acc[ai][0][m][0]) * acc[ai][1][m][0], silu4(acc[ai][0][m][1]) * acc[ai][1][m][1]); } } };

struct EpiRes { float* h; const float* ada; float coef; const float* stats; const float* g; const float* bta; const float* hsrc;
    __device__ __forceinline__ void operator()(f32x4 (&acc)[2][2][4][2], int pm, int pn) const { COORDS
        const float* ap = ada + (size_t)(pm >> 5) * 9216;
        EPI2_LOOP { const int r = pm * 256 + ai * 128 + wr * 64 + m * 16 + fr, c = pn * 256 + bj * 128 + wc * 32 + fq * 8;
            const float mu = stats[2 * r], rs = stats[2 * r + 1]; float* hp = h + (size_t)r * DM + c; const float* sp = hsrc + (size_t)r * DM + c;
#pragma unroll
            for (int n = 0; n < 2; ++n) { const f32x4 gv = *(const f32x4*)(ap + c + 4 * n), gg = *(const f32x4*)(g + c + 4 * n), bb = *(const f32x4*)(bta + c + 4 * n), zv = *(const f32x4*)(sp + 4 * n);
                f32x4 z;
#pragma unroll
                for (int j = 0; j < 4; ++j) { const float hv = (zv[j] - mu) * rs * gg[j] + bb[j]; z[j] = DN_ALPHA * hv + coef * (1.f + gv[j]) * acc[ai][bj][m][n][j]; }
                *(f32x4*)(hp + 4 * n) = z; }
            EPI2_FENCE; } } };

struct EpiWin1 { bf16_t *hq, *hv, *sg, *cq, *ckv; unsigned short* zf; float* krraw;
    __device__ __forceinline__ void operator()(f32x4 (&acc)[2][2][4][2], int pm, int pn) const { COORDS
        const int kind = pn >> 2;
        EPI2_LOOP { const int r = pm * 256 + ai * 128 + wr * 64 + m * 16 + fr, c = pn * 256 + bj * 128 + wc * 32 + fq * 8; const f32x4 v0 = acc[ai][bj][m][0], v1 = acc[ai][bj][m][1];
            if (kind == 0) *(u32x4*)(hq + (size_t)r * DM + c) = pk8(silu4(v0), silu4(v1));
            else if (kind == 1) *(u32x4*)(zf + (size_t)r * DM + (c - 1024)) = pkh8(v0, v1);
            else if (kind == 2) *(u32x4*)(hv + (size_t)r * DM + (c - 2048)) = pk8(v0, v1);
            else if (kind == 3) *(u32x4*)(sg + (size_t)r * DM + (c - 3072)) = pk8(silu4(v0), silu4(v1));
            else { const int gc = c - 4096;
                if (gc < 384) *(u32x4*)(cq + (size_t)r * 384 + gc) = pk8(v0, v1);
                else if (gc < 640) *(u32x4*)(ckv + (size_t)r * 256 + (gc - 384)) = pk8(v0, v1);
                else if (gc < 704) { *(f32x4*)(krraw + (size_t)r * 64 + (gc - 640)) = v0; *(f32x4*)(krraw + (size_t)r * 64 + (gc - 640) + 4) = v1; } } } } };

struct EpiQ { bf16_t *qn, *qr; const float *rsq, *cosT, *sinT;
    __device__ __forceinline__ void operator()(f32x4 (&acc)[2][2][4][2], int pm, int pn) const { COORDS
#pragma unroll
        for (int ai = 0; ai < 2; ++ai)
#pragma unroll
            for (int m = 0; m < 4; ++m) { const int r = pm * 256 + ai * 128 + wr * 64 + m * 16 + fr; const float rs = rsq[r] * QSCALE;
                if (pn < 4) {
#pragma unroll
                    for (int bj = 0; bj < 2; ++bj) { const int c = pn * 256 + bj * 128 + wc * 32 + fq * 8; *(u32x4*)(qn + (size_t)r * DM + c) = pk8(acc[ai][bj][m][0] * rs, acc[ai][bj][m][1] * rs); }
                } else { const int cl = wc * 32 + fq * 8, hh = (pn - 4) * 4 + (cl >> 5), i = cl & 31;
                    f32x4 o1[2], o2[2];
#pragma unroll
                    for (int n = 0; n < 2; ++n) { const f32x4 x1 = acc[ai][0][m][n] * rs, x2 = acc[ai][1][m][n] * rs; const f32x4 cs = *(const f32x4*)(cosT + (size_t)r * 32 + i + 4 * n), sn = *(const f32x4*)(sinT + (size_t)r * 32 + i + 4 * n);
                        o1[n] = x1 * cs - x2 * sn; o2[n] = x1 * sn + x2 * cs; }
                    *(u32x4*)(qr + (size_t)r * 512 + hh * 64 + i) = pk8(o1[0], o1[1]); *(u32x4*)(qr + (size_t)r * 512 + hh * 64 + 32 + i) = pk8(o2[0], o2[1]);
                }
                asm volatile("" ::: "memory"); } } };

struct EpiKn { bf16_t* kn; const float* rskv;
    __device__ __forceinline__ void operator()(f32x4 (&acc)[2][2][4][2], int pm, int pn) const { COORDS
        EPI2_LOOP { const int r = pm * 256 + ai * 128 + wr * 64 + m * 16 + fr, c = pn * 256 + bj * 128 + wc * 32 + fq * 8; const float rs = rskv[r];
            *(u32x4*)(kn + (size_t)r * DM + c) = pk8(acc[ai][bj][m][0] * rs, acc[ai][bj][m][1] * rs); EPI2_FENCE; } } };

struct EpiV { bf16_t* vt; const float* rskv;
    __device__ __forceinline__ void operator()(f32x4 (&acc)[2][2][4][2], int pm, int pn) const { COORDS
        typedef unsigned u2_t __attribute__((ext_vector_type(2)));
        const int odd = fq & 1;
        EPI2_LOOP { const int r0 = pm * 256 + ai * 128 + wr * 64 + m * 16 + fq * 4;
            const f32x4 rs = *(const f32x4*)(rskv + r0);
            const u32x2 x = pk4(acc[ai][bj][m][0] * rs), y = pk4(acc[ai][bj][m][1] * rs);
            const u2_t sa = __builtin_amdgcn_permlane16_swap(x.x, y.x, false, false);
            const u2_t sb = __builtin_amdgcn_permlane16_swap(x.y, y.y, false, false);
            u32x4 w; if (odd) { w.x = sa[0]; w.y = sb[0]; w.z = sa[1]; w.w = sb[1]; } else { w.x = sa[0]; w.y = sb[0]; w.z = sa[1]; w.w = sb[1]; }
            const int cv = pn * 256 + bj * 128 + wc * 32 + odd * 16 + fr, rr = r0 - odd * 4;
            const int b = rr >> 13, sx = rr & 8191, hh = cv >> 7, e = cv & 127;
            *(u32x4*)(vt + (((size_t)((b * 8 + hh) * 128 + e)) << 13) + sx) = w; EPI2_FENCE; } } };

struct EpiGate { unsigned short *sga, *sgb;
    __device__ __forceinline__ void operator()(f32x4 (&acc)[2][2][4][2], int pm, int pn) const { COORDS
        unsigned short* dst = pn < 4 ? sga : sgb;
        EPI2_LOOP { const int r = pm * 256 + ai * 128 + wr * 64 + m * 16 + fr, c = (pn & 3) * 256 + bj * 128 + wc * 32 + fq * 8;
            *(u32x4*)(dst + (size_t)r * DM + c) = pkh8(sigm4(acc[ai][bj][m][0]), sigm4(acc[ai][bj][m][1])); } } };

struct EpiM1 { bf16_t* m1; const unsigned short* sga;
    __device__ __forceinline__ void operator()(f32x4 (&acc)[2][2][4][2], int pm, int pn) const { COORDS
        EPI2_LOOP { const int r = pm * 256 + ai * 128 + wr * 64 + m * 16 + fr, c = pn * 256 + bj * 128 + wc * 32 + fq * 8;
            f32x4 s0, s1; unh8(*(const u32x4*)(sga + (size_t)r * DM + c), s0, s1);
            *(u32x4*)(m1 + (size_t)r * DM + c) = pk8(acc[ai][bj][m][0] * s0, acc[ai][bj][m][1] * s1); EPI2_FENCE; } } };
struct EpiM2 { const bf16_t* m1; const unsigned short* sgb; bf16_t* merged;
    __device__ __forceinline__ void operator()(f32x4 (&acc)[2][2][4][2], int pm, int pn) const { COORDS
        EPI2_LOOP { const int r = pm * 256 + ai * 128 + wr * 64 + m * 16 + fr, c = pn * 256 + bj * 128 + wc * 32 + fq * 8;
            f32x4 s0, s1, m0, m1v; unh8(*(const u32x4*)(sgb + (size_t)r * DM + c), s0, s1); unb8(*(const u32x4*)(m1 + (size_t)r * DM + c), m0, m1v);
            *(u32x4*)(merged + (size_t)r * DM + c) = pk8(m0 + acc[ai][bj][m][0] * s0, m1v + acc[ai][bj][m][1] * s1); EPI2_FENCE; } } };

struct ConvDesc { const float* src0; const float* src1; const float* kscale; int K, Ns; bf16_t* dst; int kind, item; };
__device__ __forceinline__ void conv_load(const ConvDesc& d, int tid, float (&v)[8]) {
    const int nkt = d.K / 64; const int kt = d.item % nkt, ntile = d.item / nkt; const int k0 = kt * 64, n0 = ntile * 64;
    const int tn = tid & 63, np = n0 + tn; const float* s = d.src0; int col = np;
    if (d.kind == 1) { const int tile = np >> 8, bj = (np >> 7) & 1, cc = np & 127; s = bj ? d.src1 : d.src0; col = tile * 128 + cc; }
    else if (d.kind == 2) { if (np < 1024) col = (np >> 7) * 192 + (np & 127); else { const int r = np - 1024, t2 = r >> 8, bj = (r >> 7) & 1, cc = r & 127, hh = t2 * 4 + (cc >> 5), i = cc & 31; col = hh * 192 + 128 + bj * 32 + i; } }
    else if (d.kind == 3) { if (np < 1024) col = (np >> 7) * 256 + (np & 127); else { const int r = np - 1024; col = (r >> 7) * 256 + 128 + (r & 127); } }
#pragma unroll
    for (int i = 0; i < 8; ++i) { const int kk = (tid >> 6) + 8 * i; float x = s[(size_t)(k0 + kk) * d.Ns + col]; if (d.kscale) x *= d.kscale[k0 + kk]; v[i] = x; }
}
__device__ __forceinline__ void conv_store(LAS uchar* lds, const ConvDesc& d, int tid, const float (&v)[8]) {
    LAS float* tl = (LAS float*)lds;
    const int nkt = d.K / 64; const int kt = d.item % nkt, ntile = d.item / nkt; const int k0 = kt * 64, n0 = ntile * 64;
    { const int tn = tid & 63;
#pragma unroll
      for (int i = 0; i < 8; ++i) tl[tn * 65 + (tid >> 6) + 8 * i] = v[i]; }
    __syncthreads();
    { const int n = tid >> 3, kc = tid & 7; const LAS float* rp = tl + n * 65 + kc * 8; u32x4 w; w.x = pk2(rp[0], rp[1]); w.y = pk2(rp[2], rp[3]); w.z = pk2(rp[4], rp[5]); w.w = pk2(rp[6], rp[7]);
      *(u32x4*)(d.dst + (size_t)(n0 + n) * d.K + k0 + kc * 8) = w; }
    __syncthreads();
}
__device__ __forceinline__ ConvDesc conv_desc(const Params& p, int l, int it) {
    bf16_t* W = (bf16_t*)(p.ws + OFF_W + (size_t)(l & 1) * WSZ);
    constexpr int I_GU = 16 * 88, I_D = 44 * 16, I_IN = 16 * 107, I_UQ = 6 * 24, I_UKV = 4 * 32, I_SQ = 256;
    const size_t o_ff = (size_t)l * DM * FF; int r = it;
    if (r < I_GU) return ConvDesc{p.f1g + o_ff, p.f1u + o_ff, nullptr, DM, FF, W + W_GU1, 1, r}; r -= I_GU;
    if (r < I_D) return ConvDesc{p.f1d + o_ff, nullptr, nullptr, FF, DM, W + W_D1, 0, r}; r -= I_D;
    if (r < I_IN) return ConvDesc{p.w_in + (size_t)l * DM * 6848, nullptr, nullptr, DM, 6848, W + W_IN, 0, r}; r -= I_IN;
    if (r < I_UQ) return ConvDesc{p.w_uq + (size_t)l * 384 * 1536, nullptr, p.qng + l * 384, 384, 1536, W + W_UQ, 2, r}; r -= I_UQ;
    if (r < I_UKV) return ConvDesc{p.w_ukv + (size_t)l * 256 * 2048, nullptr, p.kvng + l * 256, 256, 2048, W + W_UKV, 3, r}; r -= I_UKV;
    if (r < I_SQ) return ConvDesc{p.w_bh + (size_t)l * DM * DM, nullptr, nullptr, DM, DM, W + W_BH, 0, r}; r -= I_SQ;
    if (r < I_SQ) return ConvDesc{p.w_bm + (size_t)l * DM * DM, nullptr, nullptr, DM, DM, W + W_BM, 0, r}; r -= I_SQ;
    if (r < I_SQ) return ConvDesc{p.w_out + (size_t)l * DM * DM, nullptr, nullptr, DM, DM, W + W_OUT, 0, r}; r -= I_SQ;
    if (r < I_GU) return ConvDesc{p.f2g + o_ff, p.f2u + o_ff, nullptr, DM, FF, W + W_GU2, 1, r}; r -= I_GU;
    return ConvDesc{p.f2d + o_ff, nullptr, nullptr, FF, DM, W + W_D2, 0, r};
}
__device__ void conv_layer(LAS uchar* lds, const Params& p, int l, int start, int stride) {
    constexpr int TOT = 2 * 16 * 88 + 2 * 44 * 16 + 16 * 107 + 6 * 24 + 4 * 32 + 3 * 256;
    const int tid = otid();
    float v[8], vn[8];
    if (start < TOT) { const ConvDesc d = conv_desc(p, l, start); conv_load(d, tid, v); }
    for (int it = start; it < TOT; it += stride) {
        const ConvDesc d = conv_desc(p, l, it);
        if (it + stride < TOT) { const ConvDesc dn = conv_desc(p, l, it + stride); conv_load(dn, tid, vn); }
        conv_store(lds, d, tid, v);
#pragma unroll
        for (int i = 0; i < 8; ++i) v[i] = vn[i];
    }
}

__device__ void p0a(LAS uchar* lds, const Params& p) {
    const int tid = otid(), G = ogdim();
    float* ADA = (float*)(p.ws + OFF_ADA);
    LAS float* red = (LAS float*)lds;
    LAS float* cond = red + 2048;
    for (int i = tid; i < 4096; i += NTHR) cond[i] = siluf(p.c[i]);
    __syncthreads();
    for (int it = obid(); it < NL * 144; it += G) {
        const int l = it / 144, cg0 = (it % 144) * 64, cn = tid & 63, kp = tid >> 6;
        const float* w = p.ada_w + (size_t)l * DM * 9216 + cg0 + cn;
        float a0 = 0.f, a1 = 0.f, a2 = 0.f, a3 = 0.f;
        for (int k = kp * 128; k < kp * 128 + 128; ++k) { const float wv = w[(size_t)k * 9216];
            a0 += cond[k] * wv; a1 += cond[1024 + k] * wv; a2 += cond[2048 + k] * wv; a3 += cond[3072 + k] * wv; }
        red[(kp * 4 + 0) * 64 + cn] = a0; red[(kp * 4 + 1) * 64 + cn] = a1; red[(kp * 4 + 2) * 64 + cn] = a2; red[(kp * 4 + 3) * 64 + cn] = a3;
        __syncthreads();
        if (tid < 256) { const int b = tid >> 6; float s = 0.f;
#pragma unroll
            for (int q = 0; q < 8; ++q) s += red[(q * 4 + b) * 64 + cn];
            ADA[(size_t)(l * 4 + b) * 9216 + cg0 + cn] = s + p.ada_b[(size_t)l * 9216 + cg0 + cn]; }
        __syncthreads();
    }
    float* COS = (float*)(p.ws + OFF_COS); float* SIN = (float*)(p.ws + OFF_SIN);
    for (int e = obid() * NTHR + tid; e < T * 32; e += G * NTHR) {
        const int tok = e >> 5, i = e & 31; double inv = 1.0, rr = 0.7498942093324558; int n = i;
        while (n) { if (n & 1) inv *= rr; rr *= rr; n >>= 1; }
        const double ang = (double)p.pos[tok] * inv; const double kq = __builtin_rint(ang * 0.15915494309189535);
        double r = ang - kq * 6.283185307179586 - kq * 2.4492935982947064e-16; const double r2 = r * r;
        double sn, cs;
        { double t = 1.0;
#pragma unroll
          for (int q = 27; q >= 3; q -= 2) t = 1.0 - t * r2 * (1.0 / (double)(q * (q - 1))); sn = t * r; }
        { double t = 1.0;
#pragma unroll
          for (int q = 26; q >= 2; q -= 2) t = 1.0 - t * r2 * (1.0 / (double)(q * (q - 1))); cs = t; }
        COS[e] = (float)cs; SIN[e] = (float)sn;
    }
    { float* onz = (float*)(p.ws + OFF_ONES); for (int ch = obid() * NTHR + tid; ch < 2048; ch += G * NTHR) onz[ch] = ch < 1024 ? 1.f : 0.f; }
    float* LBT = (float*)(p.ws + OFF_LBT);
    for (int ch = obid() * NTHR + tid; ch < 1024; ch += G * NTHR) {
        const float v0 = p.hg_lb[ch], v1 = p.hg_lb[1024 + ch], v2 = p.hg_lb[2048 + ch], v3 = p.hg_lb[3072 + ch];
        const float mx = fmaxf(fmaxf(v0, v1), fmaxf(v2, v3)); const float e0 = expf(v0 - mx), e1 = expf(v1 - mx), e2 = expf(v2 - mx), e3 = expf(v3 - mx); const float inv = 1.f / (e0 + e1 + e2 + e3);
        float lw[4]; lw[0] = 0.f; lw[1] = e1 * inv; lw[2] = (e1 + e2) * inv; lw[3] = (e1 + e2 + e3) * inv;
#pragma unroll
        for (int l = 0; l < 4; ++l) { const float lb = lw[l]; LBT[(l * 3 + 0) * 1024 + ch] = fmaxf(lb, 1e-30f); LBT[(l * 3 + 1) * 1024 + ch] = log1pf(-lb); LBT[(l * 3 + 2) * 1024 + ch] = 1.f - lb; }
    }
}

__device__ void ln_pass(const Params& p, const float* src, float* hdst, bf16_t* U, const float* g, const float* bta, const float* ada_l, int sc_idx, int sh_idx, bool donorm, bool writeU, bool writeH) {
    float* stats = (float*)(p.ws + OFF_STATS);
    const int tid = otid(), wid = tid >> 6, lane = tid & 63;
    for (int row = obid() * 8 + wid; row < T; row += ogdim() * 8) {
        const f32x4* xr = (const f32x4*)(src + (size_t)row * DM) + lane; f32x4 v[4]; float s = 0.f;
#pragma unroll
        for (int j = 0; j < 4; ++j) { v[j] = xr[64 * j]; s += (v[j][0] + v[j][1]) + (v[j][2] + v[j][3]); }
        if (donorm) {
#pragma unroll
            for (int o = 32; o > 0; o >>= 1) s += __shfl_xor(s, o);
            const float mean = s * (1.f / DM); float s2 = 0.f;
#pragma unroll
            for (int j = 0; j < 4; ++j) { v[j] = v[j] - mean; s2 += (v[j][0] * v[j][0] + v[j][1] * v[j][1]) + (v[j][2] * v[j][2] + v[j][3] * v[j][3]); }
#pragma unroll
            for (int o = 32; o > 0; o >>= 1) s2 += __shfl_xor(s2, o);
            const float rstd = 1.f / sqrtf(s2 * (1.f / DM) + 1e-5f);
            if (lane == 0) *(f32x2v*)(stats + 2 * row) = (f32x2v){mean, rstd};
#pragma unroll
            for (int j = 0; j < 4; ++j) { const f32x4 gg = *((const f32x4*)g + lane + 64 * j), bb = *((const f32x4*)bta + lane + 64 * j); v[j] = v[j] * rstd * gg + bb; }
        }
        else if (lane == 0) { const float zz = v[0][0] * 0.f; *(f32x2v*)(stats + 2 * row) = (f32x2v){zz, 1.f + zz}; }
        if (writeH) { f32x4* hr = (f32x4*)(hdst + (size_t)row * DM) + lane;
#pragma unroll
            for (int j = 0; j < 4; ++j) hr[64 * j] = v[j]; }
        if (writeU) { const float* ab = ada_l + (size_t)(row >> 13) * 9216; u32x2* ur = (u32x2*)(U + (size_t)row * DM) + lane;
#pragma unroll
            for (int j = 0; j < 4; ++j) { const f32x4 sc = *((const f32x4*)(ab + sc_idx * 1024) + lane + 64 * j), sh = *((const f32x4*)(ab + sh_idx * 1024) + lane + 64 * j); ur[64 * j] = pk4(v[j] * (1.f + sc) + sh); } }
    }
}

__device__ void ln_pass2(const Params& p, const float* src, float* outH, bf16_t* U, const float* g, const float* bta, const float* ada_l, int sc_idx, int sh_idx) {
    float* stats = (float*)(p.ws + OFF_STATS);
    const int tid = otid(), wid = tid >> 6, lane = tid & 63; const int rstep = ogdim() * 8, r0 = obid() * 8 + wid;
    for (int b = 0; b < 4; ++b) {
        f32x4 A[4], B[4];
#pragma unroll
        for (int j = 0; j < 4; ++j) { const f32x4 gg = *((const f32x4*)g + lane + 64 * j), bb = *((const f32x4*)bta + lane + 64 * j);
            if (outH) { A[j] = gg; B[j] = bb; }
            else { const float* ab = ada_l + (size_t)b * 9216; const f32x4 sc = *((const f32x4*)(ab + sc_idx * 1024) + lane + 64 * j), sh = *((const f32x4*)(ab + sh_idx * 1024) + lane + 64 * j); A[j] = gg * (1.f + sc); B[j] = bb * (1.f + sc) + sh; } }
        f32x4 v[4], vn[4];
        if (r0 < SEQ) {
#pragma unroll
            for (int j = 0; j < 4; ++j) v[j] = *((const f32x4*)(src + (size_t)(b * SEQ + r0) * DM) + lane + 64 * j); }
        for (int rr = r0; rr < SEQ; rr += rstep) {
            const int row = b * SEQ + rr;
            if (rr + rstep < SEQ) {
#pragma unroll
                for (int j = 0; j < 4; ++j) vn[j] = *((const f32x4*)(src + (size_t)(row + rstep) * DM) + lane + 64 * j); }
            float s = 0.f;
#pragma unroll
            for (int j = 0; j < 4; ++j) s += (v[j][0] + v[j][1]) + (v[j][2] + v[j][3]);
#pragma unroll
            for (int o = 32; o > 0; o >>= 1) s += __shfl_xor(s, o);
            const float mean = s * (1.f / DM); float s2 = 0.f;
#pragma unroll
            for (int j = 0; j < 4; ++j) { v[j] = v[j] - mean; s2 += (v[j][0] * v[j][0] + v[j][1] * v[j][1]) + (v[j][2] * v[j][2] + v[j][3] * v[j][3]); }
#pragma unroll
            for (int o = 32; o > 0; o >>= 1) s2 += __shfl_xor(s2, o);
            const float rstd = 1.f / sqrtf(s2 * (1.f / DM) + 1e-5f);
            if (lane == 0) *(f32x2v*)(stats + 2 * row) = (f32x2v){mean, rstd};
            if (outH) { f32x4* hr = (f32x4*)(outH + (size_t)row * DM) + lane;
#pragma unroll
                for (int j = 0; j < 4; ++j) hr[64 * j] = v[j] * rstd * A[j] + B[j]; }
            else { u32x2* ur = (u32x2*)(U + (size_t)row * DM) + lane;
#pragma unroll
                for (int j = 0; j < 4; ++j) ur[64 * j] = pk4(v[j] * rstd * A[j] + B[j]); }
#pragma unroll
            for (int j = 0; j < 4; ++j) v[j] = vn[j];
        }
    }
}

__device__ void tok_pass(const Params& p) {
    const int tid = otid(), wid = tid >> 6, lane = tid & 63;
    const bf16_t* CQ = (const bf16_t*)(p.ws + OFF_CQ); const bf16_t* CKV = (const bf16_t*)(p.ws + OFF_CKV);
    const float* KRRAW = (const float*)(p.ws + OFF_KRRAW); bf16_t* KR = (bf16_t*)(p.ws + OFF_KR);
    const float* COS = (const float*)(p.ws + OFF_COS); const float* SIN = (const float*)(p.ws + OFF_SIN);
    float* RSQ = (float*)(p.ws + OFF_RSQ); float* RSKV = (float*)(p.ws + OFF_RSKV);
    const int step = ogdim() * 8, t0 = obid() * 8 + wid; const int l31 = lane & 31;
    unsigned qw[3], qn[3]; u32x2 kw, kn2; float x1, x2, cs, sn, x1n, x2n, csn, snn;
#define TOK_LOAD(tok_, Q_, K_, X1_, X2_, C_, S_) do { const unsigned* q_ = (const unsigned*)(CQ + (size_t)(tok_) * 384) + lane * 3; Q_[0] = q_[0]; Q_[1] = q_[1]; Q_[2] = q_[2]; K_ = *((const u32x2*)(CKV + (size_t)(tok_) * 256) + lane); \
        X1_ = KRRAW[(size_t)(tok_) * 64 + l31]; X2_ = KRRAW[(size_t)(tok_) * 64 + 32 + l31]; C_ = COS[(size_t)(tok_) * 32 + l31]; S_ = SIN[(size_t)(tok_) * 32 + l31]; } while (0)
    if (t0 < T) TOK_LOAD(t0, qw, kw, x1, x2, cs, sn);
    for (int tok = t0; tok < T; tok += step) {
        if (tok + step < T) TOK_LOAD(tok + step, qn, kn2, x1n, x2n, csn, snn);
        float s = 0.f;
#pragma unroll
        for (int j = 0; j < 3; ++j) { const float a = bf2f(qw[j] & 0xffff), b = bf2f(qw[j] >> 16); s += a * a + b * b; }
        float s2; { const float a = bf2f(kw.x & 0xffff), b = bf2f(kw.x >> 16), c = bf2f(kw.y & 0xffff), d = bf2f(kw.y >> 16); s2 = a * a + b * b + c * c + d * d; }
#pragma unroll
        for (int o = 32; o > 0; o >>= 1) { s += __shfl_xor(s, o); s2 += __shfl_xor(s2, o); }
        if (lane == 0) { RSQ[tok] = 1.f / sqrtf(s * (1.f / 384.f) + 1e-6f); RSKV[tok] = 1.f / sqrtf(s2 * (1.f / 256.f) + 1e-6f); }
        if (lane < 32) { KR[(size_t)tok * 64 + lane] = f2bf(x1 * cs - x2 * sn); KR[(size_t)tok * 64 + 32 + lane] = f2bf(x1 * sn + x2 * cs); }
        qw[0] = qn[0]; qw[1] = qn[1]; qw[2] = qn[2]; kw = kn2; x1 = x1n; x2 = x2n; cs = csn; sn = snn;
    }
#undef TOK_LOAD
}

__device__ __forceinline__ void gate2(float z, float lbp, float oml, float& lf2, float& hk) {
    const float t = __builtin_amdgcn_exp2f(-fabsf(z) * 1.44269504f), r = __builtin_amdgcn_rcpf(1.f + t), sm = t * r;
    const float sz = z >= 0.f ? r : sm, snz = z >= 0.f ? sm : r;
    lf2 = __builtin_amdgcn_logf(lbp + oml * sz); hk = oml * snz;
}
constexpr int KT_STR = 72;
constexpr int TD_STR = 136;

__device__ void hg1_phase(LAS uchar* lds, const Params& p, int l) {
    COORDS
    const unsigned* ZF32 = (const unsigned*)(p.ws + OFF_R1); const unsigned* HV32 = (const unsigned*)(p.ws + OFF_R2);
    bf16_t* LS = (bf16_t*)(p.ws + OFF_R4); float* DEC = (float*)(p.ws + OFF_DEC); const float* LBT = (const float*)(p.ws + OFF_LBT) + (size_t)l * 3 * 1024;
    LAS bf16_t* Kt = (LAS bf16_t*)lds;
    LAS bf16_t* Vt = (LAS bf16_t*)(lds + 128 * KT_STR * 2);
    LAS float* tot = (LAS float*)(lds + 2 * 128 * KT_STR * 2);
    const int d2 = lane, part = wid;
    unsigned zr[8], vr[8];
    { const int unit = obid(); if (unit < 32 * 128) { const int chunk = unit & 127, bh = unit >> 7, b = bh >> 3, hh = bh & 7; const size_t t0 = (size_t)b * SEQ + chunk * 64 + part * 8;
#pragma unroll
        for (int i = 0; i < 8; ++i) { zr[i] = ZF32[(t0 + i) * 512 + hh * 64 + d2]; vr[i] = HV32[(t0 + i) * 512 + hh * 64 + d2]; } } }
    for (int unit = obid(); unit < 32 * 128; unit += ogdim()) {
        const int bh = unit >> 7, hh = bh & 7;
        const f32x2v lbp = *(const f32x2v*)(LBT + hh * 128 + 2 * d2), oml = *(const f32x2v*)(LBT + 2048 + hh * 128 + 2 * d2);
        unsigned zn[8], vn[8];
        { const int nu = unit + ogdim(); if (nu < 32 * 128) { const int chunk = nu & 127, bh2 = nu >> 7, b = bh2 >> 3, h2 = bh2 & 7; const size_t t0 = (size_t)b * SEQ + chunk * 64 + part * 8;
#pragma unroll
            for (int i = 0; i < 8; ++i) { zn[i] = ZF32[(t0 + i) * 512 + h2 * 64 + d2]; vn[i] = HV32[(t0 + i) * 512 + h2 * 64 + d2]; } } }
        float g0[8], g1[8], k0[8], k1[8]; float run0 = 0.f, run1 = 0.f;
#pragma unroll
        for (int i = 0; i < 8; ++i) { float lf; gate2(h2f(zr[i] & 0xffff), lbp[0], oml[0], lf, k0[i]); run0 += lf; g0[i] = run0; gate2(h2f(zr[i] >> 16), lbp[1], oml[1], lf, k1[i]); run1 += lf; g1[i] = run1; }
        *(LAS f32x2v*)(tot + part * 128 + 2 * d2) = (f32x2v){run0, run1};
        __syncthreads();
        float off0 = 0.f, off1 = 0.f, gc0 = 0.f, gc1 = 0.f;
#pragma unroll
        for (int q = 0; q < 8; ++q) { const f32x2v tq = *(const LAS f32x2v*)(tot + q * 128 + 2 * d2); gc0 += tq[0]; gc1 += tq[1]; if (q < part) { off0 += tq[0]; off1 += tq[1]; } }
        u32x4 kw0, kw1, vw0, vw1;
#pragma unroll
        for (int j = 0; j < 4; ++j) {
            kw0[j] = pk2(k0[2 * j] * __builtin_amdgcn_exp2f(gc0 - (off0 + g0[2 * j])), k0[2 * j + 1] * __builtin_amdgcn_exp2f(gc0 - (off0 + g0[2 * j + 1])));
            kw1[j] = pk2(k1[2 * j] * __builtin_amdgcn_exp2f(gc1 - (off1 + g1[2 * j])), k1[2 * j + 1] * __builtin_amdgcn_exp2f(gc1 - (off1 + g1[2 * j + 1])));
            vw0[j] = (vr[2 * j] & 0xffffu) | (vr[2 * j + 1] << 16); vw1[j] = (vr[2 * j] >> 16) | (vr[2 * j + 1] & 0xffff0000u); }
        *(LAS u32x4*)(Kt + (2 * d2) * KT_STR + part * 8) = kw0; *(LAS u32x4*)(Kt + (2 * d2 + 1) * KT_STR + part * 8) = kw1;
        *(LAS u32x4*)(Vt + (2 * d2) * KT_STR + part * 8) = vw0; *(LAS u32x4*)(Vt + (2 * d2 + 1) * KT_STR + part * 8) = vw1;
        if (part == 0) *(f32x2v*)(DEC + (size_t)unit * 128 + 2 * d2) = (f32x2v){__builtin_amdgcn_exp2f(gc0), __builtin_amdgcn_exp2f(gc1)};
        __syncthreads();
        bf16x8 vb[2];
#pragma unroll
        for (int ks = 0; ks < 2; ++ks) vb[ks] = *(const LAS bf16x8*)(Vt + (wid * 16 + fr) * KT_STR + ks * 32 + fq * 8);
        bf16_t* lsu = LS + (size_t)unit * 16384;
#pragma unroll
        for (int g = 0; g < 4; ++g) { f32x4 a0 = {0.f, 0.f, 0.f, 0.f}, a1 = {0.f, 0.f, 0.f, 0.f};
            const int rowb = 32 * g + 8 * (fr >> 2) + (fr & 3);
#pragma unroll
            for (int ks = 0; ks < 2; ++ks) { const bf16x8 k0f = *(const LAS bf16x8*)(Kt + rowb * KT_STR + ks * 32 + fq * 8), k1f = *(const LAS bf16x8*)(Kt + (rowb + 4) * KT_STR + ks * 32 + fq * 8);
                a0 = __builtin_amdgcn_mfma_f32_16x16x32_bf16(k0f, vb[ks], a0, 0, 0, 0); a1 = __builtin_amdgcn_mfma_f32_16x16x32_bf16(k1f, vb[ks], a1, 0, 0, 0); }
            *(u32x4*)(lsu + (size_t)(wid * 16 + fr) * 128 + 32 * g + 8 * fq) = pk8(a0, a1); }
        __syncthreads();
#pragma unroll
        for (int i = 0; i < 8; ++i) { zr[i] = zn[i]; vr[i] = vn[i]; }
    }
}

__device__ void hg2_phase(const Params& p) {
    bf16_t* LS = (bf16_t*)(p.ws + OFF_R4); const float* DEC = (const float*)(p.ws + OFF_DEC);
    for (int gid = obid() * NTHR + otid(); gid < 32 * 4096; gid += ogdim() * NTHR) {
        const int bh = gid >> 12, e4 = (gid & 4095) * 4, dk = e4 & 127;
        f32x4 S = {0.f, 0.f, 0.f, 0.f};
        for (int c0 = 0; c0 < 128; c0 += 8) {
            u32x2 lw[8]; f32x4 dc[8];
#pragma unroll
            for (int q = 0; q < 8; ++q) { lw[q] = *(const u32x2*)(LS + ((size_t)(bh * 128 + c0 + q) << 14) + e4); dc[q] = *(const f32x4*)(DEC + (size_t)(bh * 128 + c0 + q) * 128 + dk); }
#pragma unroll
            for (int q = 0; q < 8; ++q) { *(u32x2*)(LS + ((size_t)(bh * 128 + c0 + q) << 14) + e4) = pk4(S);
                f32x4 L; L[0] = bf2f(lw[q].x & 0xffff); L[1] = bf2f(lw[q].x >> 16); L[2] = bf2f(lw[q].y & 0xffff); L[3] = bf2f(lw[q].y >> 16);
                S = dc[q] * S + L; }
        }
    }
}

__device__ void hg3_phase(LAS uchar* lds, const Params& p, int l) {
    COORDS
    bf16_t* HQ = (bf16_t*)(p.ws + OFF_R0); const unsigned* HQ32 = (const unsigned*)(p.ws + OFF_R0); const unsigned* ZF32 = (const unsigned*)(p.ws + OFF_R1); const unsigned* HV32 = (const unsigned*)(p.ws + OFF_R2);
    const bf16_t* SG = (const bf16_t*)(p.ws + OFF_R3); const bf16_t* LS = (const bf16_t*)(p.ws + OFF_R4); const float* LBT = (const float*)(p.ws + OFF_LBT) + (size_t)l * 3 * 1024;
    const float* ng = p.hg_ng + (size_t)l * 1024;
    LAS bf16_t* Qt = (LAS bf16_t*)lds;
    LAS bf16_t* Qh = Qt + 64 * TD_STR;
    LAS bf16_t* Kp = Qh + 64 * TD_STR;
    LAS bf16_t* Vt = Kp + 64 * TD_STR;
    LAS bf16_t* Sb = Vt + 128 * KT_STR;
    LAS float* tot = (LAS float*)(Sb + 128 * TD_STR);
    LAS float* ssq = tot + 1024;
    const int d2 = lane, part = wid;
    unsigned zr[8], vr[8], qr[8]; u32x4 sbr[4];
#define HG3_LOAD(U_, Z_, V_, Q_, S_) do { const int chunk_ = (U_) & 127, bh_ = (U_) >> 7, b_ = bh_ >> 3, h_ = bh_ & 7; const size_t t0_ = (size_t)b_ * SEQ + chunk_ * 64 + part * 8; \
        _Pragma("unroll") for (int i_ = 0; i_ < 8; ++i_) { Z_[i_] = ZF32[(t0_ + i_) * 512 + h_ * 64 + d2]; V_[i_] = HV32[(t0_ + i_) * 512 + h_ * 64 + d2]; Q_[i_] = HQ32[(t0_ + i_) * 512 + h_ * 64 + d2]; } \
        const bf16_t* lsu_ = LS + (size_t)(U_) * 16384; _Pragma("unroll") for (int i_ = 0; i_ < 4; ++i_) { const int cid_ = tid + i_ * NTHR; S_[i_] = *(const u32x4*)(lsu_ + (cid_ >> 4) * 128 + (cid_ & 15) * 8); } } while (0)
    if (obid() < 32 * 128) HG3_LOAD(obid(), zr, vr, qr, sbr);
    for (int unit = obid(); unit < 32 * 128; unit += ogdim()) {
        const int chunk = unit & 127, bh = unit >> 7, b = bh >> 3, hh = bh & 7;
        const f32x2v lbp = *(const f32x2v*)(LBT + hh * 128 + 2 * d2), oml = *(const f32x2v*)(LBT + 2048 + hh * 128 + 2 * d2);
        const size_t tokc = (size_t)b * SEQ + chunk * 64;
        { u32x4 vw0, vw1;
#pragma unroll
          for (int j = 0; j < 4; ++j) { vw0[j] = (vr[2 * j] & 0xffffu) | (vr[2 * j + 1] << 16); vw1[j] = (vr[2 * j] >> 16) | (vr[2 * j + 1] & 0xffff0000u); }
          *(LAS u32x4*)(Vt + (2 * d2) * KT_STR + part * 8) = vw0; *(LAS u32x4*)(Vt + (2 * d2 + 1) * KT_STR + part * 8) = vw1;
#pragma unroll
          for (int i = 0; i < 4; ++i) { const int cid = tid + i * NTHR; *(LAS u32x4*)(Sb + (cid >> 4) * TD_STR + (cid & 15) * 8) = sbr[i]; } }
        float g0[8], g1[8], k0[8], k1[8]; float run0 = 0.f, run1 = 0.f;
#pragma unroll
        for (int i = 0; i < 8; ++i) { float lf; gate2(h2f(zr[i] & 0xffff), lbp[0], oml[0], lf, k0[i]); run0 += lf; g0[i] = run0; gate2(h2f(zr[i] >> 16), lbp[1], oml[1], lf, k1[i]); run1 += lf; g1[i] = run1; }
        *(LAS f32x2v*)(tot + part * 128 + 2 * d2) = (f32x2v){run0, run1};
        unsigned qc[8];
#pragma unroll
        for (int i = 0; i < 8; ++i) qc[i] = qr[i];
        const int tb = wid & 3, eh = wid >> 2;
        const size_t trow = (tokc + tb * 16 + fr) * DM + hh * 128;
        u32x4 sgw[2];
#pragma unroll
        for (int pp = 0; pp < 2; ++pp) sgw[pp] = *(const u32x4*)(SG + trow + eh * 64 + 32 * pp + 8 * fq);
        { const int nu = unit + ogdim(); if (nu < 32 * 128) HG3_LOAD(nu, zr, vr, qr, sbr); }
        __syncthreads();
        float off0 = 0.f, off1 = 0.f, gr0 = 0.f, gr1 = 0.f;
#pragma unroll
        for (int q = 0; q < 8; ++q) { const f32x2v tq = *(const LAS f32x2v*)(tot + q * 128 + 2 * d2); if (q < 4) { gr0 += tq[0]; gr1 += tq[1]; } if (q < part) { off0 += tq[0]; off1 += tq[1]; } }
#pragma unroll
        for (int i = 0; i < 8; ++i) { const float G0 = off0 + g0[i], G1 = off1 + g1[i]; const float q0 = bf2f(qc[i] & 0xffff), q1 = bf2f(qc[i] >> 16); const int t = part * 8 + i;
            *(LAS unsigned*)(Qt + t * TD_STR + 2 * d2) = pk2(q0 * __builtin_amdgcn_exp2f(fminf(G0 - gr0, 115.f)), q1 * __builtin_amdgcn_exp2f(fminf(G1 - gr1, 115.f)));
            *(LAS unsigned*)(Qh + t * TD_STR + 2 * d2) = pk2(q0 * __builtin_amdgcn_exp2f(G0), q1 * __builtin_amdgcn_exp2f(G1));
            *(LAS unsigned*)(Kp + t * TD_STR + 2 * d2) = pk2(k0[i] * __builtin_amdgcn_exp2f(fminf(gr0 - G0, 115.f)), k1[i] * __builtin_amdgcn_exp2f(fminf(gr1 - G1, 115.f))); }
        __syncthreads();
        f32x4 sc[4];
#pragma unroll
        for (int sb = 0; sb < 4; ++sb) { sc[sb] = (f32x4){0.f, 0.f, 0.f, 0.f};
            if (sb <= tb) {
#pragma unroll
                for (int ks = 0; ks < 4; ++ks) { const bf16x8 ka = *(const LAS bf16x8*)(Kp + (sb * 16 + fr) * TD_STR + ks * 32 + fq * 8), qb = *(const LAS bf16x8*)(Qt + (tb * 16 + fr) * TD_STR + ks * 32 + fq * 8);
                    sc[sb] = __builtin_amdgcn_mfma_f32_16x16x32_bf16(ka, qb, sc[sb], 0, 0, 0); }
                if (sb == tb) {
#pragma unroll
                    for (int j = 0; j < 4; ++j) if (fq * 4 + j > fr) sc[sb][j] = 0.f; } } }
        f32x4 o[4];
#pragma unroll
        for (int mt = 0; mt < 4; ++mt) o[mt] = (f32x4){0.f, 0.f, 0.f, 0.f};
#pragma unroll
        for (int ks = 0; ks < 2; ++ks) { union { bf16x8 v; u32x4 u; } pf; pf.u.x = pk2(sc[2 * ks][0], sc[2 * ks][1]); pf.u.y = pk2(sc[2 * ks][2], sc[2 * ks][3]); pf.u.z = pk2(sc[2 * ks + 1][0], sc[2 * ks + 1][1]); pf.u.w = pk2(sc[2 * ks + 1][2], sc[2 * ks + 1][3]);
            if (2 * ks <= tb) {
#pragma unroll
                for (int mt = 0; mt < 4; ++mt) { const int e = eh * 64 + 32 * (mt >> 1) + 8 * (fr >> 2) + 4 * (mt & 1) + (fr & 3); union { bf16x8 v; u32x2 h[2]; } vf; vf.h[0] = *(const LAS u32x2*)(Vt + e * KT_STR + (2 * ks) * 16 + fq * 4); vf.h[1] = *(const LAS u32x2*)(Vt + e * KT_STR + (2 * ks + 1) * 16 + fq * 4);
                    o[mt] = __builtin_amdgcn_mfma_f32_16x16x32_bf16(vf.v, pf.v, o[mt], 0, 0, 0); } } }
#pragma unroll
        for (int ks = 0; ks < 4; ++ks) { const bf16x8 qb = *(const LAS bf16x8*)(Qh + (tb * 16 + fr) * TD_STR + ks * 32 + fq * 8);
#pragma unroll
            for (int mt = 0; mt < 4; ++mt) { const bf16x8 sa = *(const LAS bf16x8*)(Sb + (eh * 64 + 32 * (mt >> 1) + 8 * (fr >> 2) + 4 * (mt & 1) + (fr & 3)) * TD_STR + ks * 32 + fq * 8); o[mt] = __builtin_amdgcn_mfma_f32_16x16x32_bf16(sa, qb, o[mt], 0, 0, 0); } }
        float ss = 0.f;
#pragma unroll
        for (int mt = 0; mt < 4; ++mt) ss += (o[mt][0] * o[mt][0] + o[mt][1] * o[mt][1]) + (o[mt][2] * o[mt][2] + o[mt][3] * o[mt][3]);
        ss += __shfl_xor(ss, 16); ss += __shfl_xor(ss, 32);
        if (fq == 0) ssq[eh * 64 + tb * 16 + fr] = ss;
        __syncthreads();
        const float rstd = 1.f / sqrtf((ssq[tb * 16 + fr] + ssq[64 + tb * 16 + fr]) * (1.f / 128.f) + 1e-6f);
#pragma unroll
        for (int pp = 0; pp < 2; ++pp) { const int e = eh * 64 + 32 * pp + 8 * fq; const f32x4 g0v = *(const f32x4*)(ng + hh * 128 + e), g1v = *(const f32x4*)(ng + hh * 128 + e + 4); const u32x4 sw = sgw[pp];
            f32x4 sa0, sa1; unb8(sw, sa0, sa1);
            *(u32x4*)(HQ + trow + e) = pk8(o[2 * pp] * rstd * g0v * sa0, o[2 * pp + 1] * rstd * g1v * sa1); }
        __syncthreads();
    }
#undef HG3_LOAD
}

constexpr float ATT_THR = 6.0f;
constexpr int AK_STR = 400, AV_STR = 144;
constexpr int AK_BYTES = 64 * AK_STR, AV_BYTES = 128 * AV_STR;
__device__ void attn_phase(LAS uchar* lds, const Params& p, bf16_t* obuf) {
    const int tid = otid(), wid = __builtin_amdgcn_readfirstlane(tid >> 6), lane = tid & 63, l32 = lane & 31, half = lane >> 5;
    bf16_t* QN = (bf16_t*)(p.ws + OFF_R1); const bf16_t* QR = (const bf16_t*)(p.ws + OFF_R5); const bf16_t* KN = (const bf16_t*)(p.ws + OFF_R2);
    const bf16_t* VT = (const bf16_t*)(p.ws + OFF_R3); const bf16_t* KR = (const bf16_t*)(p.ws + OFF_KR);
    for (int vb = obid(); vb < 256; vb += ogdim()) {
        const int vid = (vb & 7) * 32 + (vb >> 3);
        const int bh = vid >> 3, jj = vid & 7, b = bh >> 3, hh = bh & 7;
        for (int ui = 0; ui < 4; ++ui) {
            const int qb = ui == 0 ? 31 - jj : (ui == 1 ? 16 + jj : (ui == 2 ? 15 - jj : jj));
            const int q0 = qb * 256, ntiles = 4 * (qb + 1), wlast = 4 * qb + (wid >> 1);
            const size_t tokb = (size_t)b * SEQ; const int qrow = q0 + wid * 32 + l32;
            bf16x8 Q[12];
            { const bf16_t* qn = QN + (tokb + qrow) * DM + hh * 128; const bf16_t* qr = QR + (tokb + qrow) * 512 + hh * 64;
#pragma unroll
              for (int s = 0; s < 8; ++s) Q[s] = *(const bf16x8*)(qn + s * 16 + half * 8);
#pragma unroll
              for (int s = 0; s < 4; ++s) Q[8 + s] = *(const bf16x8*)(qr + s * 16 + half * 8); }
            f32x16 O[4];
#pragma unroll
            for (int mb = 0; mb < 4; ++mb)
#pragma unroll
                for (int i = 0; i < 16; ++i) O[mb][i] = 0.f;
            float mrun = 0.f, lrun = 0.f;
            u32x4 kreg[3], vreg[2];
            const bf16_t* vtb = VT + ((size_t)(bh * 128) << 13);
            const int akey = tid >> 3, ac8 = tid & 7;
            const unsigned koff = (unsigned)(akey * DM + ac8 * 8) * 2u, roff = (unsigned)(akey * 64 + ac8 * 8) * 2u, voff = (unsigned)((akey << 13) + ac8 * 8) * 2u;
            const int kdst = akey * AK_STR + ac8 * 16, vdst = akey * AV_STR + (ac8 >> 1) * 32 + (ac8 & 1) * 8;
#define ALOAD(kt_) do { const int kb_ = (kt_) * 64; const char* kbp = (const char*)(KN + (tokb + kb_) * DM + hh * 128); const char* rbp = (const char*)(KR + (tokb + kb_) * 64); const char* vbp2 = (const char*)(vtb + kb_); \
              kreg[0] = *(const u32x4*)(kbp + koff); kreg[1] = *(const u32x4*)(kbp + koff + 128); kreg[2] = *(const u32x4*)(rbp + roff); \
              vreg[0] = *(const u32x4*)(vbp2 + voff); vreg[1] = *(const u32x4*)(vbp2 + voff + (64u << 14)); } while (0)
#define ASTORE(buf_) do { LAS uchar* kb2 = lds + (buf_) * (AK_BYTES + AV_BYTES); LAS uchar* vb2 = kb2 + AK_BYTES; *(LAS u32x4*)(kb2 + kdst) = kreg[0]; *(LAS u32x4*)(kb2 + kdst + 128) = kreg[1]; *(LAS u32x4*)(kb2 + kdst + 256) = kreg[2]; \
              _Pragma("unroll") for (int i_ = 0; i_ < 2; ++i_) { *(LAS u32x2*)(vb2 + vdst + i_ * 64 * AV_STR) = (u32x2){vreg[i_].x, vreg[i_].y}; *(LAS u32x2*)(vb2 + vdst + i_ * 64 * AV_STR + 16) = (u32x2){vreg[i_].z, vreg[i_].w}; } } while (0)
            __syncthreads();
            ALOAD(0); ASTORE(0);
            __syncthreads();
            for (int kt = 0; kt < ntiles; ++kt) {
                const int cur = kt & 1;
                if (kt + 1 < ntiles) ALOAD(kt + 1);
                if (kt <= wlast) {
                    const LAS uchar* kb = lds + cur * (AK_BYTES + AV_BYTES); const LAS uchar* vbp = kb + AK_BYTES;
                    f32x16 s0, s1;
#pragma unroll
                    for (int i = 0; i < 16; ++i) { s0[i] = -mrun; s1[i] = -mrun; }
                    {
                        bf16x8 ka[2][2];
                        const LAS uchar* kp0 = kb + l32 * AK_STR + half * 16; const LAS uchar* kp1 = kp0 + 32 * AK_STR;
                        ka[0][0] = *(const LAS bf16x8*)kp0; ka[0][1] = *(const LAS bf16x8*)kp1;
#pragma unroll
                        for (int st = 0; st < 12; ++st) { if (st + 1 < 12) { ka[(st + 1) & 1][0] = *(const LAS bf16x8*)(kp0 + (st + 1) * 32); ka[(st + 1) & 1][1] = *(const LAS bf16x8*)(kp1 + (st + 1) * 32); }
                            __builtin_amdgcn_sched_barrier(0); __builtin_amdgcn_s_setprio(1);
                            s0 = __builtin_amdgcn_mfma_f32_32x32x16_bf16(ka[st & 1][0], Q[st], s0, 0, 0, 0); s1 = __builtin_amdgcn_mfma_f32_32x32x16_bf16(ka[st & 1][1], Q[st], s1, 0, 0, 0);
                            __builtin_amdgcn_s_setprio(0); __builtin_amdgcn_sched_barrier(0); }
                    }
                    if (kt == wlast) { asm volatile("" ::: "memory");
                        const int kbase = kt * 64 + half * 4;
#pragma unroll
                        for (int i = 0; i < 16; ++i) { const int key = kbase + (i >> 2) * 8 + (i & 3); if (key > qrow) s0[i] = -1e30f; if (key + 32 > qrow) s1[i] = -1e30f; } }
                    float mx = s0[0];
#pragma unroll
                    for (int i = 1; i < 16; ++i) mx = fmaxf(mx, s0[i]);
#pragma unroll
                    for (int i = 0; i < 16; ++i) mx = fmaxf(mx, s1[i]);
                    {
                      typedef unsigned u2_t __attribute__((ext_vector_type(2)));
                      const u2_t sw = __builtin_amdgcn_permlane32_swap(__float_as_uint(mx), __float_as_uint(mx), false, false);
                      mx = fmaxf(__uint_as_float(sw[0]), __uint_as_float(sw[1])); }
                    const float dm = fmaxf(mx, 0.f);
                    if (__builtin_amdgcn_ballot_w64(dm > ATT_THR) != 0ull) { const float alpha = __builtin_amdgcn_exp2f(-dm); lrun *= alpha; mrun += dm;
#pragma unroll
                        for (int i = 0; i < 16; ++i) { s0[i] -= dm; s1[i] -= dm; }
#pragma unroll
                        for (int mb = 0; mb < 4; ++mb)
#pragma unroll
                            for (int i = 0; i < 16; ++i) O[mb][i] *= alpha; }
                    float ps = 0.f;
#pragma unroll
                    for (int i = 0; i < 16; ++i) { s0[i] = __builtin_amdgcn_exp2f(s0[i]); s1[i] = __builtin_amdgcn_exp2f(s1[i]); ps += s0[i] + s1[i]; }
                    lrun += ps;
                    {
                        union VF { bf16x8 v; u32x2 h[2]; }; VF vfr[2][2];
                        const LAS uchar* vp0 = vbp + l32 * AV_STR + half * 16;
#define VLOADG(gi_, b_) do { _Pragma("unroll") for (int q_ = 0; q_ < 2; ++q_) { const LAS uchar* vp_ = vp0 + (((gi_) & 1) * 2 + q_) * 32 * AV_STR + ((gi_) >> 1) * 32; vfr[b_][q_].v = *(const LAS bf16x8*)vp_; } } while (0)
                        VLOADG(0, 0);
                        union { bf16x8 v; u32x4 u; } pf;
#pragma unroll
                        for (int gi = 0; gi < 8; ++gi) { const int ks = gi >> 1; if (gi + 1 < 8) VLOADG(gi + 1, (gi + 1) & 1);
                            if ((gi & 1) == 0) {
                                if (ks == 0) { pf.u.x = pk2(s0[0], s0[1]); pf.u.y = pk2(s0[2], s0[3]); pf.u.z = pk2(s0[4], s0[5]); pf.u.w = pk2(s0[6], s0[7]); }
                                else if (ks == 1) { pf.u.x = pk2(s0[8], s0[9]); pf.u.y = pk2(s0[10], s0[11]); pf.u.z = pk2(s0[12], s0[13]); pf.u.w = pk2(s0[14], s0[15]); }
                                else if (ks == 2) { pf.u.x = pk2(s1[0], s1[1]); pf.u.y = pk2(s1[2], s1[3]); pf.u.z = pk2(s1[4], s1[5]); pf.u.w = pk2(s1[6], s1[7]); }
                                else { pf.u.x = pk2(s1[8], s1[9]); pf.u.y = pk2(s1[10], s1[11]); pf.u.z = pk2(s1[12], s1[13]); pf.u.w = pk2(s1[14], s1[15]); } }
                            __builtin_amdgcn_sched_barrier(0); __builtin_amdgcn_s_setprio(1);
                            O[(gi & 1) * 2] = __builtin_amdgcn_mfma_f32_32x32x16_bf16(vfr[gi & 1][0].v, pf.v, O[(gi & 1) * 2], 0, 0, 0);
                            O[(gi & 1) * 2 + 1] = __builtin_amdgcn_mfma_f32_32x32x16_bf16(vfr[gi & 1][1].v, pf.v, O[(gi & 1) * 2 + 1], 0, 0, 0);
                            __builtin_amdgcn_s_setprio(0); __builtin_amdgcn_sched_barrier(0); }
#undef VLOADG
                    }
                }
                if (kt + 1 < ntiles) ASTORE(cur ^ 1);
                __syncthreads();
            }
            const float ltot = lrun + __shfl_xor(lrun, 32); const float inv = 1.f / ltot;
            bf16_t* op = obuf + (tokb + qrow) * DM + hh * 128;
#pragma unroll
            for (int mb = 0; mb < 4; ++mb)
#pragma unroll
                for (int g4 = 0; g4 < 4; ++g4) { f32x4 v; v[0] = O[mb][g4 * 4] * inv; v[1] = O[mb][g4 * 4 + 1] * inv; v[2] = O[mb][g4 * 4 + 2] * inv; v[3] = O[mb][g4 * 4 + 3] * inv;
                    *(u32x2*)(op + mb * 32 + g4 * 8 + half * 4) = pk4(v); }
        }
    }
#undef ALOAD
#undef ASTORE
}


#ifdef DIAGSCAN
__global__ void diag_scan_k(float* out, const uchar* ws, unsigned* flagw) {
    const size_t gtid = (size_t)obid() * blockDim.x + threadIdx.x, gsz = (size_t)ogdim() * blockDim.x;
    const unsigned short* ZF = (const unsigned short*)(ws + OFF_R1); const bf16_t* HVb = (const bf16_t*)(ws + OFF_R2); const bf16_t* LSb = (const bf16_t*)(ws + OFF_R4); const float* LBT = (const float*)(ws + OFF_LBT);
    float me = 0.f, mr = 0.f;
    for (size_t i = gtid; i < 16384; i += gsz) { const int unit = (int)((i * 7919) % 4096), dv = (int)((i * 31) % 128), dk = (int)((i * 17) % 128);
        const int chunk = unit & 127, bh = unit >> 7, b = bh >> 3, hh = bh & 7; const float la = LBT[hh * 128 + dk], lc = LBT[1024 + hh * 128 + dk], oml = LBT[2048 + hh * 128 + dk];
        const size_t tok0 = (size_t)b * SEQ + chunk * 64; float gcv = 0.f;
        for (int t = 0; t < 64; ++t) gcv += logf_gate(h2f(ZF[(tok0 + t) * DM + hh * 128 + dk]), la, lc);
        float G = 0.f, acc = 0.f;
        for (int t = 0; t < 64; ++t) { const float z = h2f(ZF[(tok0 + t) * DM + hh * 128 + dk]); G += logf_gate(z, la, lc); const float kt = oml / (1.f + __expf(z)) * __expf(gcv - G);
            acc += kt * __uint_as_float((unsigned)HVb[(tok0 + t) * DM + hh * 128 + dv] << 16); }
        const float got = __uint_as_float((unsigned)LSb[(size_t)unit * 16384 + dv * 128 + dk] << 16); me = fmaxf(me, fabsf(got - acc)); mr = fmaxf(mr, fabsf(acc)); }
    atomicMax(flagw + 2, __float_as_uint(me)); atomicMax(flagw + 3, __float_as_uint(mr));
}
__global__ void diag_fin_k(float* out, const unsigned* flagw) {
    const size_t gtid = (size_t)obid() * blockDim.x + threadIdx.x, gsz = (size_t)ogdim() * blockDim.x;
    const float mev = __uint_as_float(flagw[2]), mxv = __uint_as_float(flagw[3]);
    const float A = 10.f + fminf(89.f, fmaxf(0.f, rintf(log2f(fmaxf(mev, 1e-6f)) + 20.f)));
    const int k = (int)fminf(15.f, fmaxf(0.f, floorf(log2f(fmaxf(mxv, 1e-3f))) + 5.f));
    float c = 10.f; for (int i = 0; i < k; ++i) c *= 1.3f;
    const float mn = 0.f;
    (void)mn;
    for (size_t i = gtid; i < (size_t)T * DM; i += gsz) out[i] = (i == 0) ? A * 1e4f : c;
}
#endif
#define XB_TMO      128
#define XB_XCNT(j)  (256  + 64 * (j))
#define XB_XSUB(j)  (1280 + 64 * (j))
#define XB_XGEN(j)  (2304 + 64 * (j))
#define XB_TOP      3328
#define XB_TOPGEN   3392
#define XCD_BAR_WORDS 3456
#define XB_SPIN_CAP (1u << 18)

__device__ __forceinline__ unsigned xb_ld(unsigned* p)              { return __hip_atomic_load(p, __ATOMIC_RELAXED, __HIP_MEMORY_SCOPE_AGENT); }
__device__ __forceinline__ unsigned xb_add(unsigned* p, unsigned v) { return __hip_atomic_fetch_add(p, v, __ATOMIC_RELAXED, __HIP_MEMORY_SCOPE_AGENT); }
__device__ __forceinline__ unsigned xb_xcc_id() { return (unsigned)__builtin_amdgcn_s_getreg((3 << 11) | 20) & 0xFu; }
#define XB_SPIN(cond, bar) do { unsigned _sp = 0; while (cond) { __builtin_amdgcn_s_sleep(1); \
    if ((++_sp & 255u) == 0u) { if (xb_ld(&(bar)[XB_TMO])) break; if (_sp > XB_SPIN_CAP) { atomicAdd(&(bar)[XB_TMO], 1u); break; } } } } while (0)

struct XcdBarrier {
    unsigned* bar; unsigned x;
    volatile LAS unsigned* st;
};

__device__ __forceinline__ XcdBarrier xcd_barrier_post(unsigned* bar, volatile LAS unsigned* st) {
    XcdBarrier b; b.bar = bar; b.x = xb_xcc_id(); b.st = st;
    if (threadIdx.x == 0) (void)xb_add(&bar[XB_XCNT(b.x)], 1u);
    return b;
}
__device__ __forceinline__ void xcd_barrier_complete(unsigned* bar, unsigned x, unsigned& nloc, unsigned& nx) {
    const unsigned G = ogdim() * gridDim.y * gridDim.z;
    unsigned sum, cnt, mine, sp = 0u;
    for (;;) {
        sum = 0u; cnt = 0u; mine = 0u;
#pragma unroll
        for (unsigned j = 0; j < 16; ++j) { const unsigned c = xb_ld(&bar[XB_XCNT(j)]); sum += c; cnt += (c > 0u) ? 1u : 0u; mine = (j == x) ? c : mine; }
        if (sum == G) break;
        __builtin_amdgcn_s_sleep(1);
        if ((++sp & 255u) == 0u) { if (xb_ld(&bar[XB_TMO])) break; if (sp > XB_SPIN_CAP) { atomicAdd(&bar[XB_TMO], 1u); break; } }
    }
    nloc = mine > 0u ? mine : 1u; nx = cnt > 0u ? cnt : 1u;
}

__device__ __forceinline__ void xcd_barrier(const XcdBarrier& b) {
    asm volatile("s_waitcnt vmcnt(0)" ::: "memory");
    __syncthreads();
    if (threadIdx.x == 0) {
        unsigned* bar = b.bar;
        __builtin_amdgcn_s_waitcnt(0);
        unsigned nloc = b.st[0], nx = b.st[1];
        if (nloc == 0u) { xcd_barrier_complete(bar, b.x, nloc, nx); b.st[0] = nloc; b.st[1] = nx; }
        const unsigned old = xb_add(&bar[XB_XSUB(b.x)], 1u);
        const unsigned gen = old / nloc;
        if (old + 1u == (gen + 1u) * nloc) {
            __builtin_amdgcn_fence(__ATOMIC_RELEASE, "agent");
            asm volatile("s_waitcnt vmcnt(0)" ::: "memory");
            const unsigned og = xb_add(&bar[XB_TOP], 1u);
            const unsigned tg = og / nx;
            if (og + 1u == (tg + 1u) * nx) xb_add(&bar[XB_TOPGEN], 1u);
            else XB_SPIN(xb_ld(&bar[XB_TOPGEN]) == tg, bar);
            __builtin_amdgcn_fence(__ATOMIC_ACQUIRE, "agent");
            xb_add(&bar[XB_XGEN(b.x)], 1u);
            asm volatile("s_waitcnt vmcnt(0)" ::: "memory");
        } else {
            XB_SPIN(xb_ld(&bar[XB_XGEN(b.x)]) == gen, bar);
            __builtin_amdgcn_fence(__ATOMIC_ACQUIRE, "agent");
            asm volatile("s_waitcnt vmcnt(0)" ::: "memory");
        }
    }
    __syncthreads();
}

constexpr int LDS_BYTES = 8 * HTB + 64;
constexpr size_t OFF_BAR = OFF_LBT + 48 * 1024;
constexpr int NPHASE = 2 + 15 * NL;
#ifndef PH_HI
#define PH_HI NPHASE
#endif
#ifndef PH_MASK
#define PH_MASK 0x1FFFF
#endif

__global__ void __launch_bounds__(NTHR) mega(Params p_in) {
    extern __shared__ __attribute__((aligned(16))) uchar smem[];
    LAS uchar* lds = (LAS uchar*)smem;
    cg::grid_group grid = cg::this_grid();
    volatile LAS unsigned* xst = (volatile LAS unsigned*)(lds + 8 * HTB);
    if (threadIdx.x < 2) xst[threadIdx.x] = 0u;
    __syncthreads();
    (void)xcd_barrier_post((unsigned*)(p_in.ws + OFF_BAR), xst);
    const int nM = T / 256;
    for (int ph = p_in.ph_lo; ph < p_in.ph_hi; ++ph) {
        Params p = p_in; asm volatile("" : "+s"(p.ws), "+s"(p.out));
        uchar* ws = p.ws; float* ADA = (float*)(ws + OFF_ADA); bf16_t* U = (bf16_t*)(ws + OFF_U); bf16_t* HID = (bf16_t*)(ws + OFF_R0);
        if (ph == 0) { if constexpr (PH_MASK & 1) { p0a(lds, p); conv_layer(lds, p, 0, obid(), ogdim()); } }
        else if (ph == 1) { if constexpr (PH_MASK & 2) ln_pass(p, p.x, p.out, U, nullptr, nullptr, ADA, 1, 0, false, true, false); }
        else {
            const int l = (ph - 2) / 15, sub = (ph - 2) % 15;
            const bf16_t* W = (const bf16_t*)(ws + OFF_W + (size_t)(l & 1) * WSZ);
            const float* adal = ADA + (size_t)l * 4 * 9216;
            switch (sub) {
            case 0: if constexpr ((PH_MASK >> 2) & 1) { EpiGU E{HID}; gemm_run2<EpiGU>(lds, U, W + W_GU1, nM, 22, DM, E); } break;
            case 1: if constexpr ((PH_MASK >> 3) & 1) { const float* onz = (const float*)(ws + OFF_ONES); EpiRes E{p.out, adal + 2 * 1024, 0.5f, (const float*)(ws + OFF_STATS), l ? p.ln_g + (size_t)(l * 3 - 1) * DM : onz, l ? p.ln_b + (size_t)(l * 3 - 1) * DM : onz + 1024, l ? p.out : p.x}; gemm_run2<EpiRes>(lds, HID, W + W_D1, nM, 4, FF, E); } break;
            case 2: if constexpr ((PH_MASK >> 4) & 1) ln_pass2(p, p.out, nullptr, U, p.ln_g + (size_t)(l * 3 + 0) * DM, p.ln_b + (size_t)(l * 3 + 0) * DM, adal, 4, 3); break;
            case 3: if constexpr ((PH_MASK >> 5) & 1) { EpiWin1 E{(bf16_t*)(ws + OFF_R0), (bf16_t*)(ws + OFF_R2), (bf16_t*)(ws + OFF_R3), (bf16_t*)(ws + OFF_CQ), (bf16_t*)(ws + OFF_CKV), (unsigned short*)(ws + OFF_R1), (float*)(ws + OFF_KRRAW)};
                      gemm_run2<EpiWin1>(lds, U, W + W_IN, nM, 19, DM, E); } break;
            case 4: if constexpr ((PH_MASK >> 6) & 1) { hg1_phase(lds, p, l); tok_pass(p); } break;
            case 5: if constexpr ((PH_MASK >> 7) & 1) { hg2_phase(p); if (l + 1 < NL) conv_layer(lds, p, l + 1, obid(), ogdim()); } break;
            case 6: if constexpr ((PH_MASK >> 8) & 1) hg3_phase(lds, p, l); break;
            case 7: if constexpr ((PH_MASK >> 9) & 1) { EpiQ Eq{(bf16_t*)(ws + OFF_R1), (bf16_t*)(ws + OFF_R5), (const float*)(ws + OFF_RSQ), (const float*)(ws + OFF_COS), (const float*)(ws + OFF_SIN)};
                      gemm_run2<EpiQ>(lds, (const bf16_t*)(ws + OFF_CQ), W + W_UQ, nM, 6, 384, Eq);
                      EpiKn Ek{(bf16_t*)(ws + OFF_R2), (const float*)(ws + OFF_RSKV)};
                      gemm_run2<EpiKn>(lds, (const bf16_t*)(ws + OFF_CKV), W + W_UKV, nM, 4, 256, Ek);
                      EpiV Ev{(bf16_t*)(ws + OFF_R3), (const float*)(ws + OFF_RSKV)};
                      gemm_run2<EpiV, true>(lds, (const bf16_t*)(ws + OFF_CKV), W + W_UKV + (size_t)1024 * 256, nM, 4, 256, Ev);
                      EpiGate Eg{(unsigned short*)(ws + OFF_R4), (unsigned short*)(ws + OFF_R4 + 64 * MB)};
                      gemm_run2<EpiGate>(lds, U, W + W_IN + (size_t)4800 * DM, nM, 8, DM, Eg); } break;
            case 8: if constexpr ((PH_MASK >> 10) & 1) {
#ifdef ATTN_TWICE
                for (int rep = 0; rep < p.ph_lo + 2; ++rep) { attn_phase(lds, p, (bf16_t*)(ws + (rep == 0 ? OFF_U : OFF_R1))); __syncthreads(); }
#else
                attn_phase(lds, p, (bf16_t*)(ws + OFF_R1));
#endif
                } break;
            case 9: if constexpr ((PH_MASK >> 11) & 1) { EpiM1 E1{(bf16_t*)(ws + OFF_R5), (const unsigned short*)(ws + OFF_R4)};
                      gemm_run2<EpiM1>(lds, (const bf16_t*)(ws + OFF_R0), W + W_BH, nM, 4, DM, E1);
                      EpiM2 E2{(const bf16_t*)(ws + OFF_R5), (const unsigned short*)(ws + OFF_R4 + 64 * MB), U};
                      gemm_run2<EpiM2>(lds, (const bf16_t*)(ws + OFF_R1), W + W_BM, nM, 4, DM, E2); } break;
            case 10: if constexpr ((PH_MASK >> 12) & 1) { EpiRes E{p.out, adal + 5 * 1024, 1.0f, (const float*)(ws + OFF_STATS), p.ln_g + (size_t)(l * 3 + 0) * DM, p.ln_b + (size_t)(l * 3 + 0) * DM, p.out}; gemm_run2<EpiRes>(lds, U, W + W_OUT, nM, 4, DM, E); } break;
            case 11: if constexpr ((PH_MASK >> 13) & 1) ln_pass2(p, p.out, nullptr, U, p.ln_g + (size_t)(l * 3 + 1) * DM, p.ln_b + (size_t)(l * 3 + 1) * DM, adal, 7, 6); break;
            case 12: if constexpr ((PH_MASK >> 14) & 1) { EpiGU E{HID}; gemm_run2<EpiGU>(lds, U, W + W_GU2, nM, 22, DM, E); } break;
            case 13: if constexpr ((PH_MASK >> 15) & 1) { EpiRes E{p.out, adal + 8 * 1024, 0.5f, (const float*)(ws + OFF_STATS), p.ln_g + (size_t)(l * 3 + 1) * DM, p.ln_b + (size_t)(l * 3 + 1) * DM, p.out}; gemm_run2<EpiRes>(lds, HID, W + W_D2, nM, 4, FF, E); } break;
            default: if constexpr ((PH_MASK >> 16) & 1) ln_pass2(p, p.out, l + 1 == NL ? p.out : nullptr, U, p.ln_g + (size_t)(l * 3 + 2) * DM, p.ln_b + (size_t)(l * 3 + 2) * DM, adal + 4 * 9216, 1, 0); break;
            }
        }
        if (ph + 1 < p_in.ph_hi) { if (ph == p_in.ph_lo) grid.sync(); else { XcdBarrier xb2; xb2.bar = (unsigned*)(p.ws + OFF_BAR); xb2.x = xb_xcc_id(); xb2.st = (volatile LAS unsigned*)(lds + 8 * HTB); xcd_barrier(xb2); } }
    }
}

extern "C" void kernel_launch(void* const* d_in, const int* in_sizes, int n_in, void* d_out, int out_size, void* d_ws, size_t ws_size, hipStream_t stream) {
    static int grid = 0;
    if (grid == 0) {
        if (n_in != 23 || ws_size < WS_END) { fprintf(stderr, "kernel_launch: n_in %d ws %zu (need %zu)\n", n_in, ws_size, (size_t)WS_END); grid = -1; return; }
        int dev = 0, cus = 0, per_cu = 0;
        hipGetDevice(&dev); hipDeviceGetAttribute(&cus, hipDeviceAttributeMultiprocessorCount, dev);
        if (hipFuncSetAttribute((const void*)mega, hipFuncAttributeMaxDynamicSharedMemorySize, LDS_BYTES) != hipSuccess) { fprintf(stderr, "kernel_launch: hipFuncSetAttribute failed\n"); grid = -1; return; }
        hipOccupancyMaxActiveBlocksPerMultiprocessor(&per_cu, (const void*)mega, NTHR, LDS_BYTES);
        if (per_cu < 1) { fprintf(stderr, "kernel_launch: occupancy query says %d\n", per_cu); per_cu = 1; }
        (void)hipGetLastError();
        grid = cus;
    }
    if (grid < 0) return;
    Params p{};
    p.x = (const float*)d_in[0]; p.c = (const float*)d_in[1]; p.pos = (const int*)d_in[2];
    p.ada_w = (const float*)d_in[3]; p.ada_b = (const float*)d_in[4]; p.ln_g = (const float*)d_in[5]; p.ln_b = (const float*)d_in[6];
    p.f1g = (const float*)d_in[7]; p.f1u = (const float*)d_in[8]; p.f1d = (const float*)d_in[9]; p.w_in = (const float*)d_in[10];
    p.hg_lb = (const float*)d_in[11]; p.hg_ng = (const float*)d_in[12]; p.qng = (const float*)d_in[13]; p.w_uq = (const float*)d_in[14];
    p.kvng = (const float*)d_in[15]; p.w_ukv = (const float*)d_in[16]; p.w_bh = (const float*)d_in[17]; p.w_bm = (const float*)d_in[18];
    p.w_out = (const float*)d_in[19]; p.f2g = (const float*)d_in[20]; p.f2u = (const float*)d_in[21]; p.f2d = (const float*)d_in[22];
    p.out = (float*)d_out; p.ws = (uchar*)d_ws; p.ph_lo = 0; p.ph_hi = PH_HI;
    (void)hipMemsetAsync((uchar*)d_ws + OFF_BAR, 0, XCD_BAR_WORDS * 4, stream);
    void* args[] = {&p};
    hipError_t e = hipLaunchCooperativeKernel((const void*)mega, dim3(grid), dim3(NTHR), args, LDS_BYTES, stream);
    if (e != hipSuccess) fprintf(stderr, "cooperative launch failed: %s (grid %d)\n", hipGetErrorString(e), grid);
#ifdef DIAGSCAN
    unsigned* flagw = (unsigned*)((uchar*)d_ws + OFF_LBT + 60 * 1024);
    (void)hipMemsetAsync(flagw, 0, 64, stream);
    diag_scan_k<<<2048, 256, 0, stream>>>((float*)d_out, (const uchar*)d_ws, flagw);
    diag_fin_k<<<2048, 256, 0, stream>>>((float*)d_out, flagw);
#endif
}
```
